# Optimizing an MI355X kernel written in HIP

```python
import jax, jax.numpy as jnp
from jax import lax
import numpy as np

D_MODEL = 1024
BATCH = 8
SEQ = 2048
DEPTH = 2
DEC_BATCH = 128
DEC_SEQ = 4
PAST_LEN = 16384
PAGE_SIZE = 128

LRU_BW = 128
D_RNN = (4 * D_MODEL // 3) // LRU_BW * LRU_BW
LRU_BLOCKS = D_RNN // LRU_BW
CONV_W = 4
LRU_C = 8.0
GLA_HEADS = 4
GLA_DK_TOTAL = D_MODEL // 2
GLA_DV_TOTAL = D_MODEL
GLA_DK = GLA_DK_TOTAL // GLA_HEADS
GLA_DV = GLA_DV_TOTAL // GLA_HEADS
GLA_RANK = 16
GLA_TAU = 16.0
GLA_CHUNK = 16
D_FF = ((8 * D_MODEL // 3 + 255) // 256) * 256
EPS = 1e-6
IN_SIZES = (D_RNN, D_RNN, GLA_DK_TOTAL, GLA_DK_TOTAL, GLA_DV_TOTAL, GLA_DV_TOTAL, GLA_RANK, D_MODEL, D_MODEL)
N_IN = sum(IN_SIZES)

kernel_name = "hybrid_rglru_gla_adaln_decode_step"


def _rmsnorm(x, g):
    xf = x.astype(jnp.float32)
    return xf * lax.rsqrt(jnp.mean(xf * xf, axis=-1, keepdims=True) + EPS) * g.astype(jnp.float32)


def _lin_combine(e1, e2):
    a1, b1 = e1
    a2, b2 = e2
    return a1 * a2, a2 * b1 + b2


def _causal_conv(u, buf, w, b):
    xa = jnp.concatenate([buf.astype(jnp.float32), u], axis=1)
    T = u.shape[1]
    out = b.astype(jnp.float32)
    for i in range(CONV_W):
        out = out + xa[:, i:i + T] * w[i].astype(jnp.float32)
    return out, xa[:, -(CONV_W - 1):]


def _rg_lru(xc, h0, wa, ba, wx, bx, lam):
    B, T, _ = xc.shape
    xb = xc.reshape(B, T, LRU_BLOCKS, LRU_BW)
    r = jax.nn.sigmoid(jnp.einsum('btnw,nwv->btnv', xb, wa.astype(jnp.float32)).reshape(B, T, D_RNN) + ba)
    i = jax.nn.sigmoid(jnp.einsum('btnw,nwv->btnv', xb, wx.astype(jnp.float32)).reshape(B, T, D_RNN) + bx)
    log_a = -LRU_C * jax.nn.softplus(-lam.astype(jnp.float32)) * r
    a = jnp.exp(log_a)
    b = jnp.sqrt(-jnp.expm1(2.0 * log_a)) * (i * xc)
    b = b.at[:, 0].add(a[:, 0] * h0.astype(jnp.float32))
    _, h = lax.associative_scan(_lin_combine, (a, b), axis=1)
    return h, h[:, -1]


def _gla_chunked(q, k, v, g, S0):
    B, T, H, K = q.shape
    V = v.shape[-1]
    C = min(GLA_CHUNK, T)
    n = -(-T // C)
    pad = n * C - T

    def blocks(z):
        z = jnp.pad(z, ((0, 0), (0, pad), (0, 0), (0, 0)))
        return z.reshape(B, n, C, H, z.shape[-1]).transpose(1, 0, 3, 2, 4)

    mask = jnp.tril(jnp.ones((C, C), dtype=bool))[:, :, None]

    def step(S, inp):
        qc, kc, vc, gc = inp
        bc = jnp.cumsum(gc, axis=2)
        decay = jnp.exp(jnp.where(mask, bc[:, :, :, None, :] - bc[:, :, None, :, :], -jnp.inf))
        att = jnp.einsum('bhik,bhjk,bhijk->bhij', qc, kc, decay)
        o = jnp.einsum('bhij,bhjv->bhiv', att, vc) + jnp.einsum('bhik,bhkv->bhiv', qc * jnp.exp(bc), S)
        b_last = bc[:, :, -1:, :]
        S = jnp.exp(b_last[:, :, 0, :])[..., None] * S + jnp.einsum('bhjk,bhjv->bhkv', kc * jnp.exp(b_last - bc), vc)
        return S, o

    S_T, o = lax.scan(step, S0.astype(jnp.float32), (blocks(q), blocks(k), blocks(v), blocks(g)))
    o = o.transpose(1, 0, 3, 2, 4).reshape(B, n * C, H, V)[:, :T]
    return o, S_T


def _layer(x, c, conv_buf, h0, S0, norm1_g, norm2_g, ada_w, ada_b, w_in, conv_w, conv_b,
           lru_wa, lru_ba, lru_wx, lru_bx, lru_lambda, gla_wa2, gla_ba, gla_norm_g,
           proj_a, proj_b, w_out, ffn_w1, ffn_w2):
    B, T, _ = x.shape
    mod = jax.nn.silu(c.astype(jnp.float32)) @ ada_w + ada_b
    sh1, sc1, gt1, sh2, sc2, gt2 = jnp.split(mod[:, None, :], 6, axis=-1)
    h = _rmsnorm(x, norm1_g) * (1.0 + sc1) + sh1
    u = h @ w_in
    idx = [int(s) for s in np.cumsum(IN_SIZES)[:-1]]
    u_x, u_g, u_q, u_k, u_v, u_r, u_lr, u_ga, u_gb = jnp.split(u, idx, axis=-1)
    xc, new_conv = _causal_conv(u_x, conv_buf, conv_w, conv_b)
    h_lru, h_T = _rg_lru(xc, h0, lru_wa, lru_ba, lru_wx, lru_bx, lru_lambda)
    y_a = h_lru * jax.nn.gelu(u_g)
    q = u_q.reshape(B, T, GLA_HEADS, GLA_DK) * (GLA_DK ** -0.5)
    k = u_k.reshape(B, T, GLA_HEADS, GLA_DK)
    v = u_v.reshape(B, T, GLA_HEADS, GLA_DV)
    g = (jax.nn.log_sigmoid(u_lr @ gla_wa2 + gla_ba) / GLA_TAU).reshape(B, T, GLA_HEADS, GLA_DK)
    o, S_T = _gla_chunked(q, k, v, g, S0)
    o = o * lax.rsqrt(jnp.mean(o * o, axis=-1, keepdims=True) + EPS) * gla_norm_g.reshape(GLA_HEADS, GLA_DV)
    y_b = o.reshape(B, T, GLA_DV_TOTAL) * jax.nn.silu(u_r)
    m = jax.nn.sigmoid(u_ga) * (y_a @ proj_a) + jax.nn.sigmoid(u_gb) * (y_b @ proj_b)
    x = (x + gt1 * (m @ w_out)).astype(x.dtype)
    h2 = _rmsnorm(x, norm2_g) * (1.0 + sc2) + sh2
    f1, f2 = jnp.split(h2 @ ffn_w1, 2, axis=-1)
    x = (x + gt2 * ((jax.nn.silu(f1) * f2) @ ffn_w2)).astype(x.dtype)
    return x, new_conv.astype(x.dtype), h_T.astype(x.dtype), S_T.astype(x.dtype)


def setup_inputs(seed: int = 0) -> dict:
    key = jax.random.key(seed)
    ks = jax.random.split(key, 32)
    nrm = jax.random.normal
    D = D_MODEL
    u = jax.random.uniform(ks[20], (DEPTH, D_RNN), minval=0.9, maxval=0.999)
    s = u ** (1.0 / LRU_C)
    lru_lambda = jnp.log(s) - jnp.log1p(-s)
    return {
        "x_prompt": nrm(ks[0], (BATCH, SEQ, D)),
        "x_sample": nrm(ks[1], (DEC_BATCH, DEC_SEQ, D)),
        "c_prompt": nrm(ks[2], (BATCH, D)),
        "c_sample": nrm(ks[3], (DEC_BATCH, D)),
        "state_conv": nrm(ks[4], (DEPTH, DEC_BATCH, CONV_W - 1, D_RNN)) * 0.5,
        "state_lru": nrm(ks[5], (DEPTH, DEC_BATCH, D_RNN)) * 0.5,
        "state_gla": nrm(ks[6], (DEPTH, DEC_BATCH, GLA_HEADS, GLA_DK, GLA_DV)) * 0.3,
        "norm1_g": 1.0 + 0.05 * nrm(ks[7], (DEPTH, D)),
        "norm2_g": 1.0 + 0.05 * nrm(ks[8], (DEPTH, D)),
        "ada_w": nrm(ks[9], (DEPTH, D, 6 * D)) * (0.3 * D ** -0.5),
        "ada_b": 0.05 * nrm(ks[10], (DEPTH, 6 * D)),
        "w_in": nrm(ks[11], (DEPTH, D, N_IN)) * D ** -0.5,
        "conv_w": nrm(ks[12], (DEPTH, CONV_W, D_RNN)) * CONV_W ** -0.5,
        "conv_b": 0.02 * nrm(ks[13], (DEPTH, D_RNN)),
        "lru_wa": nrm(ks[14], (DEPTH, LRU_BLOCKS, LRU_BW, LRU_BW)) * LRU_BW ** -0.5,
        "lru_ba": 0.02 * nrm(ks[15], (DEPTH, D_RNN)),
        "lru_wx": nrm(ks[16], (DEPTH, LRU_BLOCKS, LRU_BW, LRU_BW)) * LRU_BW ** -0.5,
        "lru_bx": 0.02 * nrm(ks[17], (DEPTH, D_RNN)),
        "lru_lambda": lru_lambda,
        "gla_wa2": nrm(ks[18], (DEPTH, GLA_RANK, GLA_DK_TOTAL)) * GLA_RANK ** -0.5,
        "gla_ba": 1.0 + 0.1 * nrm(ks[19], (DEPTH, GLA_DK_TOTAL)),
        "gla_norm_g": 1.0 + 0.05 * nrm(ks[21], (DEPTH, GLA_DV_TOTAL)),
        "proj_a": nrm(ks[22], (DEPTH, D_RNN, D)) * D_RNN ** -0.5,
        "proj_b": nrm(ks[23], (DEPTH, GLA_DV_TOTAL, D)) * GLA_DV_TOTAL ** -0.5,
        "w_out": nrm(ks[24], (DEPTH, D, D)) * D ** -0.5,
        "ffn_w1": nrm(ks[25], (DEPTH, D, 2 * D_FF)) * D ** -0.5,
        "ffn_w2": nrm(ks[26], (DEPTH, D_FF, D)) * D_FF ** -0.5,
        "final_g": 1.0 + 0.05 * nrm(ks[27], (D,)),
    }


def reference(x_prompt, x_sample, c_prompt, c_sample, state_conv, state_lru, state_gla,
              norm1_g, norm2_g, ada_w, ada_b, w_in, conv_w, conv_b, lru_wa, lru_ba, lru_wx, lru_bx,
              lru_lambda, gla_wa2, gla_ba, gla_norm_g, proj_a, proj_b, w_out, ffn_w1, ffn_w2, final_g):
    Bp = x_prompt.shape[0]
    dt = x_prompt.dtype
    xp, xs = x_prompt, x_sample
    conv_p, lru_p, gla_p, conv_s, lru_s, gla_s = [], [], [], [], [], []
    for l in range(DEPTH):
        p = (norm1_g[l], norm2_g[l], ada_w[l], ada_b[l], w_in[l], conv_w[l], conv_b[l],
             lru_wa[l], lru_ba[l], lru_wx[l], lru_bx[l], lru_lambda[l], gla_wa2[l], gla_ba[l],
             gla_norm_g[l], proj_a[l], proj_b[l], w_out[l], ffn_w1[l], ffn_w2[l])
        xp, cb, hT, ST = _layer(xp, c_prompt,
                                jnp.zeros((Bp, CONV_W - 1, D_RNN), dt),
                                jnp.zeros((Bp, D_RNN), dt),
                                jnp.zeros((Bp, GLA_HEADS, GLA_DK, GLA_DV), dt), *p)
        conv_p.append(cb); lru_p.append(hT); gla_p.append(ST)
        xs, cb, hT, ST = _layer(xs, c_sample, state_conv[l], state_lru[l], state_gla[l], *p)
        conv_s.append(cb); lru_s.append(hT); gla_s.append(ST)
    y_prompt = _rmsnorm(xp, final_g).astype(x_prompt.dtype)
    y_sample = _rmsnorm(xs, final_g).astype(x_sample.dtype)
    return (y_prompt, y_sample, jnp.stack(conv_p), jnp.stack(lru_p), jnp.stack(gla_p),
            jnp.stack(conv_s), jnp.stack(lru_s), jnp.stack(gla_s))
```

```cpp
#include <hip/hip_runtime.h>
#include <hip/hip_cooperative_groups.h>
#include <cstdio>
#include <cstdint>
namespace cg = cooperative_groups;

constexpr int D = 1024, MP = 16384, MS = 512, M = MP + MS, NB = 136, SEQ = 2048;
constexpr int DR = 1280, DKT = 512, DVT = 1024, DFF = 2816, NINP = 7936, NMOD = 6144;
constexpr int X0 = 0, G0 = 1280, Q0 = 2560, K0 = 3072, V0 = 3584, R0 = 4608, GA0 = 5632, GB0 = 6656, LR0 = 7680;
constexpr float EPS = 1e-6f;

namespace pg8 {
#define PG8_LAS __attribute__((address_space(3)))
typedef unsigned short bf16_t;
typedef short bf16x8 __attribute__((ext_vector_type(8)));
typedef float f32x4 __attribute__((ext_vector_type(4)));
typedef unsigned u32x4 __attribute__((ext_vector_type(4)));
constexpr int BM = 256, BK = 64, HALF = 128, HTB = HALF * BK * 2  , STAGE_BYTES = 8 * HTB, NXCD = 8, WGM = 8;

__host__ __device__ __forceinline__ int lds_byte(int r, int c) { const int st = (r >> 4) * 2 + (c >> 5), rr = r & 15, cc = c & 31, ob = rr * 64 + cc * 2; return st * 1024 + (ob ^ (((ob >> 9) & 1) << 5)); }
__host__ __device__ __forceinline__ void stage_rc(int b, int& R, int& C) { const int st = b / 1024, sb = b % 1024, swz = sb ^ (((sb >> 9) & 1) << 5); R = (st >> 1) * 16 + swz / 64; C = (st & 1) * 32 + (swz % 64) / 2; }
__host__ __device__ __forceinline__ int perm32(int rho) { const int n = rho >> 4, i = rho & 15; return 8 * (i >> 2) + 4 * n + (i & 3); }

struct Unit { int pm, pn; };
struct Gemm { const bf16_t* A; const bf16_t* Bt; int M, N, K, lda, ldb; };

struct StaticOrder {
    int nM, nN, nwg, G, c;
    __host__ __device__ void init(int M, int N, int G_, int c_) { nM = M / BM; nN = N / BM; nwg = nM * nN; G = G_; c = c_; }
    __host__ __device__ bool next(int i, Unit& u) const {
        const long L = (long)i * G + c; if (L >= nwg) return false;
        int wgid = (int)L; { const int q = nwg / NXCD, r = nwg % NXCD, xcd = wgid % NXCD, off = wgid / NXCD; wgid = (xcd < r ? xcd * (q + 1) : r * (q + 1) + (xcd - r) * q) + off; }
        const int nig = WGM * nN, gid = wgid / nig, fm = gid * WGM, gsz = (nM - fm) < WGM ? (nM - fm) : WGM;
        u.pm = fm + ((wgid % nig) % gsz); u.pn = (wgid % nig) / gsz; return true;
    }
    __device__ __forceinline__ void a_ready(const Unit&) const {}
    __device__ __forceinline__ void done(const Unit&) const {}
};


typedef __bf16 bf16x2_t __attribute__((ext_vector_type(2)));
typedef float f32x2_t __attribute__((ext_vector_type(2)));
typedef unsigned u32x2 __attribute__((ext_vector_type(2)));
__device__ __forceinline__ unsigned cvtpk(float lo, float hi) { f32x2_t v = {lo, hi}; bf16x2_t b = __builtin_convertvector(v, bf16x2_t); return __builtin_bit_cast(unsigned, b); }
__device__ __forceinline__ float bflo(unsigned w) { return __uint_as_float(w << 16); }
__device__ __forceinline__ float bfhi(unsigned w) { return __uint_as_float(w & 0xffff0000u); }
__device__ __forceinline__ float bf2f(bf16_t h) { return __uint_as_float(((unsigned)h) << 16); }
__device__ __forceinline__ float fsigmoid(float z) { return __builtin_amdgcn_rcpf(1.0f + __builtin_amdgcn_exp2f(-1.4426950408889634f * z)); }
__device__ __forceinline__ float fexp(float z) { return __builtin_amdgcn_exp2f(1.4426950408889634f * z); }
__device__ __forceinline__ float act_apply(float x, int mode) {
    if (mode == 1) { const float z = 1.5957691216057308f * (x + 0.044715f * x * x * x); return x * fsigmoid(z); }
    if (mode == 2) return x * 0.08838834764831845f;
    if (mode == 3) return x * fsigmoid(x);
    if (mode == 4) return fsigmoid(x);
    return x;
}
__device__ __forceinline__ int row_batch(int row) { return row < MP ? (row >> 11) : 8 + ((row - MP) >> 2); }

struct EpiWin {
    static constexpr bool PERM = true, AFTER_DRAIN = false;
    bf16_t* U;
    __device__ __forceinline__ void operator()(const f32x4 (&acc)[2][2][4][2], const Unit& u, int wr, int wc, int fr, int fq) const {
        const int row0 = u.pm * BM + wr * 64 + fr, colt = u.pn * BM;
        int mode = 0;
        if (colt >= G0 && colt < Q0) mode = 1; else if (colt >= Q0 && colt < K0) mode = 2; else if (colt >= R0 && colt < GA0) mode = 3; else if (colt >= GA0 && colt < LR0) mode = 4;
        const int col0 = colt + wc * 32 + 8 * fq;
#pragma unroll
        for (int ai = 0; ai < 2; ++ai)
#pragma unroll
            for (int m = 0; m < 4; ++m) { bf16_t* rowp = U + (size_t)(row0 + ai * HALF + m * 16) * NINP + col0;
#pragma unroll
                for (int bj = 0; bj < 2; ++bj) { f32x4 v0 = acc[ai][bj][m][0], v1 = acc[ai][bj][m][1];
#pragma unroll
                    for (int e = 0; e < 4; ++e) { v0[e] = act_apply(v0[e], mode); v1[e] = act_apply(v1[e], mode); }
                    u32x4 w; w.x = cvtpk(v0[0], v0[1]); w.y = cvtpk(v0[2], v0[3]); w.z = cvtpk(v1[0], v1[1]); w.w = cvtpk(v1[2], v1[3]);
                    *(u32x4*)(rowp + bj * HALF) = w; }
                __builtin_amdgcn_sched_barrier(0); }
    }
};
struct EpiProj {
    static constexpr bool PERM = true, AFTER_DRAIN = false;
    const bf16_t* U; float* P; bf16_t* Mo; int second;
    __device__ __forceinline__ void operator()(const f32x4 (&acc)[2][2][4][2], const Unit& u, int wr, int wc, int fr, int fq) const {
        const int row0 = u.pm * BM + wr * 64 + fr, col0 = u.pn * BM + wc * 32 + 8 * fq; const int goff = second ? GB0 : GA0;
#pragma unroll
        for (int ai = 0; ai < 2; ++ai)
#pragma unroll
            for (int m = 0; m < 4; ++m) { const int row = row0 + ai * HALF + m * 16;
#pragma unroll
                for (int bj = 0; bj < 2; ++bj) { const int col = col0 + bj * HALF;
                    const u32x4 gw = *(const u32x4*)(U + (size_t)row * NINP + goff + col);
                    f32x4 g0 = {bflo(gw.x), bfhi(gw.x), bflo(gw.y), bfhi(gw.y)}, g1 = {bflo(gw.z), bfhi(gw.z), bflo(gw.w), bfhi(gw.w)};
                    f32x4 v0 = acc[ai][bj][m][0] * g0, v1 = acc[ai][bj][m][1] * g1;
                    float* pp = P + (size_t)row * D + col;
                    if (!second) { *(f32x4*)pp = v0; *(f32x4*)(pp + 4) = v1; }
                    else { v0 += *(const f32x4*)pp; v1 += *(const f32x4*)(pp + 4);
                        u32x4 w; w.x = cvtpk(v0[0], v0[1]); w.y = cvtpk(v0[2], v0[3]); w.z = cvtpk(v1[0], v1[1]); w.w = cvtpk(v1[2], v1[3]);
                        *(u32x4*)(Mo + (size_t)row * D + col) = w; } }
                __builtin_amdgcn_sched_barrier(0); }
    }
};
struct EpiRes {
    static constexpr bool PERM = false, AFTER_DRAIN = false;
    const float* base_p; const float* base_s; float* out; const float* gate;
    __device__ __forceinline__ void operator()(const f32x4 (&acc)[2][2][4][2], const Unit& u, int wr, int wc, int fr, int fq) const {
        const int row0 = u.pm * BM + wr * 64 + fr, col0 = u.pn * BM + wc * 32 + 4 * fq;
#pragma unroll
        for (int ai = 0; ai < 2; ++ai)
#pragma unroll
            for (int m = 0; m < 4; ++m) { const int row = row0 + ai * HALF + m * 16; const float* bp = row < MP ? base_p + (size_t)row * D : base_s + (size_t)(row - MP) * D;
                const float* gp = gate + (size_t)row_batch(row) * NMOD; float* op = out + (size_t)row * D;
#pragma unroll
                for (int bj = 0; bj < 2; ++bj)
#pragma unroll
                    for (int n = 0; n < 2; ++n) { const int col = col0 + bj * HALF + n * 16;
                        const f32x4 b = *(const f32x4*)(bp + col), g = *(const f32x4*)(gp + col);
                        *(f32x4*)(op + col) = b + g * acc[ai][bj][m][n]; }
                __builtin_amdgcn_sched_barrier(0); }
    }
};
struct EpiSwiglu {
    static constexpr bool PERM = true, AFTER_DRAIN = false;
    bf16_t* O;
    __device__ __forceinline__ void operator()(const f32x4 (&acc)[2][2][4][2], const Unit& u, int wr, int wc, int fr, int fq) const {
        const int row0 = u.pm * BM + wr * 64 + fr, col0 = u.pn * HALF + wc * 32 + 8 * fq;
#pragma unroll
        for (int ai = 0; ai < 2; ++ai)
#pragma unroll
            for (int m = 0; m < 4; ++m) { f32x4 v0, v1;
#pragma unroll
                for (int e = 0; e < 4; ++e) { const float a0 = acc[ai][0][m][0][e], a1 = acc[ai][0][m][1][e]; v0[e] = a0 * fsigmoid(a0) * acc[ai][1][m][0][e]; v1[e] = a1 * fsigmoid(a1) * acc[ai][1][m][1][e]; }
                u32x4 w; w.x = cvtpk(v0[0], v0[1]); w.y = cvtpk(v0[2], v0[3]); w.z = cvtpk(v1[0], v1[1]); w.w = cvtpk(v1[2], v1[3]);
                *(u32x4*)(O + (size_t)(row0 + ai * HALF + m * 16) * DFF + col0) = w;
                __builtin_amdgcn_sched_barrier(0); }
    }
};
struct EpiMod {
    static constexpr bool PERM = false, AFTER_DRAIN = false;
    float* out; const float* bias;
    __device__ __forceinline__ void operator()(const f32x4 (&acc)[2][2][4][2], const Unit& u, int wr, int wc, int fr, int fq) const {
        const int row0 = u.pm * BM + wr * 64 + fr, col0 = u.pn * BM + wc * 32 + 4 * fq;
#pragma unroll
        for (int ai = 0; ai < 2; ++ai)
#pragma unroll
            for (int m = 0; m < 4; ++m) { const int row = row0 + ai * HALF + m * 16; if (row < NB) {
#pragma unroll
                for (int bj = 0; bj < 2; ++bj)
#pragma unroll
                    for (int n = 0; n < 2; ++n) { const int col = col0 + bj * HALF + n * 16;
                        *(f32x4*)(out + (size_t)row * NMOD + col) = acc[ai][bj][m][n] + *(const f32x4*)(bias + col); } } }
    }
};

template <class Epi, class Sched, bool ALIGN_EPI = false, bool SP2 = false>
__device__ __forceinline__ void gemm_phase(PG8_LAS unsigned char* lds, const Gemm g, const Sched& S, const Epi& E) {
    int tid_ = threadIdx.x; asm volatile("" : "+v"(tid_));
    const int tid = tid_, wid = __builtin_amdgcn_readfirstlane(tid >> 6), lane = tid & 63, wr = wid >> 2, wc = wid & 3, fr = lane & 15, fq = lane >> 4;
    const int K = g.K, nt = K / BK;
    unsigned voffA[2], voffB[2];
#pragma unroll
    for (int i = 0; i < 2; ++i) { int R, C; stage_rc(tid * 16 + i * 8192, R, C); const int Rb = Epi::PERM ? ((R & ~31) + perm32(R & 31)) : R;
        voffA[i] = (unsigned)(R * g.lda + C) * 2u; voffB[i] = (unsigned)(Rb * g.ldb + C) * 2u; }
    const size_t kstep = (size_t)(BK * 2);
    const size_t hstepA = (size_t)HALF * g.lda * 2, hstepB = (size_t)HALF * g.ldb * 2;
    const size_t tstepA = 2 * hstepA, tstepB = 2 * hstepB;
    const unsigned ldsw = (unsigned)wid * 1024u;
    const int aoff = lds_byte(wr * 64 + fr, fq * 8), boff = lds_byte(wc * 32 + fr, fq * 8);
#define PG8_SA(b, h) (((b) * 2 + (h)) * HTB)
#define PG8_SB(b, h) ((4 + (b) * 2 + (h)) * HTB)
#define PG8_STAGE(bufoff, gbase, voff) do { _Pragma("unroll") for (int _i = 0; _i < 2; ++_i) \
        __builtin_amdgcn_global_load_lds((const unsigned*)((const char*)(gbase) + (voff)[_i]), (PG8_LAS unsigned*)(lds + (bufoff) + ldsw + _i * 8192), 16, 0, 0); } while (0)
#define PG8_LDA(dst, b, h) do { _Pragma("unroll") for (int m = 0; m < 4; ++m) _Pragma("unroll") for (int k = 0; k < 2; ++k) dst[m][k] = *(const PG8_LAS bf16x8*)(lds + PG8_SA(b, h) + aoff + m * 2048 + k * 1024); } while (0)
#define PG8_LDB(dst, b, h) do { _Pragma("unroll") for (int n = 0; n < 2; ++n) _Pragma("unroll") for (int k = 0; k < 2; ++k) dst[n][k] = *(const PG8_LAS bf16x8*)(lds + PG8_SB(b, h) + boff + n * 2048 + k * 1024); } while (0)
#define PG8_MMA(ai, bj, At, Bt) do { __builtin_amdgcn_s_setprio(1); _Pragma("unroll") for (int m = 0; m < 4; ++m) _Pragma("unroll") for (int n = 0; n < 2; ++n) _Pragma("unroll") for (int k = 0; k < 2; ++k) \
        acc[ai][bj][m][n] = __builtin_amdgcn_mfma_f32_16x16x32_bf16(Bt[n][k], At[m][k], acc[ai][bj][m][n], 0, 0, 0); __builtin_amdgcn_s_setprio(0); } while (0)
#define PG8_WAIT_V(n) asm volatile("s_waitcnt vmcnt(" #n ")" ::: "memory")
#define PG8_WAIT_L(n) asm volatile("s_waitcnt lgkmcnt(" #n ")" ::: "memory")
#define PG8_BAR __builtin_amdgcn_s_barrier()
#define PG8_SCHED __builtin_amdgcn_sched_barrier(0)
    Unit cur, nxt; int ui = 0;
    if (!S.next(0, cur)) return;
    f32x4 acc[2][2][4][2];
#pragma unroll
    for (int a = 0; a < 2; ++a)
#pragma unroll
        for (int b = 0; b < 2; ++b)
#pragma unroll
            for (int m = 0; m < 4; ++m)
#pragma unroll
                for (int n = 0; n < 2; ++n) acc[a][b][m][n] = (f32x4){0.f, 0.f, 0.f, 0.f};
    bf16x8 At[4][2], B0[2][2], B1[2][2];
    const char* cA = (const char*)g.A + (size_t)cur.pm * tstepA; const char* cB = (const char*)g.Bt + (size_t)cur.pn * tstepB;
    S.a_ready(cur);
    if constexpr (SP2) {
        PG8_STAGE(PG8_SB(0, 0), cB, voffB); PG8_STAGE(PG8_SB(0, 1), cB + hstepB, voffB); PG8_STAGE(PG8_SA(0, 0), cA, voffA); PG8_STAGE(PG8_SA(0, 1), cA + hstepA, voffA);
        if (wr == 1) PG8_BAR;
        PG8_WAIT_V(2); PG8_BAR;
        PG8_STAGE(PG8_SB(1, 0), cB + kstep, voffB); PG8_STAGE(PG8_SA(1, 0), cA + kstep, voffA); PG8_STAGE(PG8_SB(1, 1), cB + hstepB + kstep, voffB);
        PG8_WAIT_V(6); PG8_BAR;
    } else {
        PG8_STAGE(PG8_SB(0, 0), cB, voffB); PG8_STAGE(PG8_SA(0, 0), cA, voffA); PG8_STAGE(PG8_SB(0, 1), cB + hstepB, voffB); PG8_STAGE(PG8_SA(0, 1), cA + hstepA, voffA);
        if (wr == 1) PG8_BAR;
        PG8_WAIT_V(4); PG8_BAR;
        PG8_STAGE(PG8_SB(1, 0), cB + kstep, voffB); PG8_STAGE(PG8_SA(1, 0), cA + kstep, voffA); PG8_STAGE(PG8_SB(1, 1), cB + hstepB + kstep, voffB);
        PG8_WAIT_V(6); PG8_BAR;
    }
    for (;;) {
        const bool has_next = S.next(ui + 1, nxt);
        const char* nA = has_next ? (const char*)g.A + (size_t)nxt.pm * tstepA : cA; const char* nB = has_next ? (const char*)g.Bt + (size_t)nxt.pn * tstepB : cB;
        for (int t = 0; t < nt; t += 2) {
            const bool last = (t == nt - 2);
            const char* a1 = cA + (size_t)(t + 1) * kstep;
            const char* a2 = last ? nA : cA + (size_t)(t + 2) * kstep; const char* b2 = last ? nB : cB + (size_t)(t + 2) * kstep;
            const char* a3 = a2 + kstep; const char* b3 = b2 + kstep;
            if (last && has_next) S.a_ready(nxt);
            if constexpr (SP2) {
            PG8_LDB(B0, 0, 0); PG8_LDB(B1, 0, 1); PG8_SCHED; PG8_LDA(At, 0, 0); PG8_STAGE(PG8_SA(1, 1), a1 + hstepA, voffA);
            PG8_WAIT_V(8); PG8_WAIT_L(0); PG8_BAR; PG8_MMA(0, 0, At, B0); PG8_MMA(0, 1, At, B1); PG8_BAR; PG8_SCHED;
            PG8_LDA(At, 0, 1); PG8_STAGE(PG8_SB(0, 0), b2, voffB); PG8_STAGE(PG8_SB(0, 1), b2 + hstepB, voffB); PG8_STAGE(PG8_SA(0, 0), a2, voffA);
            PG8_WAIT_V(8); PG8_WAIT_L(0); PG8_BAR; PG8_MMA(1, 0, At, B0); PG8_MMA(1, 1, At, B1); PG8_BAR; PG8_SCHED;
            PG8_LDB(B0, 1, 0); PG8_LDB(B1, 1, 1); PG8_SCHED; PG8_LDA(At, 1, 0); PG8_STAGE(PG8_SA(0, 1), a2 + hstepA, voffA);
            PG8_WAIT_V(8); PG8_WAIT_L(0); PG8_BAR; PG8_MMA(0, 0, At, B0); PG8_MMA(0, 1, At, B1); PG8_BAR; PG8_SCHED;
            PG8_LDA(At, 1, 1); PG8_STAGE(PG8_SB(1, 0), b3, voffB); PG8_STAGE(PG8_SB(1, 1), b3 + hstepB, voffB); PG8_STAGE(PG8_SA(1, 0), a3, voffA);
            PG8_WAIT_V(8); PG8_WAIT_L(0); PG8_BAR; PG8_MMA(1, 0, At, B0); PG8_MMA(1, 1, At, B1); PG8_BAR; PG8_SCHED;
            } else {
            PG8_LDB(B0, 0, 0); PG8_SCHED; PG8_LDA(At, 0, 0); PG8_STAGE(PG8_SA(1, 1), a1 + hstepA, voffA);
            PG8_WAIT_L(8); PG8_BAR; PG8_WAIT_L(0); PG8_MMA(0, 0, At, B0); PG8_BAR; PG8_SCHED;
            PG8_LDB(B1, 0, 1); PG8_STAGE(PG8_SB(0, 0), b2, voffB);
            PG8_BAR; PG8_WAIT_L(0); PG8_MMA(0, 1, At, B1); PG8_BAR;
            PG8_LDA(At, 0, 1); PG8_STAGE(PG8_SA(0, 0), a2, voffA);
            PG8_BAR; PG8_WAIT_L(0); PG8_MMA(1, 0, At, B0); PG8_BAR; PG8_SCHED;
            PG8_STAGE(PG8_SB(0, 1), b2 + hstepB, voffB);
            PG8_WAIT_V(6); PG8_BAR; PG8_MMA(1, 1, At, B1); PG8_BAR;
            PG8_LDB(B0, 1, 0); PG8_SCHED; PG8_LDA(At, 1, 0); PG8_STAGE(PG8_SA(0, 1), a2 + hstepA, voffA);
            PG8_WAIT_L(8); PG8_BAR; PG8_WAIT_L(0); PG8_MMA(0, 0, At, B0); PG8_BAR; PG8_SCHED;
            PG8_LDB(B1, 1, 1); PG8_STAGE(PG8_SB(1, 0), b3, voffB);
            PG8_BAR; PG8_WAIT_L(0); PG8_MMA(0, 1, At, B1); PG8_BAR;
            PG8_LDA(At, 1, 1); PG8_STAGE(PG8_SA(1, 0), a3, voffA);
            PG8_BAR; PG8_WAIT_L(0); PG8_MMA(1, 0, At, B0); PG8_BAR; PG8_SCHED;
            PG8_STAGE(PG8_SB(1, 1), b3 + hstepB, voffB);
            PG8_WAIT_V(6); PG8_BAR; PG8_MMA(1, 1, At, B1); PG8_BAR;
            }
        }
        if constexpr (ALIGN_EPI) { if (wr == 0) PG8_BAR; }
        if constexpr (!Epi::AFTER_DRAIN) { E(acc, cur, wr, wc, fr, fq); S.done(cur); }
        if (!has_next) break;
#pragma unroll
        for (int a = 0; a < 2; ++a)
#pragma unroll
            for (int b = 0; b < 2; ++b)
#pragma unroll
                for (int m = 0; m < 4; ++m)
#pragma unroll
                    for (int n = 0; n < 2; ++n) acc[a][b][m][n] = (f32x4){0.f, 0.f, 0.f, 0.f};
        cur = nxt; cA = nA; cB = nB; ++ui;
        if constexpr (ALIGN_EPI) { if (wr == 1) PG8_BAR; }
    }
    PG8_WAIT_V(0);
    if constexpr (!ALIGN_EPI) { if (wr == 0) PG8_BAR; }
    PG8_BAR;
    if constexpr (Epi::AFTER_DRAIN) { E.fused(acc, cur, wr, wc, fr, fq, lds, wid, lane); S.done(cur); }
#undef PG8_SA
#undef PG8_SB
#undef PG8_STAGE
#undef PG8_LDA
#undef PG8_LDB
#undef PG8_MMA
#undef PG8_WAIT_V
#undef PG8_WAIT_L
#undef PG8_BAR
#undef PG8_SCHED
}
}

#define LAS __attribute__((address_space(3)))
typedef unsigned short bf16;
typedef float f32x4 __attribute__((ext_vector_type(4)));
typedef short bf16x8 __attribute__((ext_vector_type(8)));
typedef short bf16x4 __attribute__((ext_vector_type(4)));
typedef unsigned u32x4 __attribute__((ext_vector_type(4)));
typedef unsigned u32x2 __attribute__((ext_vector_type(2)));
using pg8::cvtpk; using pg8::bflo; using pg8::bfhi; using pg8::bf2f; using pg8::fsigmoid; using pg8::fexp; using pg8::row_batch;
constexpr int NWAVES = 8, NTHR = 512, LDS_BYTES = 147456;
constexpr size_t MiB = 1u << 20;
constexpr size_t WS_WIN = 1 * MiB;
constexpr size_t SZ_WIN = (size_t)NINP * D * 2;
constexpr size_t WS_WPJ = WS_WIN + 2 * SZ_WIN;
constexpr size_t SZ_WPJ = (size_t)D * (DR + DVT) * 2;
constexpr size_t WS_WOUT = WS_WPJ + 2 * SZ_WPJ;
constexpr size_t SZ_WOUT = (size_t)D * D * 2;
constexpr size_t WS_W1 = WS_WOUT + 2 * SZ_WOUT;
constexpr size_t SZ_W1 = (size_t)2 * DFF * D * 2;
constexpr size_t WS_W2 = WS_W1 + 2 * SZ_W1;
constexpr size_t SZ_W2 = (size_t)D * DFF * 2;
constexpr size_t WS_ADA = WS_W2 + 2 * SZ_W2;
constexpr size_t SZ_ADA = (size_t)NMOD * D * 2;
constexpr size_t WS_WG = WS_ADA + 2 * SZ_ADA;
constexpr size_t SZ_WG = (size_t)10 * 256 * 128 * 2;
constexpr size_t WS_CS = WS_WG + 2 * SZ_WG;
constexpr size_t WS_MOD = WS_CS + (size_t)256 * D * 2;
constexpr size_t SZ_MOD = (size_t)NB * NMOD * 4;
constexpr size_t WS_HN = ((WS_MOD + 2 * SZ_MOD + MiB - 1) / MiB) * MiB;
constexpr size_t WS_U = WS_HN + (size_t)M * D * 2;
constexpr size_t WS_P = WS_U + (size_t)M * NINP * 2;
constexpr size_t WS_END = WS_P + (size_t)M * D * 4;

struct Args {
    const float* in[28]; float* out; unsigned char* ws; int ph_lo, ph_hi;
};
constexpr size_t O_Y = 0, O_CONVP = (size_t)M * D, O_LRUP = O_CONVP + 2 * 8 * 3 * DR, O_GLAP = O_LRUP + 2 * 8 * DR, O_CONVS = O_GLAP + (size_t)2 * 8 * 4 * 128 * 256,
                 O_LRUS = O_CONVS + (size_t)2 * 128 * 3 * DR, O_GLAS = O_LRUS + (size_t)2 * 128 * DR, O_END = O_GLAS + (size_t)2 * 128 * 4 * 128 * 256;

__device__ __forceinline__ float bperm(int srclane, float v) { return __int_as_float(__builtin_amdgcn_ds_bpermute(srclane << 2, __float_as_int(v))); }
__device__ __forceinline__ float wave_sum(float v, int lane) {
#pragma unroll
    for (int o = 1; o < 64; o <<= 1) v += bperm(lane ^ o, v);
    return v;
}
__device__ __forceinline__ int src_col(int np, int mapmode) {
    if (mapmode == 1) { if (np < GA0) return np; if (np < LR0) return np + 16; if (np < LR0 + 16) return np - LR0 + 5632; return -1; }
    if (mapmode == 2) { const int pn = np >> 8, bj = (np >> 7) & 1, j = np & 127; return bj * DFF + pn * 128 + j; }
    return np;
}
__device__ __forceinline__ void transpose_item(const float* W, int K, int N, bf16* WT, int ldt, int koff, int nblk, int mapmode, LAS float* scr, int item, int lane) {
    const int kb = item / nblk, nb = item % nblk, k0 = 64 * kb, n0 = 32 * nb;
    const int sc = src_col(n0 + (lane & 31), mapmode);
#pragma unroll 8
    for (int i = 0; i < 32; ++i) { const int kk = 2 * i + (lane >> 5); scr[kk * 33 + (lane & 31)] = sc >= 0 ? W[(size_t)(k0 + kk) * N + sc] : 0.f; }
    asm volatile("s_waitcnt lgkmcnt(0)" ::: "memory");
    const int c = lane & 7;
#pragma unroll
    for (int j = 0; j < 4; ++j) { const int n = (lane >> 3) + 8 * j; const LAS float* s = scr + (8 * c) * 33 + n;
        u32x4 o; o.x = cvtpk(s[0 * 33], s[1 * 33]); o.y = cvtpk(s[2 * 33], s[3 * 33]); o.z = cvtpk(s[4 * 33], s[5 * 33]); o.w = cvtpk(s[6 * 33], s[7 * 33]);
        *(u32x4*)(WT + (size_t)(n0 + n) * ldt + koff + k0 + 8 * c) = o; }
    asm volatile("s_waitcnt lgkmcnt(0)" ::: "memory");
}
__device__ __forceinline__ void norm_row(const float* xrow, const float* g, const float* sc, const float* sh, bf16* orow, float* orow_f, int lane) {
    const f32x4* xr = (const f32x4*)xrow + lane; f32x4 v[4]; float s = 0.f;
#pragma unroll
    for (int j = 0; j < 4; ++j) { v[j] = xr[64 * j]; s += (v[j].x * v[j].x + v[j].y * v[j].y) + (v[j].z * v[j].z + v[j].w * v[j].w); }
    const float rstd = 1.0f / sqrtf(wave_sum(s, lane) * (1.0f / D) + EPS);
#pragma unroll
    for (int j = 0; j < 4; ++j) { const int col = 4 * lane + 256 * j; const f32x4 gg = *(const f32x4*)(g + col);
        f32x4 o = v[j] * rstd * gg;
        if (orow_f) { *(f32x4*)(orow_f + col) = o; }
        else { const f32x4 a = *(const f32x4*)(sc + col), b = *(const f32x4*)(sh + col); o = o * (a + 1.0f) + b;
            u32x2 w; w.x = cvtpk(o.x, o.y); w.y = cvtpk(o.z, o.w); *(u32x2*)(orow + col) = w; } }
}

struct ScanP { int l; };
typedef const float* fptr_t;
__device__ __forceinline__ fptr_t inp(int i) {
    const __attribute__((address_space(4))) unsigned char* kp = (const __attribute__((address_space(4))) unsigned char*)__builtin_amdgcn_kernarg_segment_ptr();
    asm volatile("" : "+s"(kp));
    return *(const __attribute__((address_space(4))) fptr_t*)(kp + 8 * i);
}
#define WSP ((unsigned char*)inp(29))
#define OUTP ((float*)inp(28))
__device__ __forceinline__ bf16 f2bf1(float x) { return (bf16)(cvtpk(x, 0.f) & 0xffffu); }
#define MFMA16(a, b, c) __builtin_amdgcn_mfma_f32_16x16x32_bf16((a), (b), (c), 0, 0, 0)

template <bool SAMPLE>
__device__ __forceinline__ void lru_item(LAS unsigned char* lds, const ScanP& P, int item) {
    int tid_ = threadIdx.x; asm volatile("" : "+v"(tid_));
    const int tid = tid_, lane = tid & 63, w = __builtin_amdgcn_readfirstlane(tid >> 6), fr = lane & 15, fq = lane >> 4;
    const int n = item % 10, bb = item / 10;
    const int row0 = SAMPLE ? MP + bb * 64 : bb * SEQ;
    const int nch = SAMPLE ? 1 : SEQ / 64;
    LAS bf16* XC = (LAS bf16*)lds;
    const int l = P.l; bf16* const U = (bf16*)(WSP + WS_U);
    const bf16* wg = (const bf16*)(WSP + WS_WG + l * SZ_WG) + (size_t)n * 256 * 128;
    bf16x8 Bw[2][4];
#pragma unroll
    for (int nt = 0; nt < 2; ++nt)
#pragma unroll
        for (int ks = 0; ks < 4; ++ks) Bw[nt][ks] = *(const bf16x8*)(wg + (size_t)(nt * 128 + 16 * w + fr) * 128 + 32 * ks + 8 * fq);
    const int ch = n * 128 + 16 * w + fr;
    const float ba = (inp(15) + (size_t)l * DR)[ch], bx = (inp(17) + (size_t)l * DR)[ch], lam = (inp(18) + (size_t)l * DR)[ch];
    const float cl = -8.0f * log1pf(expf(-lam));
    const int cg = tid & 15, tt = tid >> 4, cch = n * 128 + 8 * cg;
    float cw[4][8], cb[8];
#pragma unroll
    for (int i = 0; i < 4; ++i)
#pragma unroll
        for (int j = 0; j < 8; ++j) cw[i][j] = (inp(12) + (size_t)l * 4 * DR)[i * DR + cch + j];
#pragma unroll
    for (int j = 0; j < 8; ++j) cb[j] = (inp(13) + (size_t)l * DR)[cch + j];
    const float* const st_conv = SAMPLE ? inp(4) + (size_t)l * 128 * 3 * DR : nullptr; const float* const st_lru = SAMPLE ? inp(5) + (size_t)l * 128 * DR : nullptr;
    float* const o_lru_s = OUTP + O_LRUS + (size_t)l * 128 * DR;
    float hc = 0.f;
    for (int c = 0; c < nch; ++c) {
        const int r0 = row0 + c * 64;
#pragma unroll
        for (int p = 0; p < 2; ++p) {
            const int tl = tt + 32 * p; float xc[8];
#pragma unroll
            for (int j = 0; j < 8; ++j) xc[j] = cb[j];
#pragma unroll
            for (int d = 0; d < 4; ++d) {
                float uv[8];
                bool from_u, zero = false;
                if (!SAMPLE) { from_u = (c * 64 + tl - d) >= 0; zero = !from_u; } else { from_u = ((tl & 3) - d) >= 0; }
                if (from_u) { const u32x4 q = *(const u32x4*)(U + (size_t)(r0 + tl - d) * NINP + X0 + cch);
                    uv[0] = bflo(q.x); uv[1] = bfhi(q.x); uv[2] = bflo(q.y); uv[3] = bfhi(q.y); uv[4] = bflo(q.z); uv[5] = bfhi(q.z); uv[6] = bflo(q.w); uv[7] = bfhi(q.w); }
                else if (zero) {
#pragma unroll
                    for (int j = 0; j < 8; ++j) uv[j] = 0.f; }
                else { const int b = bb * 16 + (tl >> 2); const float* sp = st_conv + ((size_t)b * 3 + (3 + (tl & 3) - d)) * DR + cch;
                    const f32x4 s0 = *(const f32x4*)sp, s1 = *(const f32x4*)(sp + 4);
                    uv[0] = s0.x; uv[1] = s0.y; uv[2] = s0.z; uv[3] = s0.w; uv[4] = s1.x; uv[5] = s1.y; uv[6] = s1.z; uv[7] = s1.w; }
#pragma unroll
                for (int j = 0; j < 8; ++j) xc[j] += cw[3 - d][j] * uv[j];
            }
            u32x4 o; o.x = cvtpk(xc[0], xc[1]); o.y = cvtpk(xc[2], xc[3]); o.z = cvtpk(xc[4], xc[5]); o.w = cvtpk(xc[6], xc[7]);
            *(LAS u32x4*)(XC + tl * 136 + 8 * cg) = o;
        }
        __syncthreads();
        f32x4 acc[4][2];
#pragma unroll
        for (int mt = 0; mt < 4; ++mt) { acc[mt][0] = (f32x4){0.f, 0.f, 0.f, 0.f}; acc[mt][1] = (f32x4){0.f, 0.f, 0.f, 0.f};
#pragma unroll
            for (int ks = 0; ks < 4; ++ks) { const bf16x8 a = *(const LAS bf16x8*)(XC + (16 * mt + fr) * 136 + 32 * ks + 8 * fq);
                acc[mt][0] = MFMA16(a, Bw[0][ks], acc[mt][0]); acc[mt][1] = MFMA16(a, Bw[1][ks], acc[mt][1]); } }
#pragma unroll
        for (int mt = 0; mt < 4; ++mt) {
            float Pe[4], Qe[4];
#pragma unroll
            for (int e = 0; e < 4; ++e) { const int tl = 16 * mt + 4 * fq + e;
                const float r = fsigmoid(acc[mt][0][e] + ba), ii = fsigmoid(acc[mt][1][e] + bx), la = cl * r, a = fexp(la), x2 = 2.0f * la;
                const float om = (x2 > -0.1f) ? -x2 * (1.0f + x2 * (0.5f + x2 * (0.16666667f + x2 * 0.041666668f))) : 1.0f - a * a;
                const float xcv = bf2f(XC[tl * 136 + 16 * w + fr]), bv = sqrtf(om) * ii * xcv;
                if (e == 0) { Pe[0] = a; Qe[0] = bv; } else { Pe[e] = a * Pe[e - 1]; Qe[e] = a * Qe[e - 1] + bv; } }
            float hin;
            if (!SAMPLE) {
                float Pi = Pe[3], Qi = Qe[3];
                { const float Pp = bperm(lane - 16, Pi), Qp = bperm(lane - 16, Qi); if (fq >= 1) { Qi = Pi * Qp + Qi; Pi = Pi * Pp; } }
                { const float Pp = bperm(lane - 32, Pi), Qp = bperm(lane - 32, Qi); if (fq >= 2) { Qi = Pi * Qp + Qi; Pi = Pi * Pp; } }
                float Px = bperm(lane - 16, Pi), Qx = bperm(lane - 16, Qi); if (fq == 0) { Px = 1.f; Qx = 0.f; }
                hin = Px * hc + Qx;
            } else { hin = st_lru[(size_t)(bb * 16 + 4 * mt + fq) * DR + ch]; }
            float hv[4];
#pragma unroll
            for (int e = 0; e < 4; ++e) hv[e] = Pe[e] * hin + Qe[e];
            if (!SAMPLE) hc = bperm(48 + fr, hv[3]); else o_lru_s[(size_t)(bb * 16 + 4 * mt + fq) * DR + ch] = hv[3];
#pragma unroll
            for (int e = 0; e < 4; ++e) { bf16* gp = U + (size_t)(r0 + 16 * mt + 4 * fq + e) * NINP + G0 + ch; *gp = f2bf1(hv[e] * bf2f(*gp)); }
        }
        __syncthreads();
    }
    if (!SAMPLE) {
        if (fq == 0) (OUTP + O_LRUP + (size_t)l * 8 * DR)[(size_t)bb * DR + ch] = hc;
        if (tid < 384) { const int j = tid >> 7, cc = tid & 127; (OUTP + O_CONVP + (size_t)l * 8 * 3 * DR)[((size_t)bb * 3 + j) * DR + n * 128 + cc] = bf2f(U[(size_t)(row0 + SEQ - 3 + j) * NINP + X0 + n * 128 + cc]); }
    } else {
        for (int idx = tid; idx < 6144; idx += NTHR) { const int s = idx / 384, rem = idx % 384, j = rem >> 7, cc = rem & 127;
            (OUTP + O_CONVS + (size_t)l * 128 * 3 * DR)[((size_t)(bb * 16 + s) * 3 + j) * DR + n * 128 + cc] = bf2f(U[(size_t)(row0 + 4 * s + 1 + j) * NINP + X0 + n * 128 + cc]); }
    }
}

__device__ __forceinline__ void gla_item(LAS unsigned char* lds, const ScanP& P, int h, int row_base, int T, const float* S0, float* ST) {
    int tid_ = threadIdx.x; asm volatile("" : "+v"(tid_));
    const int tid = tid_, lane = tid & 63, w = __builtin_amdgcn_readfirstlane(tid >> 6), fr = lane & 15, fq = lane >> 4;
    LAS bf16* Qs = (LAS bf16*)lds; LAS bf16* Ks = (LAS bf16*)(lds + 17408); LAS bf16* KDT = (LAS bf16*)(lds + 34816); LAS bf16* VT = (LAS bf16*)(lds + 53248);
    LAS bf16* ATT = (LAS bf16*)(lds + 90112); LAS float* TOT = (LAS float*)(lds + 99328); LAS float* EL = (LAS float*)(lds + 101376); LAS float* SS = (LAS float*)(lds + 101888); LAS float* LRS = (LAS float*)(lds + 103936);
    const int c = tid & 127, tg = tid >> 7;
    float wa2c[16];
#pragma unroll
    for (int r = 0; r < 16; ++r) wa2c[r] = (inp(19) + (size_t)P.l * 16 * DKT)[r * DKT + h * 128 + c];
    const float gba = (inp(20) + (size_t)P.l * DKT)[h * 128 + c];
    bf16* const U = (bf16*)(WSP + WS_U); const float* const gnorm = inp(21) + (size_t)P.l * DVT;
    f32x4 S[8][2];
#pragma unroll
    for (int kt = 0; kt < 8; ++kt)
#pragma unroll
        for (int vt = 0; vt < 2; ++vt)
#pragma unroll
            for (int e = 0; e < 4; ++e) { S[kt][vt][e] = S0 ? S0[(size_t)(16 * kt + 4 * fq + e) * 256 + 32 * w + 16 * vt + fr] : 0.f; if (e == 3 && vt == 1 && (kt & 1)) __builtin_amdgcn_sched_barrier(0); }
    const int nch = (T + 63) >> 6;
    for (int chn = 0; chn < nch; ++chn) {
        const int r0 = row_base + chn * 64; const int nv = (T - chn * 64) < 64 ? (T - chn * 64) : 64;
        if (tid < 128) { const int t = tid >> 1, hf = tid & 1; u32x4 a = {0u, 0u, 0u, 0u};
            if (t < nv) a = *(const u32x4*)(U + (size_t)(r0 + t) * NINP + LR0 + 8 * hf);
            const f32x4 l0 = {bflo(a.x), bfhi(a.x), bflo(a.y), bfhi(a.y)}, l1 = {bflo(a.z), bfhi(a.z), bflo(a.w), bfhi(a.w)};
            *(LAS f32x4*)(LRS + t * 16 + 8 * hf) = l0; *(LAS f32x4*)(LRS + t * 16 + 8 * hf + 4) = l1; }
        __syncthreads();
        float bc[16]; float run = 0.f;
#pragma unroll
        for (int i = 0; i < 16; ++i) { const int t = 16 * tg + i; float g = 0.f;
            if (t < nv) { const LAS f32x4* lp = (const LAS f32x4*)(LRS + t * 16); const f32x4 a = lp[0], b = lp[1], cc = lp[2], d = lp[3];
                float pre = gba;
                pre += wa2c[0] * a.x + wa2c[1] * a.y + wa2c[2] * a.z + wa2c[3] * a.w + wa2c[4] * b.x + wa2c[5] * b.y + wa2c[6] * b.z + wa2c[7] * b.w;
                pre += wa2c[8] * cc.x + wa2c[9] * cc.y + wa2c[10] * cc.z + wa2c[11] * cc.w + wa2c[12] * d.x + wa2c[13] * d.y + wa2c[14] * d.z + wa2c[15] * d.w;
                g = (fminf(pre, 0.f) - __logf(1.0f + fexp(-fabsf(pre)))) * 0.0625f; }
            run += g; bc[i] = run; }
        TOT[tg * 128 + c] = run;
        __syncthreads();
        float off = 0.f, blast = 0.f;
#pragma unroll
        for (int j = 0; j < 4; ++j) { const float v = TOT[j * 128 + c]; blast += v; if (j < tg) off += v; }
        float kdv[16];
#pragma unroll
        for (int i = 0; i < 16; ++i) { const int t = 16 * tg + i; const float bci = bc[i] + off; float qv = 0.f, kv = 0.f;
            if (t < nv) { const bf16* up = U + (size_t)(r0 + t) * NINP + h * 128 + c; qv = bf2f(up[Q0]); kv = bf2f(up[K0]); }
            Qs[t * 136 + c] = f2bf1(qv * fexp(bci)); Ks[t * 136 + c] = f2bf1(kv * fexp(-bci)); kdv[i] = kv * fexp(blast - bci);
            if ((i & 3) == 3) __builtin_amdgcn_sched_barrier(0); }
        { u32x4 k0, k1; k0.x = cvtpk(kdv[0], kdv[1]); k0.y = cvtpk(kdv[2], kdv[3]); k0.z = cvtpk(kdv[4], kdv[5]); k0.w = cvtpk(kdv[6], kdv[7]);
          k1.x = cvtpk(kdv[8], kdv[9]); k1.y = cvtpk(kdv[10], kdv[11]); k1.z = cvtpk(kdv[12], kdv[13]); k1.w = cvtpk(kdv[14], kdv[15]);
          *(LAS u32x4*)(KDT + c * 72 + 16 * tg) = k0; *(LAS u32x4*)(KDT + c * 72 + 16 * tg + 8) = k1; }
        if (tg == 0) EL[c] = fexp(blast);
#pragma unroll
        for (int p = 0; p < 4; ++p) { const int vg = w * 4 + p, t = lane; u32x4 vv = {0u, 0u, 0u, 0u};
            if (t < nv) vv = *(const u32x4*)(U + (size_t)(r0 + t) * NINP + V0 + h * 256 + 8 * vg);
            LAS bf16* vp = VT + (8 * vg) * 72 + t;
            vp[0] = (bf16)(vv.x & 0xffffu); vp[72] = (bf16)(vv.x >> 16); vp[144] = (bf16)(vv.y & 0xffffu); vp[216] = (bf16)(vv.y >> 16);
            vp[288] = (bf16)(vv.z & 0xffffu); vp[360] = (bf16)(vv.z >> 16); vp[432] = (bf16)(vv.w & 0xffffu); vp[504] = (bf16)(vv.w >> 16); }
        __syncthreads();
        { const int it = w >> 1;
#pragma unroll
          for (int jj = 0; jj < 2; ++jj) { const int jt = (w & 1) * 2 + jj; f32x4 a4 = {0.f, 0.f, 0.f, 0.f};
#pragma unroll
            for (int ks = 0; ks < 4; ++ks) { const bf16x8 a = *(const LAS bf16x8*)(Ks + (16 * jt + fr) * 136 + 32 * ks + 8 * fq), b = *(const LAS bf16x8*)(Qs + (16 * it + fr) * 136 + 32 * ks + 8 * fq);
                a4 = MFMA16(a, b, a4); }
            const int i = 16 * it + fr;
#pragma unroll
            for (int e = 0; e < 4; ++e) if (16 * jt + 4 * fq + e > i) a4[e] = 0.f;
            u32x2 o2; o2.x = cvtpk(a4[0], a4[1]); o2.y = cvtpk(a4[2], a4[3]);
            *(LAS u32x2*)(ATT + i * 72 + 16 * jt + 4 * fq) = o2; } }
        __syncthreads();
        f32x4 o[4][2];
#pragma unroll
        for (int it = 0; it < 4; ++it) {
            bf16x8 qa[4], aa[2];
#pragma unroll
            for (int ks = 0; ks < 4; ++ks) { const u32x2 lo = *(const LAS u32x2*)(Qs + (16 * it + fr) * 136 + 32 * ks + 4 * fq), hi = *(const LAS u32x2*)(Qs + (16 * it + fr) * 136 + 32 * ks + 16 + 4 * fq);
                u32x4 q4; q4.x = lo.x; q4.y = lo.y; q4.z = hi.x; q4.w = hi.y; qa[ks] = __builtin_bit_cast(bf16x8, q4); }
#pragma unroll
            for (int js = 0; js < 2; ++js) if (2 * js <= it) aa[js] = *(const LAS bf16x8*)(ATT + (16 * it + fr) * 72 + 32 * js + 8 * fq);
#pragma unroll
            for (int vt = 0; vt < 2; ++vt) { f32x4 oo = {0.f, 0.f, 0.f, 0.f};
#pragma unroll
                for (int js = 0; js < 2; ++js) if (2 * js <= it) { const bf16x8 b = *(const LAS bf16x8*)(VT + (32 * w + 16 * vt + fr) * 72 + 32 * js + 8 * fq); oo = MFMA16(aa[js], b, oo); }
#pragma unroll
                for (int ks = 0; ks < 4; ++ks) { u32x4 pk; const f32x4 s0 = S[2 * ks][vt], s1 = S[2 * ks + 1][vt];
                    pk.x = cvtpk(s0[0], s0[1]); pk.y = cvtpk(s0[2], s0[3]); pk.z = cvtpk(s1[0], s1[1]); pk.w = cvtpk(s1[2], s1[3]);
                    oo = MFMA16(qa[ks], __builtin_bit_cast(bf16x8, pk), oo); }
                o[it][vt] = oo; }
            __builtin_amdgcn_sched_barrier(0);
        }
#pragma unroll
        for (int kt = 0; kt < 8; ++kt) { const f32x4 el = *(const LAS f32x4*)(EL + 16 * kt + 4 * fq); S[kt][0] *= el; S[kt][1] *= el; }
#pragma unroll
        for (int vt = 0; vt < 2; ++vt)
#pragma unroll
            for (int js = 0; js < 2; ++js) { const bf16x8 b = *(const LAS bf16x8*)(VT + (32 * w + 16 * vt + fr) * 72 + 32 * js + 8 * fq);
#pragma unroll
                for (int kt = 0; kt < 8; ++kt) { const bf16x8 a = *(const LAS bf16x8*)(KDT + (16 * kt + fr) * 72 + 32 * js + 8 * fq); S[kt][vt] = MFMA16(a, b, S[kt][vt]); }
                __builtin_amdgcn_sched_barrier(0); }
#pragma unroll
        for (int it = 0; it < 4; ++it)
#pragma unroll
            for (int e = 0; e < 4; ++e) { float p = o[it][0][e] * o[it][0][e] + o[it][1][e] * o[it][1][e];
                p += bperm(lane ^ 1, p); p += bperm(lane ^ 2, p); p += bperm(lane ^ 4, p); p += bperm(lane ^ 8, p);
                if (fr == 0) SS[w * 64 + 16 * it + 4 * fq + e] = p; }
        __syncthreads();
#pragma unroll
        for (int it = 0; it < 4; ++it)
#pragma unroll
            for (int e = 0; e < 4; ++e) { const int row = 16 * it + 4 * fq + e; float tot = 0.f;
#pragma unroll
                for (int ww = 0; ww < 8; ++ww) tot += SS[ww * 64 + row];
                const float rstd = 1.0f / sqrtf(tot * (1.0f / 256.0f) + EPS);
                if (row < nv) {
#pragma unroll
                    for (int vt = 0; vt < 2; ++vt) { const int col = h * 256 + 32 * w + 16 * vt + fr; bf16* rp = U + (size_t)(r0 + row) * NINP + R0 + col;
                        *rp = f2bf1(o[it][vt][e] * rstd * gnorm[col] * bf2f(*rp)); } }
                if (e == 3) __builtin_amdgcn_sched_barrier(0); }
        __syncthreads();
    }
#pragma unroll
    for (int kt = 0; kt < 8; ++kt)
#pragma unroll
        for (int vt = 0; vt < 2; ++vt)
#pragma unroll
            for (int e = 0; e < 4; ++e) { ST[(size_t)(16 * kt + 4 * fq + e) * 256 + 32 * w + 16 * vt + fr] = S[kt][vt][e]; if (e == 3 && vt == 1) __builtin_amdgcn_sched_barrier(0); }
}

constexpr int N_PHASES = 19;
__global__ void __launch_bounds__(NTHR, 2) fwd(Args args) {
    extern __shared__ __attribute__((aligned(16))) unsigned char lds_raw[];
    LAS unsigned char* lds = (LAS unsigned char*)lds_raw;
    cg::grid_group grid = cg::this_grid();
    const int G = gridDim.x, bx = blockIdx.x;
#define PHASE_LOCALS int t_ = threadIdx.x; asm volatile("" : "+v"(t_)); const int tid = t_, lane = tid & 63, wave = __builtin_amdgcn_readfirstlane(tid >> 6), gw = bx * NWAVES + wave, NGW = G * NWAVES; (void)tid; (void)lane; (void)gw; (void)NGW;
#define ws WSP
#define X (OUTP + O_Y)
#define HN ((bf16*)(WSP + WS_HN))
#define U ((bf16*)(WSP + WS_U))
#define FF ((bf16*)(WSP + WS_U))
#define PB ((float*)(WSP + WS_P))
#define MOD ((float*)(WSP + WS_MOD))
#define CS ((bf16*)(WSP + WS_CS))
    const int lo = args.ph_lo, hi = args.ph_hi;
#ifndef SCM
#define SCM 15
#endif
#ifndef DBG_MASK
#define DBG_MASK 0x7ffff
#endif
#define PHON(k) ((DBG_MASK >> ((k) < 10 ? (k) : (k) - 8)) & 1)
#define IN(k) (lo <= (k) && (k) < hi)
#define SEAM(k) do { if (lo <= (k) && (k) + 1 < hi) grid.sync(); } while (0)

    if (PHON(0) && IN(0)) {
        PHASE_LOCALS
        LAS float* scr = (LAS float*)(lds + wave * 16384);
        constexpr int I_WIN = 16 * 248, I_PA = 20 * 32, I_PB = 16 * 32, I_WO = 16 * 32, I_W1 = 16 * 176, I_W2 = 44 * 32, I_ADA = 16 * 192;
        constexpr int I_L = I_WIN + I_PA + I_PB + I_WO + I_W1 + I_W2 + I_ADA;
        for (int it = gw; it < 2 * I_L; it += NGW) {
            const int l = it / I_L; int r = it % I_L;
            if (r < I_WIN) { transpose_item(inp(11) + (size_t)l * D * 7696, D, 7696, (bf16*)(ws + WS_WIN + l * SZ_WIN), D, 0, 248, 1, scr, r, lane); continue; } r -= I_WIN;
            if (r < I_PA) { transpose_item(inp(22) + (size_t)l * DR * D, DR, D, (bf16*)(ws + WS_WPJ + l * SZ_WPJ), DR + DVT, 0, 32, 0, scr, r, lane); continue; } r -= I_PA;
            if (r < I_PB) { transpose_item(inp(23) + (size_t)l * DVT * D, DVT, D, (bf16*)(ws + WS_WPJ + l * SZ_WPJ), DR + DVT, DR, 32, 0, scr, r, lane); continue; } r -= I_PB;
            if (r < I_WO) { transpose_item(inp(24) + (size_t)l * D * D, D, D, (bf16*)(ws + WS_WOUT + l * SZ_WOUT), D, 0, 32, 0, scr, r, lane); continue; } r -= I_WO;
            if (r < I_W1) { transpose_item(inp(25) + (size_t)l * D * 2 * DFF, D, 2 * DFF, (bf16*)(ws + WS_W1 + l * SZ_W1), D, 0, 176, 2, scr, r, lane); continue; } r -= I_W1;
            if (r < I_W2) { transpose_item(inp(26) + (size_t)l * DFF * D, DFF, D, (bf16*)(ws + WS_W2 + l * SZ_W2), DFF, 0, 32, 0, scr, r, lane); continue; } r -= I_W2;
            transpose_item(inp(9) + (size_t)l * D * NMOD, D, NMOD, (bf16*)(ws + WS_ADA + l * SZ_ADA), D, 0, 192, 0, scr, r, lane);
        }
        bf16* WG = (bf16*)(ws + WS_WG);
        for (int idx = bx * NTHR + tid; idx < 2 * 10 * 256 * 128; idx += G * NTHR) {
            const int l = idx / 327680, r = idx % 327680, n = r >> 15, vv = (r >> 7) & 255, wi = r & 127;
            const float* src = (vv < 128 ? inp(14) : inp(16)) + ((size_t)(l * 10 + n) * 128 + wi) * 128 + (vv & 127);
            WG[idx] = f2bf1(*src);
        }
        for (int idx = bx * NTHR + tid; idx < 256 * D; idx += G * NTHR) {
            const int row = idx >> 10, col = idx & 1023; float v = 0.f;
            if (row < 8) v = inp(2)[row * D + col]; else if (row < NB) v = inp(3)[(row - 8) * D + col];
            CS[idx] = f2bf1(v * fsigmoid(v));
        }
    }
    SEAM(0);
    if (PHON(1) && IN(1)) {
        for (int l = 0; l < 2; ++l) {
            pg8::Gemm g{CS, (const bf16*)(ws + WS_ADA + l * SZ_ADA), 256, NMOD, D, D, D}; pg8::StaticOrder S; S.init(256, NMOD, G, (bx + 128 * l) % G);
            pg8::EpiMod E{MOD + (size_t)l * NB * NMOD, inp(10) + (size_t)l * NMOD};
            pg8::gemm_phase<pg8::EpiMod, pg8::StaticOrder, true, true>(lds, g, S, E);
        }
    }
    SEAM(1);
    for (int l = 0; l < 2; ++l) {
        const int pb = 2 + 8 * l;
#define modl (MOD + (size_t)l * NB * NMOD)
        if (PHON(2) && IN(pb)) {
            PHASE_LOCALS
            for (int row = gw; row < M; row += NGW) {
                const float* xr = l == 0 ? (row < MP ? inp(0) + (size_t)row * D : inp(1) + (size_t)(row - MP) * D) : X + (size_t)row * D;
                const float* mb = modl + (size_t)row_batch(row) * NMOD;
                norm_row(xr, inp(7) + l * D, mb + 1024, mb, HN + (size_t)row * D, nullptr, lane);
            }
        }
        SEAM(pb);
        if (PHON(3) && IN(pb + 1)) {
            pg8::Gemm g{HN, (const bf16*)(ws + WS_WIN + l * SZ_WIN), M, NINP, D, D, D}; pg8::StaticOrder S; S.init(M, NINP, G, bx);
            pg8::EpiWin E{U};
            pg8::gemm_phase<pg8::EpiWin, pg8::StaticOrder, true, true>(lds, g, S, E);
        }
        SEAM(pb + 1);
        if (PHON(4) && IN(pb + 2)) {
            ScanP P; P.l = l;
            float* const o_gla_p = OUTP + O_GLAP + (size_t)l * 8 * 4 * 32768; float* const o_gla_s = OUTP + O_GLAS + (size_t)l * 128 * 4 * 32768;
#ifndef DBG_NOSCAN
            if (bx < 32) { const int b = bx >> 2, h = bx & 3; if (SCM & 1) gla_item(lds, P, h, b * SEQ, SEQ, nullptr, o_gla_p + (size_t)(b * 4 + h) * 32768); }
            else if (bx < 112) { if (SCM & 2) lru_item<false>(lds, P, bx - 32); }
            else {
                for (int j = bx - 112; j < 592; j += (G - 112)) {
                    if (j < 512) { const int b = j >> 2, h = j & 3; if (SCM & 4) gla_item(lds, P, h, MP + b * 4, 4, inp(6) + (size_t)l * 128 * 4 * 32768 + (size_t)(b * 4 + h) * 32768, o_gla_s + (size_t)(b * 4 + h) * 32768); }
                    else if (SCM & 8) lru_item<true>(lds, P, j - 512);
                }
            }
#endif
        }
        SEAM(pb + 2);
        if (PHON(5) && IN(pb + 3)) {
            const bf16* wpj = (const bf16*)(ws + WS_WPJ + l * SZ_WPJ);
            { pg8::Gemm g{U + G0, wpj, M, D, DR, NINP, DR + DVT}; pg8::StaticOrder S; S.init(M, D, G, bx); pg8::EpiProj E{U, PB, HN, 0};
              pg8::gemm_phase<pg8::EpiProj, pg8::StaticOrder, true, true>(lds, g, S, E); }
            { pg8::Gemm g{U + R0, wpj + DR, M, D, DVT, NINP, DR + DVT}; pg8::StaticOrder S; S.init(M, D, G, bx); pg8::EpiProj E{U, PB, HN, 1};
              pg8::gemm_phase<pg8::EpiProj, pg8::StaticOrder, true, true>(lds, g, S, E); }
        }
        SEAM(pb + 3);
        if (PHON(6) && IN(pb + 4)) {
            pg8::Gemm g{HN, (const bf16*)(ws + WS_WOUT + l * SZ_WOUT), M, D, D, D, D}; pg8::StaticOrder S; S.init(M, D, G, bx);
            pg8::EpiRes E{l == 0 ? inp(0) : X, l == 0 ? inp(1) : X + (size_t)MP * D, X, modl + 2048};
            pg8::gemm_phase<pg8::EpiRes, pg8::StaticOrder, true, true>(lds, g, S, E);
        }
        SEAM(pb + 4);
        if (PHON(7) && IN(pb + 5)) {
            PHASE_LOCALS
            for (int row = gw; row < M; row += NGW) {
                const float* mb = modl + (size_t)row_batch(row) * NMOD;
                norm_row(X + (size_t)row * D, inp(8) + l * D, mb + 4096, mb + 3072, HN + (size_t)row * D, nullptr, lane);
            }
        }
        SEAM(pb + 5);
        if (PHON(8) && IN(pb + 6)) {
            pg8::Gemm g{HN, (const bf16*)(ws + WS_W1 + l * SZ_W1), M, 2 * DFF, D, D, D}; pg8::StaticOrder S; S.init(M, 2 * DFF, G, bx);
            pg8::EpiSwiglu E{FF};
            pg8::gemm_phase<pg8::EpiSwiglu, pg8::StaticOrder, true, true>(lds, g, S, E);
        }
        SEAM(pb + 6);
        if (PHON(9) && IN(pb + 7)) {
            pg8::Gemm g{FF, (const bf16*)(ws + WS_W2 + l * SZ_W2), M, D, DFF, DFF, DFF}; pg8::StaticOrder S; S.init(M, D, G, bx);
            pg8::EpiRes E{X, X + (size_t)MP * D, X, modl + 5120};
            pg8::gemm_phase<pg8::EpiRes, pg8::StaticOrder, true, true>(lds, g, S, E);
        }
        SEAM(pb + 7);
    }
    if (PHON(10) && IN(18)) {
        PHASE_LOCALS
        for (int row = gw; row < M; row += NGW) norm_row(X + (size_t)row * D, inp(27), nullptr, nullptr, nullptr, X + (size_t)row * D, lane);
    }
#undef IN
#undef SEAM
#undef ws
#undef X
#undef HN
#undef U
#undef FF
#undef PB
#undef MOD
#undef CS
#undef modl
}

#ifndef MK_SPLIT
#define MK_SPLIT 0
#endif
extern "C" void kernel_launch(void* const* d_in, const int* in_sizes, int n_in, void* d_out, int out_size, void* d_ws, size_t ws_size, hipStream_t stream) {
    static int grid = 0;
    if (grid == 0) {
        if (n_in != 28 || (size_t)out_size != O_END || ws_size < WS_END) { fprintf(stderr, "kernel_launch: unexpected shapes (n_in %d, out %d, ws %zu, need %zu); nothing launched\n", n_in, out_size, ws_size, (size_t)WS_END); grid = -1; return; }
        int dev = 0, cus = 0, per_cu = 0;
        (void)hipGetDevice(&dev); (void)hipDeviceGetAttribute(&cus, hipDeviceAttributeMultiprocessorCount, dev);
        if (hipFuncSetAttribute((const void*)fwd, hipFuncAttributeMaxDynamicSharedMemorySize, LDS_BYTES) != hipSuccess) { fprintf(stderr, "kernel_launch: hipFuncSetAttribute failed\n"); grid = -1; return; }
        if (hipOccupancyMaxActiveBlocksPerMultiprocessor(&per_cu, (const void*)fwd, NTHR, LDS_BYTES) != hipSuccess || per_cu < 1) { fprintf(stderr, "kernel_launch: occupancy query says %d\n", per_cu); per_cu = 1; }
        (void)hipGetLastError();
        grid = 256;
        if (cus * per_cu < 256) { fprintf(stderr, "kernel_launch: device holds only %d x %d workgroups; this kernel needs 256 co-resident\n", cus, per_cu); grid = -1; return; }
    }
    if (grid < 0) return;
    Args a{};
    for (int i = 0; i < 28; ++i) a.in[i] = (const float*)d_in[i];
    a.out = (float*)d_out; a.ws = (unsigned char*)d_ws;
#if MK_SPLIT
    for (int p = 0; p < N_PHASES; ++p) { a.ph_lo = p; a.ph_hi = p + 1; void* kargs[] = {&a};
        hipError_t e = hipLaunchCooperativeKernel((const void*)fwd, dim3(grid), dim3(NTHR), kargs, LDS_BYTES, stream);
        if (e != hipSuccess) { fprintf(stderr, "kernel_launch: launch failed: %s\n", hipGetErrorString(e)); break; } }
#else
    a.ph_lo = 0; a.ph_hi = N_PHASES; void* kargs[] = {&a};
    hipError_t e = hipLaunchCooperativeKernel((const void*)fwd, dim3(grid), dim3(NTHR), kargs, LDS_BYTES, stream);
    if (e != hipSuccess) fprintf(stderr, "kernel_launch: cooperative launch failed: %s (grid %d)\n", hipGetErrorString(e), grid);
#endif
}
```

```cpp
#include <hip/hip_runtime.h>
#include <hip/hip_cooperative_groups.h>
#include <cstdio>
#include <cstdint>
namespace cg = cooperative_groups;

constexpr int D = 1024, MP = 16384, MS = 512, M = MP + MS, NB = 136, SEQ = 2048;
constexpr int DR = 1280, DKT = 512, DVT = 1024, DFF = 2816, NINP = 7936, NMOD = 6144;
constexpr int X0 = 0, G0 = 1280, Q0 = 2560, K0 = 3072, V0 = 3584, R0 = 4608, GA0 = 5632, GB0 = 6656, LR0 = 7680;
constexpr float EPS = 1e-6f;

namespace pg8 {
#define PG8_LAS __attribute__((address_space(3)))
typedef unsigned short bf16_t;
typedef short bf16x8 __attribute__((ext_vector_type(8)));
typedef float f32x4 __attribute__((ext_vector_type(4)));
typedef unsigned u32x4 __attribute__((ext_vector_type(4)));
constexpr int BM = 256, BK = 64, HALF = 128, HTB = HALF * BK * 2  , STAGE_BYTES = 8 * HTB, NXCD = 8, WGM = 8;

__host__ __device__ __forceinline__ int lds_byte(int r, int c) { const int st = (r >> 4) * 2 + (c >> 5), rr = r & 15, cc = c & 31, ob = rr * 64 + cc * 2; return st * 1024 + (ob ^ (((ob >> 9) & 1) << 5)); }
__host__ __device__ __forceinline__ void stage_rc(int b, int& R, int& C) { const int st = b / 1024, sb = b % 1024, swz = sb ^ (((sb >> 9) & 1) << 5); R = (st >> 1) * 16 + swz / 64; C = (st & 1) * 32 + (swz % 64) / 2; }
__host__ __device__ __forceinline__ int perm32(int rho) { const int n = rho >> 4, i = rho & 15; return 8 * (i >> 2) + 4 * n + (i & 3); }

struct Unit { int pm, pn; };
struct Gemm { const bf16_t* A; const bf16_t* Bt; int M, N, K, lda, ldb; };

struct StaticOrder {
    int nM, nN, nwg, G, c;
    __host__ __device__ void init(int M, int N, int G_, int c_) { nM = M / BM; nN = N / BM; nwg = nM * nN; G = G_; c = c_; }
    __host__ __device__ bool next(int i, Unit& u) const {
        const long L = (long)i * G + c; if (L >= nwg) return false;
        int wgid = (int)L; { const int q = nwg / NXCD, r = nwg % NXCD, xcd = wgid % NXCD, off = wgid / NXCD; wgid = (xcd < r ? xcd * (q + 1) : r * (q + 1) + (xcd - r) * q) + off; }
        const int nig = WGM * nN, gid = wgid / nig, fm = gid * WGM, gsz = (nM - fm) < WGM ? (nM - fm) : WGM;
        u.pm = fm + ((wgid % nig) % gsz); u.pn = (wgid % nig) / gsz; return true;
    }
    __device__ __forceinline__ void a_ready(const Unit&) const {}
    __device__ __forceinline__ void done(const Unit&) const {}
};


typedef __bf16 bf16x2_t __attribute__((ext_vector_type(2)));
typedef float f32x2_t __attribute__((ext_vector_type(2)));
typedef unsigned u32x2 __attribute__((ext_vector_type(2)));
__device__ __forceinline__ unsigned cvtpk(float lo, float hi) { f32x2_t v = {lo, hi}; bf16x2_t b = __builtin_convertvector(v, bf16x2_t); return __builtin_bit_cast(unsigned, b); }
__device__ __forceinline__ float bflo(unsigned w) { return __uint_as_float(w << 16); }
__device__ __forceinline__ float bfhi(unsigned w) { return __uint_as_float(w & 0xffff0000u); }
__device__ __forceinline__ float bf2f(bf16_t h) { return __uint_as_float(((unsigned)h) << 16); }
__device__ __forceinline__ float fsigmoid(float z) { return __builtin_amdgcn_rcpf(1.0f + __builtin_amdgcn_exp2f(-1.4426950408889634f * z)); }
__device__ __forceinline__ float fexp(float z) { return __builtin_amdgcn_exp2f(1.4426950408889634f * z); }
__device__ __forceinline__ float act_apply(float x, int mode) {
    if (mode == 1) { const float z = 1.5957691216057308f * (x + 0.044715f * x * x * x); return x * fsigmoid(z); }
    if (mode == 2) return x * 0.08838834764831845f;
    if (mode == 3) return x * fsigmoid(x);
    if (mode == 4) return fsigmoid(x);
    return x;
}
__device__ __forceinline__ int row_batch(int row) { return row < MP ? (row >> 11) : 8 + ((row - MP) >> 2); }

struct EpiWin {
    static constexpr bool PERM = true, AFTER_DRAIN = false;
    bf16_t* U;
    __device__ __forceinline__ void operator()(const f32x4 (&acc)[2][2][4][2], const Unit& u, int wr, int wc, int fr, int fq) const {
        const int row0 = u.pm * BM + wr * 64 + fr, colt = u.pn * BM;
        int mode = 0;
        if (colt >= G0 && colt < Q0) mode = 1; else if (colt >= Q0 && colt < K0) mode = 2; else if (colt >= R0 && colt < GA0) mode = 3; else if (colt >= GA0 && colt < LR0) mode = 4;
        const int col0 = colt + wc * 32 + 8 * fq;
#pragma unroll
        for (int ai = 0; ai < 2; ++ai)
#pragma unroll
            for (int m = 0; m < 4; ++m) { bf16_t* rowp = U + (size_t)(row0 + ai * HALF + m * 16) * NINP + col0;
#pragma unroll
                for (int bj = 0; bj < 2; ++bj) { f32x4 v0 = acc[ai][bj][m][0], v1 = acc[ai][bj][m][1];
#pragma unroll
                    for (int e = 0; e < 4; ++e) { v0[e] = act_apply(v0[e], mode); v1[e] = act_apply(v1[e], mode); }
                    u32x4 w; w.x = cvtpk(v0[0], v0[1]); w.y = cvtpk(v0[2], v0[3]); w.z = cvtpk(v1[0], v1[1]); w.w = cvtpk(v1[2], v1[3]);
                    *(u32x4*)(rowp + bj * HALF) = w; }
                __builtin_amdgcn_sched_barrier(0); }
    }
};
struct EpiProj {
    static constexpr bool PERM = true, AFTER_DRAIN = false;
    const bf16_t* U; float* P; bf16_t* Mo; int second;
    __device__ __forceinline__ void operator()(const f32x4 (&acc)[2][2][4][2], const Unit& u, int wr, int wc, int fr, int fq) const {
        const int row0 = u.pm * BM + wr * 64 + fr, col0 = u.pn * BM + wc * 32 + 8 * fq; const int goff = second ? GB0 : GA0;
#pragma unroll
        for (int ai = 0; ai < 2; ++ai)
#pragma unroll
            for (int m = 0; m < 4; ++m) { const int row = row0 + ai * HALF + m * 16;
#pragma unroll
                for (int bj = 0; bj < 2; ++bj) { const int col = col0 + bj * HALF;
                    const u32x4 gw = *(const u32x4*)(U + (size_t)row * NINP + goff + col);
                    f32x4 g0 = {bflo(gw.x), bfhi(gw.x), bflo(gw.y), bfhi(gw.y)}, g1 = {bflo(gw.z), bfhi(gw.z), bflo(gw.w), bfhi(gw.w)};
                    f32x4 v0 = acc[ai][bj][m][0] * g0, v1 = acc[ai][bj][m][1] * g1;
                    float* pp = P + (size_t)row * D + col;
                    if (!second) { *(f32x4*)pp = v0; *(f32x4*)(pp + 4) = v1; }
                    else { v0 += *(const f32x4*)pp; v1 += *(const f32x4*)(pp + 4);
                        u32x4 w; w.x = cvtpk(v0[0], v0[1]); w.y = cvtpk(v0[2], v0[3]); w.z = cvtpk(v1[0], v1[1]); w.w = cvtpk(v1[2], v1[3]);
                        *(u32x4*)(Mo + (size_t)row * D + col) = w; } }
                __builtin_amdgcn_sched_barrier(0); }
    }
};
struct EpiRes {
    static constexpr bool PERM = false, AFTER_DRAIN = false;
    const float* base_p; const float* base_s; float* out; const float* gate;
    __device__ __forceinline__ void operator()(const f32x4 (&acc)[2][2][4][2], const Unit& u, int wr, int wc, int fr, int fq) const {
        const int row0 = u.pm * BM + wr * 64 + fr, col0 = u.pn * BM + wc * 32 + 4 * fq;
#pragma unroll
        for (int ai = 0; ai < 2; ++ai)
#pragma unroll
            for (int m = 0; m < 4; ++m) { const int row = row0 + ai * HALF + m * 16; const float* bp = row < MP ? base_p + (size_t)row * D : base_s + (size_t)(row - MP) * D;
                const float* gp = gate + (size_t)row_batch(row) * NMOD; float* op = out + (size_t)row * D;
#pragma unroll
                for (int bj = 0; bj < 2; ++bj)
#pragma unroll
                    for (int n = 0; n < 2; ++n) { const int col = col0 + bj * HALF + n * 16;
                        const f32x4 b = *(const f32x4*)(bp + col), g = *(const f32x4*)(gp + col);
                        *(f32x4*)(op + col) = b + g * acc[ai][bj][m][n]; }
                __builtin_amdgcn_sched_barrier(0); }
    }
};
struct EpiSwiglu {
    static constexpr bool PERM = true, AFTER_DRAIN = false;
    bf16_t* O;
    __device__ __forceinline__ void operator()(const f32x4 (&acc)[2][2][4][2], const Unit& u, int wr, int wc, int fr, int fq) const {
        const int row0 = u.pm * BM + wr * 64 + fr, col0 = u.pn * HALF + wc * 32 + 8 * fq;
#pragma unroll
        for (int ai = 0; ai < 2; ++ai)
#pragma unroll
            for (int m = 0; m < 4; ++m) { f32x4 v0, v1;
#pragma unroll
                for (int e = 0; e < 4; ++e) { const float a0 = acc[ai][0][m][0][e], a1 = acc[ai][0][m][1][e]; v0[e] = a0 * fsigmoid(a0) * acc[ai][1][m][0][e]; v1[e] = a1 * fsigmoid(a1) * acc[ai][1][m][1][e]; }
                u32x4 w; w.x = cvtpk(v0[0], v0[1]); w.y = cvtpk(v0[2], v0[3]); w.z = cvtpk(v1[0], v1[1]); w.w = cvtpk(v1[2], v1[3]);
                *(u32x4*)(O + (size_t)(row0 + ai * HALF + m * 16) * DFF + col0) = w;
                __builtin_amdgcn_sched_barrier(0); }
    }
};
struct EpiMod {
    static constexpr bool PERM = false, AFTER_DRAIN = false;
    float* out; const float* bias;
    __device__ __forceinline__ void operator()(const f32x4 (&acc)[2][2][4][2], const Unit& u, int wr, int wc, int fr, int fq) const {
        const int row0 = u.pm * BM + wr * 64 + fr, col0 = u.pn * BM + wc * 32 + 4 * fq;
#pragma unroll
        for (int ai = 0; ai < 2; ++ai)
#pragma unroll
            for (int m = 0; m < 4; ++m) { const int row = row0 + ai * HALF + m * 16; if (row < NB) {
#pragma unroll
                for (int bj = 0; bj < 2; ++bj)
#pragma unroll
                    for (int n = 0; n < 2; ++n) { const int col = col0 + bj * HALF + n * 16;
                        *(f32x4*)(out + (size_t)row * NMOD + col) = acc[ai][bj][m][n] + *(const f32x4*)(bias + col); } } }
    }
};

template <class Epi, class Sched, bool ALIGN_EPI = false, bool SP2 = false>
__device__ __forceinline__ void gemm_phase(PG8_LAS unsigned char* lds, const Gemm g, const Sched& S, const Epi& E) {
    int tid_ = threadIdx.x; asm volatile("" : "+v"(tid_));
    const int tid = tid_, wid = __builtin_amdgcn_readfirstlane(tid >> 6), lane = tid & 63, wr = wid >> 2, wc = wid & 3, fr = lane & 15, fq = lane >> 4;
    const int K = g.K, nt = K / BK;
    unsigned voffA[2], voffB[2];
#pragma unroll
    for (int i = 0; i < 2; ++i) { int R, C; stage_rc(tid * 16 + i * 8192, R, C); const int Rb = Epi::PERM ? ((R & ~31) + perm32(R & 31)) : R;
        voffA[i] = (unsigned)(R * g.lda + C) * 2u; voffB[i] = (unsigned)(Rb * g.ldb + C) * 2u; }
    const size_t kstep = (size_t)(BK * 2);
    const size_t hstepA = (size_t)HALF * g.lda * 2, hstepB = (size_t)HALF * g.ldb * 2;
    const size_t tstepA = 2 * hstepA, tstepB = 2 * hstepB;
    const unsigned ldsw = (unsigned)wid * 1024u;
    const int aoff = lds_byte(wr * 64 + fr, fq * 8), boff = lds_byte(wc * 32 + fr, fq * 8);
#define PG8_SA(b, h) (((b) * 2 + (h)) * HTB)
#define PG8_SB(b, h) ((4 + (b) * 2 + (h)) * HTB)
#define PG8_STAGE(bufoff, gbase, voff) do { _Pragma("unroll") for (int _i = 0; _i < 2; ++_i) \
        __builtin_amdgcn_global_load_lds((const unsigned*)((const char*)(gbase) + (voff)[_i]), (PG8_LAS unsigned*)(lds + (bufoff) + ldsw + _i * 8192), 16, 0, 0); } while (0)
#define PG8_LDA(dst, b, h) do { _Pragma("unroll") for (int m = 0; m < 4; ++m) _Pragma("unroll") for (int k = 0; k < 2; ++k) dst[m][k] = *(const PG8_LAS bf16x8*)(lds + PG8_SA(b, h) + aoff + m * 2048 + k * 1024); } while (0)
#define PG8_LDB(dst, b, h) do { _Pragma("unroll") for (int n = 0; n < 2; ++n) _Pragma("unroll") for (int k = 0; k < 2; ++k) dst[n][k] = *(const PG8_LAS bf16x8*)(lds + PG8_SB(b, h) + boff + n * 2048 + k * 1024); } while (0)
#define PG8_MMA(ai, bj, At, Bt) do { __builtin_amdgcn_s_setprio(1); _Pragma("unroll") for (int m = 0; m < 4; ++m) _Pragma("unroll") for (int n = 0; n < 2; ++n) _Pragma("unroll") for (int k = 0; k < 2; ++k) \
        acc[ai][bj][m][n] = __builtin_amdgcn_mfma_f32_16x16x32_bf16(Bt[n][k], At[m][k], acc[ai][bj][m][n], 0, 0, 0); __builtin_amdgcn_s_setprio(0); } while (0)
#define PG8_WAIT_V(n) asm volatile("s_waitcnt vmcnt(" #n ")" ::: "memory")
#define PG8_WAIT_L(n) asm volatile("s_waitcnt lgkmcnt(" #n ")" ::: "memory")
#define PG8_BAR __builtin_amdgcn_s_barrier()
#define PG8_SCHED __builtin_amdgcn_sched_barrier(0)
    Unit cur, nxt; int ui = 0;
    if (!S.next(0, cur)) return;
    f32x4 acc[2][2][4][2];
#pragma unroll
    for (int a = 0; a < 2; ++a)
#pragma unroll
        for (int b = 0; b < 2; ++b)
#pragma unroll
            for (int m = 0; m < 4; ++m)
#pragma unroll
                for (int n = 0; n < 2; ++n) acc[a][b][m][n] = (f32x4){0.f, 0.f, 0.f, 0.f};
    bf16x8 At[4][2], B0[2][2], B1[2][2];
    const char* cA = (const char*)g.A + (size_t)cur.pm * tstepA; const char* cB = (const char*)g.Bt + (size_t)cur.pn * tstepB;
    S.a_ready(cur);
    if constexpr (SP2) {
        PG8_STAGE(PG8_SB(0, 0), cB, voffB); PG8_STAGE(PG8_SB(0, 1), cB + hstepB, voffB); PG8_STAGE(PG8_SA(0, 0), cA, voffA); PG8_STAGE(PG8_SA(0, 1), cA + hstepA, voffA);
        if (wr == 1) PG8_BAR;
        PG8_WAIT_V(2); PG8_BAR;
        PG8_STAGE(PG8_SB(1, 0), cB + kstep, voffB); PG8_STAGE(PG8_SA(1, 0), cA + kstep, voffA); PG8_STAGE(PG8_SB(1, 1), cB + hstepB + kstep, voffB);
        PG8_WAIT_V(6); PG8_BAR;
    } else {
        PG8_STAGE(PG8_SB(0, 0), cB, voffB); PG8_STAGE(PG8_SA(0, 0), cA, voffA); PG8_STAGE(PG8_SB(0, 1), cB + hstepB, voffB); PG8_STAGE(PG8_SA(0, 1), cA + hstepA, voffA);
        if (wr == 1) PG8_BAR;
        PG8_WAIT_V(4); PG8_BAR;
        PG8_STAGE(PG8_SB(1, 0), cB + kstep, voffB); PG8_STAGE(PG8_SA(1, 0), cA + kstep, voffA); PG8_STAGE(PG8_SB(1, 1), cB + hstepB + kstep, voffB);
        PG8_WAIT_V(6); PG8_BAR;
    }
    for (;;) {
        const bool has_next = S.next(ui + 1, nxt);
        const char* nA = has_next ? (const char*)g.A + (size_t)nxt.pm * tstepA : cA; const char* nB = has_next ? (const char*)g.Bt + (size_t)nxt.pn * tstepB : cB;
        for (int t = 0; t < nt; t += 2) {
            const bool last = (t == nt - 2);
            const char* a1 = cA + (size_t)(t + 1) * kstep;
            const char* a2 = last ? nA : cA + (size_t)(t + 2) * kstep; const char* b2 = last ? nB : cB + (size_t)(t + 2) * kstep;
            const char* a3 = a2 + kstep; const char* b3 = b2 + kstep;
            if (last && has_next) S.a_ready(nxt);
            if constexpr (SP2) {
            PG8_LDB(B0, 0, 0); PG8_LDB(B1, 0, 1); PG8_SCHED; PG8_LDA(At, 0, 0); PG8_STAGE(PG8_SA(1, 1), a1 + hstepA, voffA);
            PG8_WAIT_V(8); PG8_WAIT_L(0); PG8_BAR; PG8_MMA(0, 0, At, B0); PG8_MMA(0, 1, At, B1); PG8_BAR; PG8_SCHED;
            PG8_LDA(At, 0, 1); PG8_STAGE(PG8_SB(0, 0), b2, voffB); PG8_STAGE(PG8_SB(0, 1), b2 + hstepB, voffB); PG8_STAGE(PG8_SA(0, 0), a2, voffA);
            PG8_WAIT_V(8); PG8_WAIT_L(0); PG8_BAR; PG8_MMA(1, 0, At, B0); PG8_MMA(1, 1, At, B1); PG8_BAR; PG8_SCHED;
            PG8_LDB(B0, 1, 0); PG8_LDB(B1, 1, 1); PG8_SCHED; PG8_LDA(At, 1, 0); PG8_STAGE(PG8_SA(0, 1), a2 + hstepA, voffA);
            PG8_WAIT_V(8); PG8_WAIT_L(0); PG8_BAR; PG8_MMA(0, 0, At, B0); PG8_MMA(0, 1, At, B1); PG8_BAR; PG8_SCHED;
            PG8_LDA(At, 1, 1); PG8_STAGE(PG8_SB(1, 0), b3, voffB); PG8_STAGE(PG8_SB(1, 1), b3 + hstepB, voffB); PG8_STAGE(PG8_SA(1, 0), a3, voffA);
            PG8_WAIT_V(8); PG8_WAIT_L(0); PG8_BAR; PG8_MMA(1, 0, At, B0); PG8_MMA(1, 1, At, B1); PG8_BAR; PG8_SCHED;
            } else {
            PG8_LDB(B0, 0, 0); PG8_SCHED; PG8_LDA(At, 0, 0); PG8_STAGE(PG8_SA(1, 1), a1 + hstepA, voffA);
            PG8_WAIT_L(8); PG8_BAR; PG8_WAIT_L(0); PG8_MMA(0, 0, At, B0); PG8_BAR; PG8_SCHED;
            PG8_LDB(B1, 0, 1); PG8_STAGE(PG8_SB(0, 0), b2, voffB);
            PG8_BAR; PG8_WAIT_L(0); PG8_MMA(0, 1, At, B1); PG8_BAR;
            PG8_LDA(At, 0, 1); PG8_STAGE(PG8_SA(0, 0), a2, voffA);
            PG8_BAR; PG8_WAIT_L(0); PG8_MMA(1, 0, At, B0); PG8_BAR; PG8_SCHED;
            PG8_STAGE(PG8_SB(0, 1), b2 + hstepB, voffB);
            PG8_WAIT_V(6); PG8_BAR; PG8_MMA(1, 1, At, B1); PG8_BAR;
            PG8_LDB(B0, 1, 0); PG8_SCHED; PG8_LDA(At, 1, 0); PG8_STAGE(PG8_SA(0, 1), a2 + hstepA, voffA);
            PG8_WAIT_L(8); PG8_BAR; PG8_WAIT_L(0); PG8_MMA(0, 0, At, B0); PG8_BAR; PG8_SCHED;
            PG8_LDB(B1, 1, 1); PG8_STAGE(PG8_SB(1, 0), b3, voffB);
            PG8_BAR; PG8_WAIT_L(0); PG8_MMA(0, 1, At, B1); PG8_BAR;
            PG8_LDA(At, 1, 1); PG8_STAGE(PG8_SA(1, 0), a3, voffA);
            PG8_BAR; PG8_WAIT_L(0); PG8_MMA(1, 0, At, B0); PG8_BAR; PG8_SCHED;
            PG8_STAGE(PG8_SB(1, 1), b3 + hstepB, voffB);
            PG8_WAIT_V(6); PG8_BAR; PG8_MMA(1, 1, At, B1); PG8_BAR;
            }
        }
        if constexpr (ALIGN_EPI) { if (wr == 0) PG8_BAR; }
        if constexpr (!Epi::AFTER_DRAIN) { E(acc, cur, wr, wc, fr, fq); S.done(cur); }
        if (!has_next) break;
#pragma unroll
        for (int a = 0; a < 2; ++a)
#pragma unroll
            for (int b = 0; b < 2; ++b)
#pragma unroll
                for (int m = 0; m < 4; ++m)
#pragma unroll
                    for (int n = 0; n < 2; ++n) acc[a][b][m][n] = (f32x4){0.f, 0.f, 0.f, 0.f};
        cur = nxt; cA = nA; cB = nB; ++ui;
        if constexpr (ALIGN_EPI) { if (wr == 1) PG8_BAR; }
    }
    PG8_WAIT_V(0);
    if constexpr (!ALIGN_EPI) { if (wr == 0) PG8_BAR; }
    PG8_BAR;
    if constexpr (Epi::AFTER_DRAIN) { E.fused(acc, cur, wr, wc, fr, fq, lds, wid, lane); S.done(cur); }
#undef PG8_SA
#undef PG8_SB
#undef PG8_STAGE
#undef PG8_LDA
#undef PG8_LDB
#undef PG8_MMA
#undef PG8_WAIT_V
#undef PG8_WAIT_L
#undef PG8_BAR
#undef PG8_SCHED
}
}

#define LAS __attribute__((address_space(3)))
typedef unsigned short bf16;
typedef float f32x4 __attribute__((ext_vector_type(4)));
typedef short bf16x8 __attribute__((ext_vector_type(8)));
typedef short bf16x4 __attribute__((ext_vector_type(4)));
typedef unsigned u32x4 __attribute__((ext_vector_type(4)));
typedef unsigned u32x2 __attribute__((ext_vector_type(2)));
using pg8::cvtpk; using pg8::bflo; using pg8::bfhi; using pg8::bf2f; using pg8::fsigmoid; using pg8::fexp; using pg8::row_batch;
constexpr int NWAVES = 8, NTHR = 512, LDS_BYTES = 147456;
constexpr size_t MiB = 1u << 20;
constexpr size_t WS_WIN = 1 * MiB;
constexpr size_t SZ_WIN = (size_t)NINP * D * 2;
constexpr size_t WS_WPJ = WS_WIN + 2 * SZ_WIN;
constexpr size_t SZ_WPJ = (size_t)D * (DR + DVT) * 2;
constexpr size_t WS_WOUT = WS_WPJ + 2 * SZ_WPJ;
constexpr size_t SZ_WOUT = (size_t)D * D * 2;
constexpr size_t WS_W1 = WS_WOUT + 2 * SZ_WOUT;
constexpr size_t SZ_W1 = (size_t)2 * DFF * D * 2;
constexpr size_t WS_W2 = WS_W1 + 2 * SZ_W1;
constexpr size_t SZ_W2 = (size_t)D * DFF * 2;
constexpr size_t WS_ADA = WS_W2 + 2 * SZ_W2;
constexpr size_t SZ_ADA = (size_t)NMOD * D * 2;
constexpr size_t WS_WG = WS_ADA + 2 * SZ_ADA;
constexpr size_t SZ_WG = (size_t)10 * 256 * 128 * 2;
constexpr size_t WS_CS = WS_WG + 2 * SZ_WG;
constexpr size_t WS_MOD = WS_CS + (size_t)256 * D * 2;
constexpr size_t SZ_MOD = (size_t)NB * NMOD * 4;
constexpr size_t WS_HN = ((WS_MOD + 2 * SZ_MOD + MiB - 1) / MiB) * MiB;
constexpr size_t WS_U = WS_HN + (size_t)M * D * 2;
constexpr size_t WS_P = WS_U + (size_t)M * NINP * 2;
constexpr size_t WS_END = WS_P + (size_t)M * D * 4;
constexpr size_t WS_KD = WS_P;
constexpr size_t WS_EL = WS_P + 32 * MiB;
static_assert(WS_KD + (size_t)1536 * 16384 <= WS_EL && WS_EL + (size_t)1536 * 512 <= WS_END, "KD/EL overlay P");

struct Args {
    const float* in[28]; float* out; unsigned char* ws; int ph_lo, ph_hi;
};
constexpr size_t O_Y = 0, O_CONVP = (size_t)M * D, O_LRUP = O_CONVP + 2 * 8 * 3 * DR, O_GLAP = O_LRUP + 2 * 8 * DR, O_CONVS = O_GLAP + (size_t)2 * 8 * 4 * 128 * 256,
                 O_LRUS = O_CONVS + (size_t)2 * 128 * 3 * DR, O_GLAS = O_LRUS + (size_t)2 * 128 * DR, O_END = O_GLAS + (size_t)2 * 128 * 4 * 128 * 256;

__device__ __forceinline__ float bperm(int srclane, float v) { return __int_as_float(__builtin_amdgcn_ds_bpermute(srclane << 2, __float_as_int(v))); }
__device__ __forceinline__ float wave_sum(float v, int lane) {
#pragma unroll
    for (int o = 1; o < 64; o <<= 1) v += bperm(lane ^ o, v);
    return v;
}
__device__ __forceinline__ int src_col(int np, int mapmode) {
    if (mapmode == 1) { if (np < GA0) return np; if (np < LR0) return np + 16; if (np < LR0 + 16) return np - LR0 + 5632; return -1; }
    if (mapmode == 2) { const int pn = np >> 8, bj = (np >> 7) & 1, j = np & 127; return bj * DFF + pn * 128 + j; }
    return np;
}
__device__ __forceinline__ void transpose_item(const float* W, int K, int N, bf16* WT, int ldt, int koff, int nblk, int mapmode, LAS float* scr, int item, int lane) {
    const int kb = item / nblk, nb = item % nblk, k0 = 64 * kb, n0 = 32 * nb;
    const int sc = src_col(n0 + (lane & 31), mapmode);
#pragma unroll 8
    for (int i = 0; i < 32; ++i) { const int kk = 2 * i + (lane >> 5); scr[kk * 33 + (lane & 31)] = sc >= 0 ? W[(size_t)(k0 + kk) * N + sc] : 0.f; }
    asm volatile("s_waitcnt lgkmcnt(0)" ::: "memory");
    const int c = lane & 7;
#pragma unroll
    for (int j = 0; j < 4; ++j) { const int n = (lane >> 3) + 8 * j; const LAS float* s = scr + (8 * c) * 33 + n;
        u32x4 o; o.x = cvtpk(s[0 * 33], s[1 * 33]); o.y = cvtpk(s[2 * 33], s[3 * 33]); o.z = cvtpk(s[4 * 33], s[5 * 33]); o.w = cvtpk(s[6 * 33], s[7 * 33]);
        *(u32x4*)(WT + (size_t)(n0 + n) * ldt + koff + k0 + 8 * c) = o; }
    asm volatile("s_waitcnt lgkmcnt(0)" ::: "memory");
}
__device__ __forceinline__ void norm_row(const float* xrow, const float* g, const float* sc, const float* sh, bf16* orow, float* orow_f, int lane) {
    const f32x4* xr = (const f32x4*)xrow + lane; f32x4 v[4]; float s = 0.f;
#pragma unroll
    for (int j = 0; j < 4; ++j) { v[j] = xr[64 * j]; s += (v[j].x * v[j].x + v[j].y * v[j].y) + (v[j].z * v[j].z + v[j].w * v[j].w); }
    const float rstd = 1.0f / sqrtf(wave_sum(s, lane) * (1.0f / D) + EPS);
#pragma unroll
    for (int j = 0; j < 4; ++j) { const int col = 4 * lane + 256 * j; const f32x4 gg = *(const f32x4*)(g + col);
        f32x4 o = v[j] * rstd * gg;
        if (orow_f) { *(f32x4*)(orow_f + col) = o; }
        else { const f32x4 a = *(const f32x4*)(sc + col), b = *(const f32x4*)(sh + col); o = o * (a + 1.0f) + b;
            u32x2 w; w.x = cvtpk(o.x, o.y); w.y = cvtpk(o.z, o.w); *(u32x2*)(orow + col) = w; } }
}

struct ScanP { int l; };
typedef const float* fptr_t;
__device__ __forceinline__ fptr_t inp(int i) {
    const __attribute__((address_space(4))) unsigned char* kp = (const __attribute__((address_space(4))) unsigned char*)__builtin_amdgcn_kernarg_segment_ptr();
    asm volatile("" : "+s"(kp));
    return *(const __attribute__((address_space(4))) fptr_t*)(kp + 8 * i);
}
#define WSP ((unsigned char*)inp(29))
#define OUTP ((float*)inp(28))
__device__ __forceinline__ bf16 f2bf1(float x) { return (bf16)(cvtpk(x, 0.f) & 0xffffu); }
#define MFMA16(a, b, c) __builtin_amdgcn_mfma_f32_16x16x32_bf16((a), (b), (c), 0, 0, 0)

template <bool SAMPLE>
__device__ __forceinline__ void lru_item(LAS unsigned char* lds, const ScanP& P, int item) {
    int tid_ = threadIdx.x; asm volatile("" : "+v"(tid_));
    const int tid = tid_, lane = tid & 63, w = __builtin_amdgcn_readfirstlane(tid >> 6), fr = lane & 15, fq = lane >> 4;
    const int n = item % 10, bb = item / 10;
    const int row0 = SAMPLE ? MP + bb * 64 : bb * SEQ;
    const int nch = SAMPLE ? 1 : SEQ / 64;
    LAS bf16* XC = (LAS bf16*)lds;
    const int l = P.l; bf16* const U = (bf16*)(WSP + WS_U);
    const bf16* wg = (const bf16*)(WSP + WS_WG + l * SZ_WG) + (size_t)n * 256 * 128;
    bf16x8 Bw[2][4];
#pragma unroll
    for (int nt = 0; nt < 2; ++nt)
#pragma unroll
        for (int ks = 0; ks < 4; ++ks) Bw[nt][ks] = *(const bf16x8*)(wg + (size_t)(nt * 128 + 16 * w + fr) * 128 + 32 * ks + 8 * fq);
    const int ch = n * 128 + 16 * w + fr;
    const float ba = (inp(15) + (size_t)l * DR)[ch], bx = (inp(17) + (size_t)l * DR)[ch], lam = (inp(18) + (size_t)l * DR)[ch];
    const float cl = -8.0f * log1pf(expf(-lam));
    const int cg = tid & 15, tt = tid >> 4, cch = n * 128 + 8 * cg;
    float cw[4][8], cb[8];
#pragma unroll
    for (int i = 0; i < 4; ++i)
#pragma unroll
        for (int j = 0; j < 8; ++j) cw[i][j] = (inp(12) + (size_t)l * 4 * DR)[i * DR + cch + j];
#pragma unroll
    for (int j = 0; j < 8; ++j) cb[j] = (inp(13) + (size_t)l * DR)[cch + j];
    const float* const st_conv = SAMPLE ? inp(4) + (size_t)l * 128 * 3 * DR : nullptr; const float* const st_lru = SAMPLE ? inp(5) + (size_t)l * 128 * DR : nullptr;
    float* const o_lru_s = OUTP + O_LRUS + (size_t)l * 128 * DR;
    float hc = 0.f;
    u32x4 uq[2][4];
#define LRU_LOADC(c_) do { _Pragma("unroll") for (int p = 0; p < 2; ++p) _Pragma("unroll") for (int d = 0; d < 4; ++d) { const int tl_ = tt + 32 * p; const u32x4 z4 = {0u, 0u, 0u, 0u}; uq[p][d] = z4; \
        if ((c_) * 64 + tl_ - d >= 0) uq[p][d] = *(const u32x4*)(U + (size_t)(row0 + (c_) * 64 + tl_ - d) * NINP + X0 + cch); } } while (0)
    if (!SAMPLE) LRU_LOADC(0);
    for (int c = 0; c < nch; ++c) {
        const int r0 = row0 + c * 64;
#pragma unroll
        for (int p = 0; p < 2; ++p) {
            const int tl = tt + 32 * p; float xc[8];
#pragma unroll
            for (int j = 0; j < 8; ++j) xc[j] = cb[j];
#pragma unroll
            for (int d = 0; d < 4; ++d) {
                float uv[8];
                bool from_u, zero = false;
                if (!SAMPLE) { from_u = (c * 64 + tl - d) >= 0; zero = !from_u; } else { from_u = ((tl & 3) - d) >= 0; }
                if (!SAMPLE) { const u32x4 q = uq[p][d];
                    uv[0] = bflo(q.x); uv[1] = bfhi(q.x); uv[2] = bflo(q.y); uv[3] = bfhi(q.y); uv[4] = bflo(q.z); uv[5] = bfhi(q.z); uv[6] = bflo(q.w); uv[7] = bfhi(q.w); }
                else if (from_u) { const u32x4 q = *(const u32x4*)(U + (size_t)(r0 + tl - d) * NINP + X0 + cch);
                    uv[0] = bflo(q.x); uv[1] = bfhi(q.x); uv[2] = bflo(q.y); uv[3] = bfhi(q.y); uv[4] = bflo(q.z); uv[5] = bfhi(q.z); uv[6] = bflo(q.w); uv[7] = bfhi(q.w); }
                else if (zero) {
#pragma unroll
                    for (int j = 0; j < 8; ++j) uv[j] = 0.f; }
                else { const int b = bb * 16 + (tl >> 2); const float* sp = st_conv + ((size_t)b * 3 + (3 + (tl & 3) - d)) * DR + cch;
                    const f32x4 s0 = *(const f32x4*)sp, s1 = *(const f32x4*)(sp + 4);
                    uv[0] = s0.x; uv[1] = s0.y; uv[2] = s0.z; uv[3] = s0.w; uv[4] = s1.x; uv[5] = s1.y; uv[6] = s1.z; uv[7] = s1.w; }
#pragma unroll
                for (int j = 0; j < 8; ++j) xc[j] += cw[3 - d][j] * uv[j];
            }
            u32x4 o; o.x = cvtpk(xc[0], xc[1]); o.y = cvtpk(xc[2], xc[3]); o.z = cvtpk(xc[4], xc[5]); o.w = cvtpk(xc[6], xc[7]);
            *(LAS u32x4*)(XC + tl * 136 + 8 * cg) = o;
        }
        __syncthreads();
        if (!SAMPLE && c + 1 < nch) LRU_LOADC(c + 1);
        bf16 gv[4][4];
#pragma unroll
        for (int mt = 0; mt < 4; ++mt)
#pragma unroll
            for (int e = 0; e < 4; ++e) gv[mt][e] = U[(size_t)(r0 + 16 * mt + 4 * fq + e) * NINP + G0 + ch];
        f32x4 acc[4][2];
#pragma unroll
        for (int mt = 0; mt < 4; ++mt) { acc[mt][0] = (f32x4){0.f, 0.f, 0.f, 0.f}; acc[mt][1] = (f32x4){0.f, 0.f, 0.f, 0.f};
#pragma unroll
            for (int ks = 0; ks < 4; ++ks) { const bf16x8 a = *(const LAS bf16x8*)(XC + (16 * mt + fr) * 136 + 32 * ks + 8 * fq);
                acc[mt][0] = MFMA16(a, Bw[0][ks], acc[mt][0]); acc[mt][1] = MFMA16(a, Bw[1][ks], acc[mt][1]); } }
#pragma unroll
        for (int mt = 0; mt < 4; ++mt) {
            float Pe[4], Qe[4];
#pragma unroll
            for (int e = 0; e < 4; ++e) { const int tl = 16 * mt + 4 * fq + e;
                const float r = fsigmoid(acc[mt][0][e] + ba), ii = fsigmoid(acc[mt][1][e] + bx), la = cl * r, a = fexp(la), x2 = 2.0f * la;
                const float om = (x2 > -0.1f) ? -x2 * (1.0f + x2 * (0.5f + x2 * (0.16666667f + x2 * 0.041666668f))) : 1.0f - a * a;
                const float xcv = bf2f(XC[tl * 136 + 16 * w + fr]), bv = sqrtf(om) * ii * xcv;
                if (e == 0) { Pe[0] = a; Qe[0] = bv; } else { Pe[e] = a * Pe[e - 1]; Qe[e] = a * Qe[e - 1] + bv; } }
            float hin;
            if (!SAMPLE) {
                float Pi = Pe[3], Qi = Qe[3];
                { const float Pp = bperm(lane - 16, Pi), Qp = bperm(lane - 16, Qi); if (fq >= 1) { Qi = Pi * Qp + Qi; Pi = Pi * Pp; } }
                { const float Pp = bperm(lane - 32, Pi), Qp = bperm(lane - 32, Qi); if (fq >= 2) { Qi = Pi * Qp + Qi; Pi = Pi * Pp; } }
                float Px = bperm(lane - 16, Pi), Qx = bperm(lane - 16, Qi); if (fq == 0) { Px = 1.f; Qx = 0.f; }
                hin = Px * hc + Qx;
            } else { hin = st_lru[(size_t)(bb * 16 + 4 * mt + fq) * DR + ch]; }
            float hv[4];
#pragma unroll
            for (int e = 0; e < 4; ++e) hv[e] = Pe[e] * hin + Qe[e];
            if (!SAMPLE) hc = bperm(48 + fr, hv[3]); else o_lru_s[(size_t)(bb * 16 + 4 * mt + fq) * DR + ch] = hv[3];
#pragma unroll
            for (int e = 0; e < 4; ++e) U[(size_t)(r0 + 16 * mt + 4 * fq + e) * NINP + G0 + ch] = f2bf1(hv[e] * bf2f(gv[mt][e]));
        }
        __syncthreads();
    }
#undef LRU_LOADC
    if (!SAMPLE) {
        if (fq == 0) (OUTP + O_LRUP + (size_t)l * 8 * DR)[(size_t)bb * DR + ch] = hc;
        if (tid < 384) { const int j = tid >> 7, cc = tid & 127; (OUTP + O_CONVP + (size_t)l * 8 * 3 * DR)[((size_t)bb * 3 + j) * DR + n * 128 + cc] = bf2f(U[(size_t)(row0 + SEQ - 3 + j) * NINP + X0 + n * 128 + cc]); }
    } else {
        for (int idx = tid; idx < 6144; idx += NTHR) { const int s = idx / 384, rem = idx % 384, j = rem >> 7, cc = rem & 127;
            (OUTP + O_CONVS + (size_t)l * 128 * 3 * DR)[((size_t)(bb * 16 + s) * 3 + j) * DR + n * 128 + cc] = bf2f(U[(size_t)(row0 + 4 * s + 1 + j) * NINP + X0 + n * 128 + cc]); }
    }
}

__device__ __forceinline__ void gla_prep(LAS unsigned char* lds, int l, int item) {
    int tid_ = threadIdx.x; asm volatile("" : "+v"(tid_));
    const int tid = tid_;
    LAS float* LRS = (LAS float*)lds; LAS float* TOT = (LAS float*)(lds + 4096);
    const int cidx = item >> 2, h = item & 3;
    const int r0 = cidx < 256 ? (cidx >> 5) * SEQ + (cidx & 31) * 64 : MP + 4 * (cidx - 256), nv = cidx < 256 ? 64 : 4;
    const int c = tid & 127, tg = tid >> 7;
    bf16* const U = (bf16*)(WSP + WS_U);
    float wa2c[16];
#pragma unroll
    for (int r = 0; r < 16; ++r) wa2c[r] = (inp(19) + (size_t)l * 16 * DKT)[r * DKT + h * 128 + c];
    const float gba = (inp(20) + (size_t)l * DKT)[h * 128 + c];
    if (tid < 128) { const int t = tid >> 1, hf = tid & 1; u32x4 a = {0u, 0u, 0u, 0u};
        if (t < nv) a = *(const u32x4*)(U + (size_t)(r0 + t) * NINP + LR0 + 8 * hf);
        const f32x4 l0 = {bflo(a.x), bfhi(a.x), bflo(a.y), bfhi(a.y)}, l1 = {bflo(a.z), bfhi(a.z), bflo(a.w), bfhi(a.w)};
        *(LAS f32x4*)(LRS + t * 16 + 8 * hf) = l0; *(LAS f32x4*)(LRS + t * 16 + 8 * hf + 4) = l1; }
    float qv[16], kv[16];
#pragma unroll
    for (int i = 0; i < 16; ++i) { const int t = 16 * tg + i; qv[i] = 0.f; kv[i] = 0.f;
        if (t < nv) { const bf16* up = U + (size_t)(r0 + t) * NINP + h * 128 + c; qv[i] = bf2f(up[Q0]); kv[i] = bf2f(up[K0]); } }
    __syncthreads();
    float bc[16]; float run = 0.f;
#pragma unroll
    for (int i = 0; i < 16; ++i) { const int t = 16 * tg + i; float g = 0.f;
        if (t < nv) { const LAS f32x4* lp = (const LAS f32x4*)(LRS + t * 16); const f32x4 a = lp[0], b = lp[1], cc = lp[2], d = lp[3];
            float pre = gba;
            pre += wa2c[0] * a.x + wa2c[1] * a.y + wa2c[2] * a.z + wa2c[3] * a.w + wa2c[4] * b.x + wa2c[5] * b.y + wa2c[6] * b.z + wa2c[7] * b.w;
            pre += wa2c[8] * cc.x + wa2c[9] * cc.y + wa2c[10] * cc.z + wa2c[11] * cc.w + wa2c[12] * d.x + wa2c[13] * d.y + wa2c[14] * d.z + wa2c[15] * d.w;
            g = (fminf(pre, 0.f) - __logf(1.0f + fexp(-fabsf(pre)))) * 0.0625f; }
        run += g; bc[i] = run; }
    TOT[tg * 128 + c] = run;
    __syncthreads();
    float off = 0.f, blast = 0.f;
#pragma unroll
    for (int j = 0; j < 4; ++j) { const float v = TOT[j * 128 + c]; blast += v; if (j < tg) off += v; }
    float kdv[16];
#pragma unroll
    for (int i = 0; i < 16; ++i) { const int t = 16 * tg + i; const float bci = bc[i] + off;
        if (t < nv) { bf16* up = U + (size_t)(r0 + t) * NINP + h * 128 + c; up[Q0] = f2bf1(qv[i] * fexp(bci)); up[K0] = f2bf1(kv[i] * fexp(-bci)); }
        kdv[i] = kv[i] * fexp(blast - bci); }
    { u32x4 k0, k1; k0.x = cvtpk(kdv[0], kdv[1]); k0.y = cvtpk(kdv[2], kdv[3]); k0.z = cvtpk(kdv[4], kdv[5]); k0.w = cvtpk(kdv[6], kdv[7]);
      k1.x = cvtpk(kdv[8], kdv[9]); k1.y = cvtpk(kdv[10], kdv[11]); k1.z = cvtpk(kdv[12], kdv[13]); k1.w = cvtpk(kdv[14], kdv[15]);
      bf16* kd = (bf16*)(WSP + WS_KD) + (size_t)item * 8192 + c * 64 + 16 * tg; *(u32x4*)kd = k0; *(u32x4*)(kd + 8) = k1; }
    if (tg == 0) ((float*)(WSP + WS_EL))[(size_t)item * 128 + c] = fexp(blast);
    __syncthreads();
}

__device__ __forceinline__ void gla_rec(LAS unsigned char* lds, int l, int h, int vh, int row_base, int nch, int nv_last, int cidx0, const float* S0, float* ST) {
    int tid_ = threadIdx.x; asm volatile("" : "+v"(tid_));
    const int tid = tid_, lane = tid & 63, w = __builtin_amdgcn_readfirstlane(tid >> 6), fr = lane & 15, fq = lane >> 4;
    LAS bf16* Qs = (LAS bf16*)lds; LAS bf16* Ks = (LAS bf16*)(lds + 17408); LAS bf16* KDT = (LAS bf16*)(lds + 34816); LAS bf16* VT = (LAS bf16*)(lds + 53248);
    LAS bf16* ATT = (LAS bf16*)(lds + 71680); LAS float* EL = (LAS float*)(lds + 80896);
    bf16* const U = (bf16*)(WSP + WS_U); const bf16* const KDg = (const bf16*)(WSP + WS_KD); const float* const ELg = (const float*)(WSP + WS_EL);
    f32x4 S[8];
#pragma unroll
    for (int kt = 0; kt < 8; ++kt)
#pragma unroll
        for (int e = 0; e < 4; ++e) S[kt][e] = S0 ? S0[(size_t)(16 * kt + 4 * fq + e) * 256 + 16 * w + fr] : 0.f;
    u32x4 pq[2], pk[2], pd[2], pv[2]; f32x4 pe = {0.f, 0.f, 0.f, 0.f};
#define GLA_LOADC(ci_) do { const int r0_ = row_base + (ci_) * 64, nv_ = ((ci_) == nch - 1) ? nv_last : 64; const size_t it_ = (size_t)(cidx0 + (ci_)) * 4 + h; \
        _Pragma("unroll") for (int p = 0; p < 2; ++p) { const int idx = tid + 512 * p, t = idx >> 4, seg = idx & 15, tv = idx & 63, sv = idx >> 6; \
            const u32x4 z4 = {0u, 0u, 0u, 0u}; pq[p] = z4; pk[p] = z4; pv[p] = z4; \
            if (t < nv_) { const bf16* up = U + (size_t)(r0_ + t) * NINP + h * 128 + 8 * seg; pq[p] = *(const u32x4*)(up + Q0); pk[p] = *(const u32x4*)(up + K0); } \
            pd[p] = *(const u32x4*)(KDg + it_ * 8192 + idx * 8); \
            if (tv < nv_) pv[p] = *(const u32x4*)(U + (size_t)(r0_ + tv) * NINP + V0 + h * 256 + vh * 128 + 8 * sv); } \
        if (tid < 32) pe = *(const f32x4*)(ELg + it_ * 128 + 4 * tid); } while (0)
    GLA_LOADC(0);
    for (int ci = 0; ci < nch; ++ci) {
        const int r0 = row_base + ci * 64, nv = (ci == nch - 1) ? nv_last : 64;
#pragma unroll
        for (int p = 0; p < 2; ++p) { const int idx = tid + 512 * p, t = idx >> 4, seg = idx & 15, tv = idx & 63, sv = idx >> 6;
            *(LAS u32x4*)(Qs + t * 136 + 8 * seg) = pq[p]; *(LAS u32x4*)(Ks + t * 136 + 8 * seg) = pk[p];
            *(LAS u32x4*)(KDT + (idx >> 3) * 72 + (idx & 7) * 8) = pd[p];
            LAS bf16* vp = VT + (8 * sv) * 72 + tv; const u32x4 vv = pv[p];
            vp[0] = (bf16)(vv.x & 0xffffu); vp[72] = (bf16)(vv.x >> 16); vp[144] = (bf16)(vv.y & 0xffffu); vp[216] = (bf16)(vv.y >> 16);
            vp[288] = (bf16)(vv.z & 0xffffu); vp[360] = (bf16)(vv.z >> 16); vp[432] = (bf16)(vv.w & 0xffffu); vp[504] = (bf16)(vv.w >> 16); }
        if (tid < 32) *(LAS f32x4*)(EL + 4 * tid) = pe;
        __syncthreads();
        if (ci + 1 < nch) GLA_LOADC(ci + 1);
        { const int it = w >> 1;
#pragma unroll
          for (int jj = 0; jj < 2; ++jj) { const int jt = (w & 1) * 2 + jj; f32x4 a4 = {0.f, 0.f, 0.f, 0.f};
#pragma unroll
            for (int ks = 0; ks < 4; ++ks) { const bf16x8 a = *(const LAS bf16x8*)(Ks + (16 * jt + fr) * 136 + 32 * ks + 8 * fq), b = *(const LAS bf16x8*)(Qs + (16 * it + fr) * 136 + 32 * ks + 8 * fq);
                a4 = MFMA16(a, b, a4); }
            const int i = 16 * it + fr;
#pragma unroll
            for (int e = 0; e < 4; ++e) if (16 * jt + 4 * fq + e > i) a4[e] = 0.f;
            u32x2 o2; o2.x = cvtpk(a4[0], a4[1]); o2.y = cvtpk(a4[2], a4[3]);
            *(LAS u32x2*)(ATT + i * 72 + 16 * jt + 4 * fq) = o2; } }
        __syncthreads();
        bf16x8 vb[2], Sp[4];
#pragma unroll
        for (int js = 0; js < 2; ++js) vb[js] = *(const LAS bf16x8*)(VT + (16 * w + fr) * 72 + 32 * js + 8 * fq);
#pragma unroll
        for (int ks = 0; ks < 4; ++ks) { u32x4 pk4; const f32x4 s0 = S[2 * ks], s1 = S[2 * ks + 1];
            pk4.x = cvtpk(s0[0], s0[1]); pk4.y = cvtpk(s0[2], s0[3]); pk4.z = cvtpk(s1[0], s1[1]); pk4.w = cvtpk(s1[2], s1[3]); Sp[ks] = __builtin_bit_cast(bf16x8, pk4); }
        f32x4 o[4];
#pragma unroll
        for (int it = 0; it < 4; ++it) { f32x4 oo = {0.f, 0.f, 0.f, 0.f};
#pragma unroll
            for (int js = 0; js < 2; ++js) if (2 * js <= it) { const bf16x8 aa = *(const LAS bf16x8*)(ATT + (16 * it + fr) * 72 + 32 * js + 8 * fq); oo = MFMA16(aa, vb[js], oo); }
#pragma unroll
            for (int ks = 0; ks < 4; ++ks) { const u32x2 lo = *(const LAS u32x2*)(Qs + (16 * it + fr) * 136 + 32 * ks + 4 * fq), hi = *(const LAS u32x2*)(Qs + (16 * it + fr) * 136 + 32 * ks + 16 + 4 * fq);
                u32x4 q4; q4.x = lo.x; q4.y = lo.y; q4.z = hi.x; q4.w = hi.y; oo = MFMA16(__builtin_bit_cast(bf16x8, q4), Sp[ks], oo); }
            o[it] = oo; }
#pragma unroll
        for (int kt = 0; kt < 8; ++kt) { const f32x4 el = *(const LAS f32x4*)(EL + 16 * kt + 4 * fq); S[kt] *= el; }
#pragma unroll
        for (int js = 0; js < 2; ++js)
#pragma unroll
            for (int kt = 0; kt < 8; ++kt) { const bf16x8 a = *(const LAS bf16x8*)(KDT + (16 * kt + fr) * 72 + 32 * js + 8 * fq); S[kt] = MFMA16(a, vb[js], S[kt]); }
#pragma unroll
        for (int it = 0; it < 4; ++it)
#pragma unroll
            for (int e = 0; e < 4; ++e) { const int row = 16 * it + 4 * fq + e;
                if (row < nv) U[(size_t)(r0 + row) * NINP + V0 + h * 256 + vh * 128 + 16 * w + fr] = f2bf1(o[it][e]); }
        __syncthreads();
    }
#undef GLA_LOADC
#pragma unroll
    for (int kt = 0; kt < 8; ++kt)
#pragma unroll
        for (int e = 0; e < 4; ++e) ST[(size_t)(16 * kt + 4 * fq + e) * 256 + 16 * w + fr] = S[kt][e];
}
__device__ __forceinline__ void gla_fin_row(bf16* U, const float* gnorm, int row, int lane) {
    const u32x4* op = (const u32x4*)(U + (size_t)row * NINP + V0 + 16 * lane); u32x4* rp = (u32x4*)(U + (size_t)row * NINP + R0 + 16 * lane);
    const u32x4 o0 = op[0], o1 = op[1], r0 = rp[0], r1 = rp[1];
    float ov[16] = {bflo(o0.x), bfhi(o0.x), bflo(o0.y), bfhi(o0.y), bflo(o0.z), bfhi(o0.z), bflo(o0.w), bfhi(o0.w), bflo(o1.x), bfhi(o1.x), bflo(o1.y), bfhi(o1.y), bflo(o1.z), bfhi(o1.z), bflo(o1.w), bfhi(o1.w)};
    const float rv[16] = {bflo(r0.x), bfhi(r0.x), bflo(r0.y), bfhi(r0.y), bflo(r0.z), bfhi(r0.z), bflo(r0.w), bfhi(r0.w), bflo(r1.x), bfhi(r1.x), bflo(r1.y), bfhi(r1.y), bflo(r1.z), bfhi(r1.z), bflo(r1.w), bfhi(r1.w)};
    float ss = 0.f;
#pragma unroll
    for (int i = 0; i < 16; ++i) ss += ov[i] * ov[i];
    ss += bperm(lane ^ 1, ss); ss += bperm(lane ^ 2, ss); ss += bperm(lane ^ 4, ss); ss += bperm(lane ^ 8, ss);
    const float rstd = 1.0f / sqrtf(ss * (1.0f / 256.0f) + EPS);
    const f32x4* gp = (const f32x4*)(gnorm + 16 * lane);
#pragma unroll
    for (int j = 0; j < 4; ++j) { const f32x4 g = gp[j];
#pragma unroll
        for (int e = 0; e < 4; ++e) ov[4 * j + e] = ov[4 * j + e] * rstd * g[e] * rv[4 * j + e]; }
    u32x4 w0, w1; w0.x = cvtpk(ov[0], ov[1]); w0.y = cvtpk(ov[2], ov[3]); w0.z = cvtpk(ov[4], ov[5]); w0.w = cvtpk(ov[6], ov[7]);
    w1.x = cvtpk(ov[8], ov[9]); w1.y = cvtpk(ov[10], ov[11]); w1.z = cvtpk(ov[12], ov[13]); w1.w = cvtpk(ov[14], ov[15]);
    rp[0] = w0; rp[1] = w1;
}

constexpr int N_PHASES = 23;
__global__ void __launch_bounds__(NTHR, 2) fwd(Args args) {
    extern __shared__ __attribute__((aligned(16))) unsigned char lds_raw[];
    LAS unsigned char* lds = (LAS unsigned char*)lds_raw;
    cg::grid_group grid = cg::this_grid();
    const int G = gridDim.x, bx = blockIdx.x;
#define PHASE_LOCALS int t_ = threadIdx.x; asm volatile("" : "+v"(t_)); const int tid = t_, lane = tid & 63, wave = __builtin_amdgcn_readfirstlane(tid >> 6), gw = bx * NWAVES + wave, NGW = G * NWAVES; (void)tid; (void)lane; (void)gw; (void)NGW;
#define ws WSP
#define X (OUTP + O_Y)
#define HN ((bf16*)(WSP + WS_HN))
#define U ((bf16*)(WSP + WS_U))
#define FF ((bf16*)(WSP + WS_U))
#define PB ((float*)(WSP + WS_P))
#define MOD ((float*)(WSP + WS_MOD))
#define CS ((bf16*)(WSP + WS_CS))
    const int lo = args.ph_lo, hi = args.ph_hi;
#ifndef REP
#define REP 1
#endif
#ifndef SCM
#define SCM 15
#endif
#ifndef DBG_MASK
#define DBG_MASK 0x7ffff
#endif
#define PHON(k) ((DBG_MASK >> ((k) < 10 ? (k) : (k) - 8)) & 1)
#define IN(k) (lo <= (k) && (k) < hi)
#define SEAM(k) do { if (lo <= (k) && (k) + 1 < hi) grid.sync(); } while (0)

    if (IN(0)) {
        PHASE_LOCALS
        LAS float* scr = (LAS float*)(lds + wave * 16384);
        constexpr int I_WIN = 16 * 248, I_PA = 20 * 32, I_PB = 16 * 32, I_WO = 16 * 32, I_W1 = 16 * 176, I_W2 = 44 * 32, I_ADA = 16 * 192;
        constexpr int I_L = I_WIN + I_PA + I_PB + I_WO + I_W1 + I_W2 + I_ADA;
        for (int it = gw; it < 2 * I_L; it += NGW) {
            const int l = it / I_L; int r = it % I_L;
            if (r < I_WIN) { transpose_item(inp(11) + (size_t)l * D * 7696, D, 7696, (bf16*)(ws + WS_WIN + l * SZ_WIN), D, 0, 248, 1, scr, r, lane); continue; } r -= I_WIN;
            if (r < I_PA) { transpose_item(inp(22) + (size_t)l * DR * D, DR, D, (bf16*)(ws + WS_WPJ + l * SZ_WPJ), DR + DVT, 0, 32, 0, scr, r, lane); continue; } r -= I_PA;
            if (r < I_PB) { transpose_item(inp(23) + (size_t)l * DVT * D, DVT, D, (bf16*)(ws + WS_WPJ + l * SZ_WPJ), DR + DVT, DR, 32, 0, scr, r, lane); continue; } r -= I_PB;
            if (r < I_WO) { transpose_item(inp(24) + (size_t)l * D * D, D, D, (bf16*)(ws + WS_WOUT + l * SZ_WOUT), D, 0, 32, 0, scr, r, lane); continue; } r -= I_WO;
            if (r < I_W1) { transpose_item(inp(25) + (size_t)l * D * 2 * DFF, D, 2 * DFF, (bf16*)(ws + WS_W1 + l * SZ_W1), D, 0, 176, 2, scr, r, lane); continue; } r -= I_W1;
            if (r < I_W2) { transpose_item(inp(26) + (size_t)l * DFF * D, DFF, D, (bf16*)(ws + WS_W2 + l * SZ_W2), DFF, 0, 32, 0, scr, r, lane); continue; } r -= I_W2;
            transpose_item(inp(9) + (size_t)l * D * NMOD, D, NMOD, (bf16*)(ws + WS_ADA + l * SZ_ADA), D, 0, 192, 0, scr, r, lane);
        }
        bf16* WG = (bf16*)(ws + WS_WG);
        for (int idx = bx * NTHR + tid; idx < 2 * 10 * 256 * 128; idx += G * NTHR) {
            const int l = idx / 327680, r = idx % 327680, n = r >> 15, vv = (r >> 7) & 255, wi = r & 127;
            const float* src = (vv < 128 ? inp(14) : inp(16)) + ((size_t)(l * 10 + n) * 128 + wi) * 128 + (vv & 127);
            WG[idx] = f2bf1(*src);
        }
        for (int idx = bx * NTHR + tid; idx < 256 * D; idx += G * NTHR) {
            const int row = idx >> 10, col = idx & 1023; float v = 0.f;
            if (row < 8) v = inp(2)[row * D + col]; else if (row < NB) v = inp(3)[(row - 8) * D + col];
            CS[idx] = f2bf1(v * fsigmoid(v));
        }
    }
    SEAM(0);
    if (IN(1)) {
        for (int l = 0; l < 2; ++l) {
            pg8::Gemm g{CS, (const bf16*)(ws + WS_ADA + l * SZ_ADA), 256, NMOD, D, D, D}; pg8::StaticOrder S; S.init(256, NMOD, G, (bx + 128 * l) % G);
            pg8::EpiMod E{MOD + (size_t)l * NB * NMOD, inp(10) + (size_t)l * NMOD};
            pg8::gemm_phase<pg8::EpiMod, pg8::StaticOrder, true, true>(lds, g, S, E);
        }
    }
    SEAM(1);
    for (int l = 0; l < 2; ++l) {
        const int pb = 2 + 10 * l;
#define modl (MOD + (size_t)l * NB * NMOD)
        if (IN(pb)) {
            PHASE_LOCALS
            for (int row = gw; row < M; row += NGW) {
                const float* xr = l == 0 ? (row < MP ? inp(0) + (size_t)row * D : inp(1) + (size_t)(row - MP) * D) : X + (size_t)row * D;
                const float* mb = modl + (size_t)row_batch(row) * NMOD;
                norm_row(xr, inp(7) + l * D, mb + 1024, mb, HN + (size_t)row * D, nullptr, lane);
            }
        }
        SEAM(pb);
        if (IN(pb + 1)) {
            pg8::Gemm g{HN, (const bf16*)(ws + WS_WIN + l * SZ_WIN), M, NINP, D, D, D}; pg8::StaticOrder S; S.init(M, NINP, G, bx);
            pg8::EpiWin E{U};
            pg8::gemm_phase<pg8::EpiWin, pg8::StaticOrder, true, true>(lds, g, S, E);
        }
        SEAM(pb + 1);
        if (IN(pb + 2)) {
            for (int item = bx; item < 1536; item += G) gla_prep(lds, l, item);
        }
        SEAM(pb + 2);
        if (IN(pb + 3)) {
            ScanP P; P.l = l;
            float* const o_gla_p = OUTP + O_GLAP + (size_t)l * 8 * 4 * 32768; float* const o_gla_s = OUTP + O_GLAS + (size_t)l * 128 * 4 * 32768;
            if (bx < 64) { const int b = bx >> 3, h = (bx >> 1) & 3, vh = bx & 1; gla_rec(lds, l, h, vh, b * SEQ, SEQ / 64, 64, b * 32, nullptr, o_gla_p + (size_t)(b * 4 + h) * 32768 + vh * 128); }
            else if (bx < 144) { lru_item<false>(lds, P, bx - 64); }
            else {
                for (int j = bx - 144; j < 1104; j += (G - 144)) {
                    if (j < 1024) { const int b = j >> 3, h = (j >> 1) & 3, vh = j & 1;
                        gla_rec(lds, l, h, vh, MP + b * 4, 1, 4, 256 + b, inp(6) + (size_t)l * 128 * 4 * 32768 + (size_t)(b * 4 + h) * 32768 + vh * 128, o_gla_s + (size_t)(b * 4 + h) * 32768 + vh * 128); }
                    else lru_item<true>(lds, P, j - 1024);
                }
            }
        }
        SEAM(pb + 3);
        if (IN(pb + 4)) {
            PHASE_LOCALS
            for (int row = gw; row < M; row += NGW) gla_fin_row(U, inp(21) + (size_t)l * DVT, row, lane);
        }
        SEAM(pb + 4);
        if (IN(pb + 5)) {
            const bf16* wpj = (const bf16*)(ws + WS_WPJ + l * SZ_WPJ);
            { pg8::Gemm g{U + G0, wpj, M, D, DR, NINP, DR + DVT}; pg8::StaticOrder S; S.init(M, D, G, bx); pg8::EpiProj E{U, PB, HN, 0};
              pg8::gemm_phase<pg8::EpiProj, pg8::StaticOrder, true, true>(lds, g, S, E); }
            { pg8::Gemm g{U + R0, wpj + DR, M, D, DVT, NINP, DR + DVT}; pg8::StaticOrder S; S.init(M, D, G, bx); pg8::EpiProj E{U, PB, HN, 1};
              pg8::gemm_phase<pg8::EpiProj, pg8::StaticOrder, true, true>(lds, g, S, E); }
        }
        SEAM(pb + 5);
        if (IN(pb + 6)) {
            pg8::Gemm g{HN, (const bf16*)(ws + WS_WOUT + l * SZ_WOUT), M, D, D, D, D}; pg8::StaticOrder S; S.init(M, D, G, bx);
            pg8::EpiRes E{l == 0 ? inp(0) : X, l == 0 ? inp(1) : X + (size_t)MP * D, X, modl + 2048};
            pg8::gemm_phase<pg8::EpiRes, pg8::StaticOrder, true, true>(lds, g, S, E);
        }
        SEAM(pb + 6);
        if (IN(pb + 7)) {
            PHASE_LOCALS
            for (int row = gw; row < M; row += NGW) {
                const float* mb = modl + (size_t)row_batch(row) * NMOD;
                norm_row(X + (size_t)row * D, inp(8) + l * D, mb + 4096, mb + 3072, HN + (size_t)row * D, nullptr, lane);
            }
        }
        SEAM(pb + 7);
        if (IN(pb + 8)) {
            pg8::Gemm g{HN, (const bf16*)(ws + WS_W1 + l * SZ_W1), M, 2 * DFF, D, D, D}; pg8::StaticOrder S; S.init(M, 2 * DFF, G, bx);
            pg8::EpiSwiglu E{FF};
            pg8::gemm_phase<pg8::EpiSwiglu, pg8::StaticOrder, true, true>(lds, g, S, E);
        }
        SEAM(pb + 8);
        if (IN(pb + 9)) {
            pg8::Gemm g{FF, (const bf16*)(ws + WS_W2 + l * SZ_W2), M, D, DFF, DFF, DFF}; pg8::StaticOrder S; S.init(M, D, G, bx);
            pg8::EpiRes E{X, X + (size_t)MP * D, X, modl + 5120};
            pg8::gemm_phase<pg8::EpiRes, pg8::StaticOrder, true, true>(lds, g, S, E);
        }
        SEAM(pb + 9);
    }
    if (IN(22)) {
        PHASE_LOCALS
        for (int row = gw; row < M; row += NGW) norm_row(X + (size_t)row * D, inp(27), nullptr, nullptr, nullptr, X + (size_t)row * D, lane);
    }
#undef IN
#undef SEAM
#undef ws
#undef X
#undef HN
#undef U
#undef FF
#undef PB
#undef MOD
#undef CS
#undef modl
}

#ifndef MK_SPLIT
#define MK_SPLIT 0
#endif
extern "C" void kernel_launch(void* const* d_in, const int* in_sizes, int n_in, void* d_out, int out_size, void* d_ws, size_t ws_size, hipStream_t stream) {
    static int grid = 0;
    if (grid == 0) {
        if (n_in != 28 || (size_t)out_size != O_END || ws_size < WS_END) { fprintf(stderr, "kernel_launch: unexpected shapes (n_in %d, out %d, ws %zu, need %zu); nothing launched\n", n_in, out_size, ws_size, (size_t)WS_END); grid = -1; return; }
        int dev = 0, cus = 0, per_cu = 0;
        (void)hipGetDevice(&dev); (void)hipDeviceGetAttribute(&cus, hipDeviceAttributeMultiprocessorCount, dev);
        if (hipFuncSetAttribute((const void*)fwd, hipFuncAttributeMaxDynamicSharedMemorySize, LDS_BYTES) != hipSuccess) { fprintf(stderr, "kernel_launch: hipFuncSetAttribute failed\n"); grid = -1; return; }
        if (hipOccupancyMaxActiveBlocksPerMultiprocessor(&per_cu, (const void*)fwd, NTHR, LDS_BYTES) != hipSuccess || per_cu < 1) { fprintf(stderr, "kernel_launch: occupancy query says %d\n", per_cu); per_cu = 1; }
        (void)hipGetLastError();
        grid = 256;
        if (cus * per_cu < 256) { fprintf(stderr, "kernel_launch: device holds only %d x %d workgroups; this kernel needs 256 co-resident\n", cus, per_cu); grid = -1; return; }
    }
    if (grid < 0) return;
    Args a{};
    for (int i = 0; i < 28; ++i) a.in[i] = (const float*)d_in[i];
    a.out = (float*)d_out; a.ws = (unsigned char*)d_ws;
#if MK_SPLIT
    for (int p = 0; p < N_PHASES; ++p) { a.ph_lo = p; a.ph_hi = p + 1; void* kargs[] = {&a};
        hipError_t e = hipLaunchCooperativeKernel((const void*)fwd, dim3(grid), dim3(NTHR), kargs, LDS_BYTES, stream);
        if (e != hipSuccess) { fprintf(stderr, "kernel_launch: launch failed: %s\n", hipGetErrorString(e)); break; } }
#else
    a.ph_lo = 0; a.ph_hi = N_PHASES; void* kargs[] = {&a};
    hipError_t e = hipLaunchCooperativeKernel((const void*)fwd, dim3(grid), dim3(NTHR), kargs, LDS_BYTES, stream);
    if (e != hipSuccess) fprintf(stderr, "kernel_launch: cooperative launch failed: %s (grid %d)\n", hipGetErrorString(e), grid);
#endif
}
```

```cpp
#include <hip/hip_runtime.h>
#include <hip/hip_cooperative_groups.h>
#include <cstdio>
#include <cstdint>
namespace cg = cooperative_groups;

constexpr int D = 1024, MP = 16384, MS = 512, M = MP + MS, NB = 136, SEQ = 2048;
constexpr int DR = 1280, DKT = 512, DVT = 1024, DFF = 2816, NINP = 7936, NMOD = 6144;
constexpr int X0 = 0, G0 = 1280, Q0 = 2560, K0 = 3072, V0 = 3584, R0 = 4608, GA0 = 5632, GB0 = 6656, LR0 = 7680;
constexpr float EPS = 1e-6f;

namespace pg8 {
#define PG8_LAS __attribute__((address_space(3)))
typedef unsigned short bf16_t;
typedef short bf16x8 __attribute__((ext_vector_type(8)));
typedef float f32x4 __attribute__((ext_vector_type(4)));
typedef unsigned u32x4 __attribute__((ext_vector_type(4)));
constexpr int BM = 256, BK = 64, HALF = 128, HTB = HALF * BK * 2  , STAGE_BYTES = 8 * HTB, NXCD = 8, WGM = 8;

__host__ __device__ __forceinline__ int lds_byte(int r, int c) { const int st = (r >> 4) * 2 + (c >> 5), rr = r & 15, cc = c & 31, ob = rr * 64 + cc * 2; return st * 1024 + (ob ^ (((ob >> 9) & 1) << 5)); }
__host__ __device__ __forceinline__ void stage_rc(int b, int& R, int& C) { const int st = b / 1024, sb = b % 1024, swz = sb ^ (((sb >> 9) & 1) << 5); R = (st >> 1) * 16 + swz / 64; C = (st & 1) * 32 + (swz % 64) / 2; }
__host__ __device__ __forceinline__ int perm32(int rho) { const int n = rho >> 4, i = rho & 15; return 8 * (i >> 2) + 4 * n + (i & 3); }

struct Unit { int pm, pn; };
struct Gemm { const bf16_t* A; const bf16_t* Bt; int M, N, K, lda, ldb; };

struct StaticOrder {
    int nM, nN, nwg, G, c;
    __host__ __device__ void init(int M, int N, int G_, int c_) { nM = M / BM; nN = N / BM; nwg = nM * nN; G = G_; c = c_; }
    __host__ __device__ bool next(int i, Unit& u) const {
        const long L = (long)i * G + c; if (L >= nwg) return false;
        int wgid = (int)L; { const int q = nwg / NXCD, r = nwg % NXCD, xcd = wgid % NXCD, off = wgid / NXCD; wgid = (xcd < r ? xcd * (q + 1) : r * (q + 1) + (xcd - r) * q) + off; }
        const int nig = WGM * nN, gid = wgid / nig, fm = gid * WGM, gsz = (nM - fm) < WGM ? (nM - fm) : WGM;
        u.pm = fm + ((wgid % nig) % gsz); u.pn = (wgid % nig) / gsz; return true;
    }
    __device__ __forceinline__ void a_ready(const Unit&) const {}
    __device__ __forceinline__ void done(const Unit&) const {}
};


typedef __bf16 bf16x2_t __attribute__((ext_vector_type(2)));
typedef float f32x2_t __attribute__((ext_vector_type(2)));
typedef unsigned u32x2 __attribute__((ext_vector_type(2)));
__device__ __forceinline__ unsigned cvtpk(float lo, float hi) { f32x2_t v = {lo, hi}; bf16x2_t b = __builtin_convertvector(v, bf16x2_t); return __builtin_bit_cast(unsigned, b); }
__device__ __forceinline__ float bflo(unsigned w) { return __uint_as_float(w << 16); }
__device__ __forceinline__ float bfhi(unsigned w) { return __uint_as_float(w & 0xffff0000u); }
__device__ __forceinline__ float bf2f(bf16_t h) { return __uint_as_float(((unsigned)h) << 16); }
__device__ __forceinline__ float fsigmoid(float z) { return __builtin_amdgcn_rcpf(1.0f + __builtin_amdgcn_exp2f(-1.4426950408889634f * z)); }
__device__ __forceinline__ float fexp(float z) { return __builtin_amdgcn_exp2f(1.4426950408889634f * z); }
__device__ __forceinline__ float act_apply(float x, int mode) {
    if (mode == 1) { const float z = 1.5957691216057308f * (x + 0.044715f * x * x * x); return x * fsigmoid(z); }
    if (mode == 2) return x * 0.08838834764831845f;
    if (mode == 3) return x * fsigmoid(x);
    if (mode == 4) return fsigmoid(x);
    return x;
}
__device__ __forceinline__ int row_batch(int row) { return row < MP ? (row >> 11) : 8 + ((row - MP) >> 2); }

struct EpiWin {
    static constexpr bool PERM = true, AFTER_DRAIN = false;
    bf16_t* U;
    __device__ __forceinline__ void operator()(const f32x4 (&acc)[2][2][4][2], const Unit& u, int wr, int wc, int fr, int fq) const {
        const int row0 = u.pm * BM + wr * 64 + fr, colt = u.pn * BM;
        int mode = 0;
        if (colt >= G0 && colt < Q0) mode = 1; else if (colt >= Q0 && colt < K0) mode = 2; else if (colt >= R0 && colt < GA0) mode = 3; else if (colt >= GA0 && colt < LR0) mode = 4;
        const int col0 = colt + wc * 32 + 8 * fq;
#pragma unroll
        for (int ai = 0; ai < 2; ++ai)
#pragma unroll
            for (int m = 0; m < 4; ++m) { bf16_t* rowp = U + (size_t)(row0 + ai * HALF + m * 16) * NINP + col0;
#pragma unroll
                for (int bj = 0; bj < 2; ++bj) { f32x4 v0 = acc[ai][bj][m][0], v1 = acc[ai][bj][m][1];
#pragma unroll
                    for (int e = 0; e < 4; ++e) { v0[e] = act_apply(v0[e], mode); v1[e] = act_apply(v1[e], mode); }
                    u32x4 w; w.x = cvtpk(v0[0], v0[1]); w.y = cvtpk(v0[2], v0[3]); w.z = cvtpk(v1[0], v1[1]); w.w = cvtpk(v1[2], v1[3]);
                    *(u32x4*)(rowp + bj * HALF) = w; }
                __builtin_amdgcn_sched_barrier(0); }
    }
};
struct EpiProj {
    static constexpr bool PERM = true, AFTER_DRAIN = false;
    const bf16_t* U; float* P; bf16_t* Mo; int second;
    __device__ __forceinline__ void operator()(const f32x4 (&acc)[2][2][4][2], const Unit& u, int wr, int wc, int fr, int fq) const {
        const int row0 = u.pm * BM + wr * 64 + fr, col0 = u.pn * BM + wc * 32 + 8 * fq; const int goff = second ? GB0 : GA0;
#pragma unroll
        for (int ai = 0; ai < 2; ++ai)
#pragma unroll
            for (int m = 0; m < 4; ++m) { const int row = row0 + ai * HALF + m * 16;
#pragma unroll
                for (int bj = 0; bj < 2; ++bj) { const int col = col0 + bj * HALF;
                    const u32x4 gw = *(const u32x4*)(U + (size_t)row * NINP + goff + col);
                    f32x4 g0 = {bflo(gw.x), bfhi(gw.x), bflo(gw.y), bfhi(gw.y)}, g1 = {bflo(gw.z), bfhi(gw.z), bflo(gw.w), bfhi(gw.w)};
                    f32x4 v0 = acc[ai][bj][m][0] * g0, v1 = acc[ai][bj][m][1] * g1;
                    float* pp = P + (size_t)row * D + col;
                    if (!second) { *(f32x4*)pp = v0; *(f32x4*)(pp + 4) = v1; }
                    else { v0 += *(const f32x4*)pp; v1 += *(const f32x4*)(pp + 4);
                        u32x4 w; w.x = cvtpk(v0[0], v0[1]); w.y = cvtpk(v0[2], v0[3]); w.z = cvtpk(v1[0], v1[1]); w.w = cvtpk(v1[2], v1[3]);
                        *(u32x4*)(Mo + (size_t)row * D + col) = w; } }
                __builtin_amdgcn_sched_barrier(0); }
    }
};
struct EpiRes {
    static constexpr bool PERM = false, AFTER_DRAIN = false;
    const float* base_p; const float* base_s; float* out; const float* gate;
    __device__ __forceinline__ void operator()(const f32x4 (&acc)[2][2][4][2], const Unit& u, int wr, int wc, int fr, int fq) const {
        const int row0 = u.pm * BM + wr * 64 + fr, col0 = u.pn * BM + wc * 32 + 4 * fq;
#pragma unroll
        for (int ai = 0; ai < 2; ++ai)
#pragma unroll
            for (int m = 0; m < 4; ++m) { const int row = row0 + ai * HALF + m * 16; const float* bp = row < MP ? base_p + (size_t)row * D : base_s + (size_t)(row - MP) * D;
                const float* gp = gate + (size_t)row_batch(row) * NMOD; float* op = out + (size_t)row * D;
#pragma unroll
                for (int bj = 0; bj < 2; ++bj)
#pragma unroll
                    for (int n = 0; n < 2; ++n) { const int col = col0 + bj * HALF + n * 16;
                        const f32x4 b = *(const f32x4*)(bp + col), g = *(const f32x4*)(gp + col);
                        *(f32x4*)(op + col) = b + g * acc[ai][bj][m][n]; }
                __builtin_amdgcn_sched_barrier(0); }
    }
};
struct EpiSwiglu {
    static constexpr bool PERM = true, AFTER_DRAIN = false;
    bf16_t* O;
    __device__ __forceinline__ void operator()(const f32x4 (&acc)[2][2][4][2], const Unit& u, int wr, int wc, int fr, int fq) const {
        const int row0 = u.pm * BM + wr * 64 + fr, col0 = u.pn * HALF + wc * 32 + 8 * fq;
#pragma unroll
        for (int ai = 0; ai < 2; ++ai)
#pragma unroll
            for (int m = 0; m < 4; ++m) { f32x4 v0, v1;
#pragma unroll
                for (int e = 0; e < 4; ++e) { const float a0 = acc[ai][0][m][0][e], a1 = acc[ai][0][m][1][e]; v0[e] = a0 * fsigmoid(a0) * acc[ai][1][m][0][e]; v1[e] = a1 * fsigmoid(a1) * acc[ai][1][m][1][e]; }
                u32x4 w; w.x = cvtpk(v0[0], v0[1]); w.y = cvtpk(v0[2], v0[3]); w.z = cvtpk(v1[0], v1[1]); w.w = cvtpk(v1[2], v1[3]);
                *(u32x4*)(O + (size_t)(row0 + ai * HALF + m * 16) * DFF + col0) = w;
                __builtin_amdgcn_sched_barrier(0); }
    }
};
struct EpiMod {
    static constexpr bool PERM = false, AFTER_DRAIN = false;
    float* out; const float* bias;
    __device__ __forceinline__ void operator()(const f32x4 (&acc)[2][2][4][2], const Unit& u, int wr, int wc, int fr, int fq) const {
        const int row0 = u.pm * BM + wr * 64 + fr, col0 = u.pn * BM + wc * 32 + 4 * fq;
#pragma unroll
        for (int ai = 0; ai < 2; ++ai)
#pragma unroll
            for (int m = 0; m < 4; ++m) { const int row = row0 + ai * HALF + m * 16; if (row < NB) {
#pragma unroll
                for (int bj = 0; bj < 2; ++bj)
#pragma unroll
                    for (int n = 0; n < 2; ++n) { const int col = col0 + bj * HALF + n * 16;
                        *(f32x4*)(out + (size_t)row * NMOD + col) = acc[ai][bj][m][n] + *(const f32x4*)(bias + col); } } }
    }
};

template <class Epi, class Sched, bool ALIGN_EPI = false, bool SP2 = false>
__device__ __forceinline__ void gemm_phase(PG8_LAS unsigned char* lds, const Gemm g, const Sched& S, const Epi& E) {
    int tid_ = threadIdx.x; asm volatile("" : "+v"(tid_));
    const int tid = tid_, wid = __builtin_amdgcn_readfirstlane(tid >> 6), lane = tid & 63, wr = wid >> 2, wc = wid & 3, fr = lane & 15, fq = lane >> 4;
    const int K = g.K, nt = K / BK;
    unsigned voffA[2], voffB[2];
#pragma unroll
    for (int i = 0; i < 2; ++i) { int R, C; stage_rc(tid * 16 + i * 8192, R, C); const int Rb = Epi::PERM ? ((R & ~31) + perm32(R & 31)) : R;
        voffA[i] = (unsigned)(R * g.lda + C) * 2u; voffB[i] = (unsigned)(Rb * g.ldb + C) * 2u; }
    const size_t kstep = (size_t)(BK * 2);
    const size_t hstepA = (size_t)HALF * g.lda * 2, hstepB = (size_t)HALF * g.ldb * 2;
    const size_t tstepA = 2 * hstepA, tstepB = 2 * hstepB;
    const unsigned ldsw = (unsigned)wid * 1024u;
    const int aoff = lds_byte(wr * 64 + fr, fq * 8), boff = lds_byte(wc * 32 + fr, fq * 8);
#define PG8_SA(b, h) (((b) * 2 + (h)) * HTB)
#define PG8_SB(b, h) ((4 + (b) * 2 + (h)) * HTB)
#define PG8_STAGE(bufoff, gbase, voff) do { _Pragma("unroll") for (int _i = 0; _i < 2; ++_i) \
        __builtin_amdgcn_global_load_lds((const unsigned*)((const char*)(gbase) + (voff)[_i]), (PG8_LAS unsigned*)(lds + (bufoff) + ldsw + _i * 8192), 16, 0, 0); } while (0)
#define PG8_LDA(dst, b, h) do { _Pragma("unroll") for (int m = 0; m < 4; ++m) _Pragma("unroll") for (int k = 0; k < 2; ++k) dst[m][k] = *(const PG8_LAS bf16x8*)(lds + PG8_SA(b, h) + aoff + m * 2048 + k * 1024); } while (0)
#define PG8_LDB(dst, b, h) do { _Pragma("unroll") for (int n = 0; n < 2; ++n) _Pragma("unroll") for (int k = 0; k < 2; ++k) dst[n][k] = *(const PG8_LAS bf16x8*)(lds + PG8_SB(b, h) + boff + n * 2048 + k * 1024); } while (0)
#define PG8_MMA(ai, bj, At, Bt) do { __builtin_amdgcn_s_setprio(1); _Pragma("unroll") for (int m = 0; m < 4; ++m) _Pragma("unroll") for (int n = 0; n < 2; ++n) _Pragma("unroll") for (int k = 0; k < 2; ++k) \
        acc[ai][bj][m][n] = __builtin_amdgcn_mfma_f32_16x16x32_bf16(Bt[n][k], At[m][k], acc[ai][bj][m][n], 0, 0, 0); __builtin_amdgcn_s_setprio(0); } while (0)
#define PG8_WAIT_V(n) asm volatile("s_waitcnt vmcnt(" #n ")" ::: "memory")
#define PG8_WAIT_L(n) asm volatile("s_waitcnt lgkmcnt(" #n ")" ::: "memory")
#define PG8_BAR __builtin_amdgcn_s_barrier()
#define PG8_SCHED __builtin_amdgcn_sched_barrier(0)
    Unit cur, nxt; int ui = 0;
    if (!S.next(0, cur)) return;
    f32x4 acc[2][2][4][2];
#pragma unroll
    for (int a = 0; a < 2; ++a)
#pragma unroll
        for (int b = 0; b < 2; ++b)
#pragma unroll
            for (int m = 0; m < 4; ++m)
#pragma unroll
                for (int n = 0; n < 2; ++n) acc[a][b][m][n] = (f32x4){0.f, 0.f, 0.f, 0.f};
    bf16x8 At[4][2], B0[2][2], B1[2][2];
    const char* cA = (const char*)g.A + (size_t)cur.pm * tstepA; const char* cB = (const char*)g.Bt + (size_t)cur.pn * tstepB;
    S.a_ready(cur);
    if constexpr (SP2) {
        PG8_STAGE(PG8_SB(0, 0), cB, voffB); PG8_STAGE(PG8_SB(0, 1), cB + hstepB, voffB); PG8_STAGE(PG8_SA(0, 0), cA, voffA); PG8_STAGE(PG8_SA(0, 1), cA + hstepA, voffA);
        if (wr == 1) PG8_BAR;
        PG8_WAIT_V(2); PG8_BAR;
        PG8_STAGE(PG8_SB(1, 0), cB + kstep, voffB); PG8_STAGE(PG8_SA(1, 0), cA + kstep, voffA); PG8_STAGE(PG8_SB(1, 1), cB + hstepB + kstep, voffB);
        PG8_WAIT_V(6); PG8_BAR;
    } else {
        PG8_STAGE(PG8_SB(0, 0), cB, voffB); PG8_STAGE(PG8_SA(0, 0), cA, voffA); PG8_STAGE(PG8_SB(0, 1), cB + hstepB, voffB); PG8_STAGE(PG8_SA(0, 1), cA + hstepA, voffA);
        if (wr == 1) PG8_BAR;
        PG8_WAIT_V(4); PG8_BAR;
        PG8_STAGE(PG8_SB(1, 0), cB + kstep, voffB); PG8_STAGE(PG8_SA(1, 0), cA + kstep, voffA); PG8_STAGE(PG8_SB(1, 1), cB + hstepB + kstep, voffB);
        PG8_WAIT_V(6); PG8_BAR;
    }
    for (;;) {
        const bool has_next = S.next(ui + 1, nxt);
        const char* nA = has_next ? (const char*)g.A + (size_t)nxt.pm * tstepA : cA; const char* nB = has_next ? (const char*)g.Bt + (size_t)nxt.pn * tstepB : cB;
        for (int t = 0; t < nt; t += 2) {
            const bool last = (t == nt - 2);
            const char* a1 = cA + (size_t)(t + 1) * kstep;
            const char* a2 = last ? nA : cA + (size_t)(t + 2) * kstep; const char* b2 = last ? nB : cB + (size_t)(t + 2) * kstep;
            const char* a3 = a2 + kstep; const char* b3 = b2 + kstep;
            if (last && has_next) S.a_ready(nxt);
            if constexpr (SP2) {
            PG8_LDB(B0, 0, 0); PG8_LDB(B1, 0, 1); PG8_SCHED; PG8_LDA(At, 0, 0); PG8_STAGE(PG8_SA(1, 1), a1 + hstepA, voffA);
            PG8_WAIT_V(8); PG8_WAIT_L(0); PG8_BAR; PG8_MMA(0, 0, At, B0); PG8_MMA(0, 1, At, B1); PG8_BAR; PG8_SCHED;
            PG8_LDA(At, 0, 1); PG8_STAGE(PG8_SB(0, 0), b2, voffB); PG8_STAGE(PG8_SB(0, 1), b2 + hstepB, voffB); PG8_STAGE(PG8_SA(0, 0), a2, voffA);
            PG8_WAIT_V(8); PG8_WAIT_L(0); PG8_BAR; PG8_MMA(1, 0, At, B0); PG8_MMA(1, 1, At, B1); PG8_BAR; PG8_SCHED;
            PG8_LDB(B0, 1, 0); PG8_LDB(B1, 1, 1); PG8_SCHED; PG8_LDA(At, 1, 0); PG8_STAGE(PG8_SA(0, 1), a2 + hstepA, voffA);
            PG8_WAIT_V(8); PG8_WAIT_L(0); PG8_BAR; PG8_MMA(0, 0, At, B0); PG8_MMA(0, 1, At, B1); PG8_BAR; PG8_SCHED;
            PG8_LDA(At, 1, 1); PG8_STAGE(PG8_SB(1, 0), b3, voffB); PG8_STAGE(PG8_SB(1, 1), b3 + hstepB, voffB); PG8_STAGE(PG8_SA(1, 0), a3, voffA);
            PG8_WAIT_V(8); PG8_WAIT_L(0); PG8_BAR; PG8_MMA(1, 0, At, B0); PG8_MMA(1, 1, At, B1); PG8_BAR; PG8_SCHED;
            } else {
            PG8_LDB(B0, 0, 0); PG8_SCHED; PG8_LDA(At, 0, 0); PG8_STAGE(PG8_SA(1, 1), a1 + hstepA, voffA);
            PG8_WAIT_L(8); PG8_BAR; PG8_WAIT_L(0); PG8_MMA(0, 0, At, B0); PG8_BAR; PG8_SCHED;
            PG8_LDB(B1, 0, 1); PG8_STAGE(PG8_SB(0, 0), b2, voffB);
            PG8_BAR; PG8_WAIT_L(0); PG8_MMA(0, 1, At, B1); PG8_BAR;
            PG8_LDA(At, 0, 1); PG8_STAGE(PG8_SA(0, 0), a2, voffA);
            PG8_BAR; PG8_WAIT_L(0); PG8_MMA(1, 0, At, B0); PG8_BAR; PG8_SCHED;
            PG8_STAGE(PG8_SB(0, 1), b2 + hstepB, voffB);
            PG8_WAIT_V(6); PG8_BAR; PG8_MMA(1, 1, At, B1); PG8_BAR;
            PG8_LDB(B0, 1, 0); PG8_SCHED; PG8_LDA(At, 1, 0); PG8_STAGE(PG8_SA(0, 1), a2 + hstepA, voffA);
            PG8_WAIT_L(8); PG8_BAR; PG8_WAIT_L(0); PG8_MMA(0, 0, At, B0); PG8_BAR; PG8_SCHED;
            PG8_LDB(B1, 1, 1); PG8_STAGE(PG8_SB(1, 0), b3, voffB);
            PG8_BAR; PG8_WAIT_L(0); PG8_MMA(0, 1, At, B1); PG8_BAR;
            PG8_LDA(At, 1, 1); PG8_STAGE(PG8_SA(1, 0), a3, voffA);
            PG8_BAR; PG8_WAIT_L(0); PG8_MMA(1, 0, At, B0); PG8_BAR; PG8_SCHED;
            PG8_STAGE(PG8_SB(1, 1), b3 + hstepB, voffB);
            PG8_WAIT_V(6); PG8_BAR; PG8_MMA(1, 1, At, B1); PG8_BAR;
            }
        }
        if constexpr (ALIGN_EPI) { if (wr == 0) PG8_BAR; }
        if constexpr (!Epi::AFTER_DRAIN) { E(acc, cur, wr, wc, fr, fq); S.done(cur); }
        if (!has_next) break;
#pragma unroll
        for (int a = 0; a < 2; ++a)
#pragma unroll
            for (int b = 0; b < 2; ++b)
#pragma unroll
                for (int m = 0; m < 4; ++m)
#pragma unroll
                    for (int n = 0; n < 2; ++n) acc[a][b][m][n] = (f32x4){0.f, 0.f, 0.f, 0.f};
        cur = nxt; cA = nA; cB = nB; ++ui;
        if constexpr (ALIGN_EPI) { if (wr == 1) PG8_BAR; }
    }
    PG8_WAIT_V(0);
    if constexpr (!ALIGN_EPI) { if (wr == 0) PG8_BAR; }
    PG8_BAR;
    if constexpr (Epi::AFTER_DRAIN) { E.fused(acc, cur, wr, wc, fr, fq, lds, wid, lane); S.done(cur); }
#undef PG8_SA
#undef PG8_SB
#undef PG8_STAGE
#undef PG8_LDA
#undef PG8_LDB
#undef PG8_MMA
#undef PG8_WAIT_V
#undef PG8_WAIT_L
#undef PG8_BAR
#undef PG8_SCHED
}
}

#define LAS __attribute__((address_space(3)))
typedef unsigned short bf16;
typedef float f32x4 __attribute__((ext_vector_type(4)));
typedef short bf16x8 __attribute__((ext_vector_type(8)));
typedef short bf16x4 __attribute__((ext_vector_type(4)));
typedef unsigned u32x4 __attribute__((ext_vector_type(4)));
typedef unsigned u32x2 __attribute__((ext_vector_type(2)));
using pg8::cvtpk; using pg8::bflo; using pg8::bfhi; using pg8::bf2f; using pg8::fsigmoid; using pg8::fexp; using pg8::row_batch;
constexpr int NWAVES = 8, NTHR = 512, LDS_BYTES = 147456;
constexpr size_t MiB = 1u << 20;
constexpr size_t WS_WIN = 1 * MiB;
constexpr size_t SZ_WIN = (size_t)NINP * D * 2;
constexpr size_t WS_WPJ = WS_WIN + 2 * SZ_WIN;
constexpr size_t SZ_WPJ = (size_t)D * (DR + DVT) * 2;
constexpr size_t WS_WOUT = WS_WPJ + 2 * SZ_WPJ;
constexpr size_t SZ_WOUT = (size_t)D * D * 2;
constexpr size_t WS_W1 = WS_WOUT + 2 * SZ_WOUT;
constexpr size_t SZ_W1 = (size_t)2 * DFF * D * 2;
constexpr size_t WS_W2 = WS_W1 + 2 * SZ_W1;
constexpr size_t SZ_W2 = (size_t)D * DFF * 2;
constexpr size_t WS_ADA = WS_W2 + 2 * SZ_W2;
constexpr size_t SZ_ADA = (size_t)NMOD * D * 2;
constexpr size_t WS_WG = WS_ADA + 2 * SZ_ADA;
constexpr size_t SZ_WG = (size_t)10 * 256 * 128 * 2;
constexpr size_t WS_CS = WS_WG + 2 * SZ_WG;
constexpr size_t WS_MOD = WS_CS + (size_t)256 * D * 2;
constexpr size_t SZ_MOD = (size_t)NB * NMOD * 4;
constexpr size_t WS_HN = ((WS_MOD + 2 * SZ_MOD + MiB - 1) / MiB) * MiB;
constexpr size_t WS_U = WS_HN + (size_t)M * D * 2;
constexpr size_t WS_P = WS_U + (size_t)M * NINP * 2;
constexpr size_t WS_END = WS_P + (size_t)M * D * 4;
constexpr size_t WS_KD = WS_P;
constexpr size_t WS_EL = WS_P + 32 * MiB;
static_assert(WS_KD + (size_t)1536 * 16384 <= WS_EL && WS_EL + (size_t)1536 * 512 <= WS_END, "KD/EL overlay P");

struct Args {
    const float* in[28]; float* out; unsigned char* ws; int ph_lo, ph_hi;
};
constexpr size_t O_Y = 0, O_CONVP = (size_t)M * D, O_LRUP = O_CONVP + 2 * 8 * 3 * DR, O_GLAP = O_LRUP + 2 * 8 * DR, O_CONVS = O_GLAP + (size_t)2 * 8 * 4 * 128 * 256,
                 O_LRUS = O_CONVS + (size_t)2 * 128 * 3 * DR, O_GLAS = O_LRUS + (size_t)2 * 128 * DR, O_END = O_GLAS + (size_t)2 * 128 * 4 * 128 * 256;

__device__ __forceinline__ float bperm(int srclane, float v) { return __int_as_float(__builtin_amdgcn_ds_bpermute(srclane << 2, __float_as_int(v))); }
__device__ __forceinline__ float wave_sum(float v, int lane) {
#pragma unroll
    for (int o = 1; o < 64; o <<= 1) v += bperm(lane ^ o, v);
    return v;
}
__device__ __forceinline__ int src_col(int np, int mapmode) {
    if (mapmode == 1) { if (np < GA0) return np; if (np < LR0) return np + 16; if (np < LR0 + 16) return np - LR0 + 5632; return -1; }
    if (mapmode == 2) { const int pn = np >> 8, bj = (np >> 7) & 1, j = np & 127; return bj * DFF + pn * 128 + j; }
    return np;
}
__device__ __forceinline__ void transpose_item(const float* W, int K, int N, bf16* WT, int ldt, int koff, int nblk, int mapmode, LAS float* scr, int item, int lane) {
    const int kb = item / nblk, nb = item % nblk, k0 = 64 * kb, n0 = 32 * nb;
    const int sc = src_col(n0 + (lane & 31), mapmode);
#pragma unroll 8
    for (int i = 0; i < 32; ++i) { const int kk = 2 * i + (lane >> 5); scr[kk * 33 + (lane & 31)] = sc >= 0 ? W[(size_t)(k0 + kk) * N + sc] : 0.f; }
    asm volatile("s_waitcnt lgkmcnt(0)" ::: "memory");
    const int c = lane & 7;
#pragma unroll
    for (int j = 0; j < 4; ++j) { const int n = (lane >> 3) + 8 * j; const LAS float* s = scr + (8 * c) * 33 + n;
        u32x4 o; o.x = cvtpk(s[0 * 33], s[1 * 33]); o.y = cvtpk(s[2 * 33], s[3 * 33]); o.z = cvtpk(s[4 * 33], s[5 * 33]); o.w = cvtpk(s[6 * 33], s[7 * 33]);
        *(u32x4*)(WT + (size_t)(n0 + n) * ldt + koff + k0 + 8 * c) = o; }
    asm volatile("s_waitcnt lgkmcnt(0)" ::: "memory");
}
__device__ __forceinline__ void norm_row(const float* xrow, const float* g, const float* sc, const float* sh, bf16* orow, float* orow_f, int lane) {
    const f32x4* xr = (const f32x4*)xrow + lane; f32x4 v[4]; float s = 0.f;
#pragma unroll
    for (int j = 0; j < 4; ++j) { v[j] = xr[64 * j]; s += (v[j].x * v[j].x + v[j].y * v[j].y) + (v[j].z * v[j].z + v[j].w * v[j].w); }
    const float rstd = 1.0f / sqrtf(wave_sum(s, lane) * (1.0f / D) + EPS);
#pragma unroll
    for (int j = 0; j < 4; ++j) { const int col = 4 * lane + 256 * j; const f32x4 gg = *(const f32x4*)(g + col);
        f32x4 o = v[j] * rstd * gg;
        if (orow_f) { *(f32x4*)(orow_f + col) = o; }
        else { const f32x4 a = *(const f32x4*)(sc + col), b = *(const f32x4*)(sh + col); o = o * (a + 1.0f) + b;
            u32x2 w; w.x = cvtpk(o.x, o.y); w.y = cvtpk(o.z, o.w); *(u32x2*)(orow + col) = w; } }
}

struct ScanP { int l; };
typedef const float* fptr_t;
__device__ __forceinline__ fptr_t inp(int i) {
    const __attribute__((address_space(4))) unsigned char* kp = (const __attribute__((address_space(4))) unsigned char*)__builtin_amdgcn_kernarg_segment_ptr();
    asm volatile("" : "+s"(kp));
    return *(const __attribute__((address_space(4))) fptr_t*)(kp + 8 * i);
}
#define WSP ((unsigned char*)inp(29))
#define OUTP ((float*)inp(28))
__device__ __forceinline__ bf16 f2bf1(float x) { return (bf16)(cvtpk(x, 0.f) & 0xffffu); }
#define MFMA16(a, b, c) __builtin_amdgcn_mfma_f32_16x16x32_bf16((a), (b), (c), 0, 0, 0)

template <bool SAMPLE>
__device__ __forceinline__ void lru_item(LAS unsigned char* lds, const ScanP& P, int item, int dry = 0) {
    int tid_ = threadIdx.x; asm volatile("" : "+v"(tid_));
    const int tid = tid_, lane = tid & 63, w = __builtin_amdgcn_readfirstlane(tid >> 6), fr = lane & 15, fq = lane >> 4;
    const int n = item % 10, bb = item / 10;
    const int row0 = SAMPLE ? MP + bb * 64 : bb * SEQ;
    const int nch = SAMPLE ? 1 : SEQ / 64;
    LAS bf16* XC = (LAS bf16*)lds;
    const int l = P.l; bf16* const U = (bf16*)(WSP + WS_U);
    const bf16* wg = (const bf16*)(WSP + WS_WG + l * SZ_WG) + (size_t)n * 256 * 128;
    bf16x8 Bw[2][4];
#pragma unroll
    for (int nt = 0; nt < 2; ++nt)
#pragma unroll
        for (int ks = 0; ks < 4; ++ks) Bw[nt][ks] = *(const bf16x8*)(wg + (size_t)(nt * 128 + 16 * w + fr) * 128 + 32 * ks + 8 * fq);
    const int ch = n * 128 + 16 * w + fr;
    const float ba = (inp(15) + (size_t)l * DR)[ch], bx = (inp(17) + (size_t)l * DR)[ch], lam = (inp(18) + (size_t)l * DR)[ch];
    const float cl = -8.0f * log1pf(expf(-lam));
    const int cg = tid & 15, tt = tid >> 4, cch = n * 128 + 8 * cg;
    float cw[4][8], cb[8];
#pragma unroll
    for (int i = 0; i < 4; ++i)
#pragma unroll
        for (int j = 0; j < 8; ++j) cw[i][j] = (inp(12) + (size_t)l * 4 * DR)[i * DR + cch + j];
#pragma unroll
    for (int j = 0; j < 8; ++j) cb[j] = (inp(13) + (size_t)l * DR)[cch + j];
    const float* const st_conv = SAMPLE ? inp(4) + (size_t)l * 128 * 3 * DR : nullptr; const float* const st_lru = SAMPLE ? inp(5) + (size_t)l * 128 * DR : nullptr;
    float* const o_lru_s = OUTP + O_LRUS + (size_t)l * 128 * DR;
    float hc = 0.f;
    u32x4 uq[2][4];
#define LRU_LOADC(c_) do { _Pragma("unroll") for (int p = 0; p < 2; ++p) _Pragma("unroll") for (int d = 0; d < 4; ++d) { const int tl_ = tt + 32 * p; const u32x4 z4 = {0u, 0u, 0u, 0u}; uq[p][d] = z4; \
        if ((c_) * 64 + tl_ - d >= 0) uq[p][d] = *(const u32x4*)(U + (size_t)(row0 + (c_) * 64 + tl_ - d) * NINP + X0 + cch); } } while (0)
    if (!SAMPLE) LRU_LOADC(0);
    for (int c = 0; c < nch; ++c) {
        const int r0 = row0 + c * 64;
#pragma unroll
        for (int p = 0; p < 2; ++p) {
            const int tl = tt + 32 * p; float xc[8];
#pragma unroll
            for (int j = 0; j < 8; ++j) xc[j] = cb[j];
#pragma unroll
            for (int d = 0; d < 4; ++d) {
                float uv[8];
                bool from_u, zero = false;
                if (!SAMPLE) { from_u = (c * 64 + tl - d) >= 0; zero = !from_u; } else { from_u = ((tl & 3) - d) >= 0; }
                if (!SAMPLE) { const u32x4 q = uq[p][d];
                    uv[0] = bflo(q.x); uv[1] = bfhi(q.x); uv[2] = bflo(q.y); uv[3] = bfhi(q.y); uv[4] = bflo(q.z); uv[5] = bfhi(q.z); uv[6] = bflo(q.w); uv[7] = bfhi(q.w); }
                else if (from_u) { const u32x4 q = *(const u32x4*)(U + (size_t)(r0 + tl - d) * NINP + X0 + cch);
                    uv[0] = bflo(q.x); uv[1] = bfhi(q.x); uv[2] = bflo(q.y); uv[3] = bfhi(q.y); uv[4] = bflo(q.z); uv[5] = bfhi(q.z); uv[6] = bflo(q.w); uv[7] = bfhi(q.w); }
                else if (zero) {
#pragma unroll
                    for (int j = 0; j < 8; ++j) uv[j] = 0.f; }
                else { const int b = bb * 16 + (tl >> 2); const float* sp = st_conv + ((size_t)b * 3 + (3 + (tl & 3) - d)) * DR + cch;
                    const f32x4 s0 = *(const f32x4*)sp, s1 = *(const f32x4*)(sp + 4);
                    uv[0] = s0.x; uv[1] = s0.y; uv[2] = s0.z; uv[3] = s0.w; uv[4] = s1.x; uv[5] = s1.y; uv[6] = s1.z; uv[7] = s1.w; }
#pragma unroll
                for (int j = 0; j < 8; ++j) xc[j] += cw[3 - d][j] * uv[j];
            }
            u32x4 o; o.x = cvtpk(xc[0], xc[1]); o.y = cvtpk(xc[2], xc[3]); o.z = cvtpk(xc[4], xc[5]); o.w = cvtpk(xc[6], xc[7]);
            *(LAS u32x4*)(XC + tl * 136 + 8 * cg) = o;
        }
        __syncthreads();
        if (!SAMPLE && c + 1 < nch) LRU_LOADC(c + 1);
        bf16 gv[4][4];
#pragma unroll
        for (int mt = 0; mt < 4; ++mt)
#pragma unroll
            for (int e = 0; e < 4; ++e) gv[mt][e] = U[(size_t)(r0 + 16 * mt + 4 * fq + e) * NINP + G0 + ch];
        f32x4 acc[4][2];
#pragma unroll
        for (int mt = 0; mt < 4; ++mt) { acc[mt][0] = (f32x4){0.f, 0.f, 0.f, 0.f}; acc[mt][1] = (f32x4){0.f, 0.f, 0.f, 0.f};
#pragma unroll
            for (int ks = 0; ks < 4; ++ks) { const bf16x8 a = *(const LAS bf16x8*)(XC + (16 * mt + fr) * 136 + 32 * ks + 8 * fq);
                acc[mt][0] = MFMA16(a, Bw[0][ks], acc[mt][0]); acc[mt][1] = MFMA16(a, Bw[1][ks], acc[mt][1]); } }
#pragma unroll
        for (int mt = 0; mt < 4; ++mt) {
            float Pe[4], Qe[4];
#pragma unroll
            for (int e = 0; e < 4; ++e) { const int tl = 16 * mt + 4 * fq + e;
                const float r = fsigmoid(acc[mt][0][e] + ba), ii = fsigmoid(acc[mt][1][e] + bx), la = cl * r, a = fexp(la), x2 = 2.0f * la;
                const float om = (x2 > -0.1f) ? -x2 * (1.0f + x2 * (0.5f + x2 * (0.16666667f + x2 * 0.041666668f))) : 1.0f - a * a;
                const float xcv = bf2f(XC[tl * 136 + 16 * w + fr]), bv = __builtin_amdgcn_sqrtf(om) * ii * xcv;
                if (e == 0) { Pe[0] = a; Qe[0] = bv; } else { Pe[e] = a * Pe[e - 1]; Qe[e] = a * Qe[e - 1] + bv; } }
            float hin;
            if (!SAMPLE) {
                float Pi = Pe[3], Qi = Qe[3];
                { const float Pp = bperm(lane - 16, Pi), Qp = bperm(lane - 16, Qi); if (fq >= 1) { Qi = Pi * Qp + Qi; Pi = Pi * Pp; } }
                { const float Pp = bperm(lane - 32, Pi), Qp = bperm(lane - 32, Qi); if (fq >= 2) { Qi = Pi * Qp + Qi; Pi = Pi * Pp; } }
                float Px = bperm(lane - 16, Pi), Qx = bperm(lane - 16, Qi); if (fq == 0) { Px = 1.f; Qx = 0.f; }
                hin = Px * hc + Qx;
            } else { hin = st_lru[(size_t)(bb * 16 + 4 * mt + fq) * DR + ch]; }
            float hv[4];
#pragma unroll
            for (int e = 0; e < 4; ++e) hv[e] = Pe[e] * hin + Qe[e];
            if (!SAMPLE) hc = bperm(48 + fr, hv[3]); else if (!dry) o_lru_s[(size_t)(bb * 16 + 4 * mt + fq) * DR + ch] = hv[3];
#pragma unroll
            for (int e = 0; e < 4; ++e) if (!dry || hv[e] == 1.2345e30f) U[(size_t)(r0 + 16 * mt + 4 * fq + e) * NINP + G0 + ch] = f2bf1(hv[e] * bf2f(gv[mt][e]));
        }
        __syncthreads();
    }
#undef LRU_LOADC
    if (dry) return;
    if (!SAMPLE) {
        if (fq == 0) (OUTP + O_LRUP + (size_t)l * 8 * DR)[(size_t)bb * DR + ch] = hc;
        if (tid < 384) { const int j = tid >> 7, cc = tid & 127; (OUTP + O_CONVP + (size_t)l * 8 * 3 * DR)[((size_t)bb * 3 + j) * DR + n * 128 + cc] = bf2f(U[(size_t)(row0 + SEQ - 3 + j) * NINP + X0 + n * 128 + cc]); }
    } else {
        for (int idx = tid; idx < 6144; idx += NTHR) { const int s = idx / 384, rem = idx % 384, j = rem >> 7, cc = rem & 127;
            (OUTP + O_CONVS + (size_t)l * 128 * 3 * DR)[((size_t)(bb * 16 + s) * 3 + j) * DR + n * 128 + cc] = bf2f(U[(size_t)(row0 + 4 * s + 1 + j) * NINP + X0 + n * 128 + cc]); }
    }
}

__device__ __forceinline__ void gla_prep(LAS unsigned char* lds, int l, int item, int dry = 0) {
    int tid_ = threadIdx.x; asm volatile("" : "+v"(tid_));
    const int tid = tid_;
    LAS float* LRS = (LAS float*)lds; LAS float* TOT = (LAS float*)(lds + 4096);
    const int cidx = item >> 2, h = item & 3;
    const int r0 = cidx < 256 ? (cidx >> 5) * SEQ + (cidx & 31) * 64 : MP + 4 * (cidx - 256), nv = cidx < 256 ? 64 : 4;
    const int c = tid & 127, tg = tid >> 7;
    bf16* const U = (bf16*)(WSP + WS_U);
    float wa2c[16];
#pragma unroll
    for (int r = 0; r < 16; ++r) wa2c[r] = (inp(19) + (size_t)l * 16 * DKT)[r * DKT + h * 128 + c];
    const float gba = (inp(20) + (size_t)l * DKT)[h * 128 + c];
    if (tid < 128) { const int t = tid >> 1, hf = tid & 1; u32x4 a = {0u, 0u, 0u, 0u};
        if (t < nv) a = *(const u32x4*)(U + (size_t)(r0 + t) * NINP + LR0 + 8 * hf);
        const f32x4 l0 = {bflo(a.x), bfhi(a.x), bflo(a.y), bfhi(a.y)}, l1 = {bflo(a.z), bfhi(a.z), bflo(a.w), bfhi(a.w)};
        *(LAS f32x4*)(LRS + t * 16 + 8 * hf) = l0; *(LAS f32x4*)(LRS + t * 16 + 8 * hf + 4) = l1; }
    float qv[16], kv[16];
#pragma unroll
    for (int i = 0; i < 16; ++i) { const int t = 16 * tg + i; qv[i] = 0.f; kv[i] = 0.f;
        if (t < nv) { const bf16* up = U + (size_t)(r0 + t) * NINP + h * 128 + c; qv[i] = bf2f(up[Q0]); kv[i] = bf2f(up[K0]); } }
    __syncthreads();
    float bc[16]; float run = 0.f;
#pragma unroll
    for (int i = 0; i < 16; ++i) { const int t = 16 * tg + i; float g = 0.f;
        if (t < nv) { const LAS f32x4* lp = (const LAS f32x4*)(LRS + t * 16); const f32x4 a = lp[0], b = lp[1], cc = lp[2], d = lp[3];
            float pre = gba;
            pre += wa2c[0] * a.x + wa2c[1] * a.y + wa2c[2] * a.z + wa2c[3] * a.w + wa2c[4] * b.x + wa2c[5] * b.y + wa2c[6] * b.z + wa2c[7] * b.w;
            pre += wa2c[8] * cc.x + wa2c[9] * cc.y + wa2c[10] * cc.z + wa2c[11] * cc.w + wa2c[12] * d.x + wa2c[13] * d.y + wa2c[14] * d.z + wa2c[15] * d.w;
            g = (fminf(pre, 0.f) - __logf(1.0f + fexp(-fabsf(pre)))) * 0.0625f; }
        run += g; bc[i] = run; }
    TOT[tg * 128 + c] = run;
    __syncthreads();
    float off = 0.f, blast = 0.f;
#pragma unroll
    for (int j = 0; j < 4; ++j) { const float v = TOT[j * 128 + c]; blast += v; if (j < tg) off += v; }
    float kdv[16];
#pragma unroll
    for (int i = 0; i < 16; ++i) { const int t = 16 * tg + i; const float bci = bc[i] + off;
        if (t < nv && !dry) { bf16* up = U + (size_t)(r0 + t) * NINP + h * 128 + c; up[Q0] = f2bf1(qv[i] * fexp(bci)); up[K0] = f2bf1(kv[i] * fexp(-bci)); }
        kdv[i] = kv[i] * fexp(blast - bci); }
    { u32x4 k0, k1; k0.x = cvtpk(kdv[0], kdv[1]); k0.y = cvtpk(kdv[2], kdv[3]); k0.z = cvtpk(kdv[4], kdv[5]); k0.w = cvtpk(kdv[6], kdv[7]);
      k1.x = cvtpk(kdv[8], kdv[9]); k1.y = cvtpk(kdv[10], kdv[11]); k1.z = cvtpk(kdv[12], kdv[13]); k1.w = cvtpk(kdv[14], kdv[15]);
      bf16* kd = (bf16*)(WSP + WS_KD) + (size_t)item * 8192 + c * 64 + 16 * tg; if (!dry || k0.x == 0x12345u) { *(u32x4*)kd = k0; *(u32x4*)(kd + 8) = k1; } }
    if (tg == 0 && !dry) ((float*)(WSP + WS_EL))[(size_t)item * 128 + c] = fexp(blast);
    __syncthreads();
}

__device__ __forceinline__ void gla_rec(LAS unsigned char* lds, int l, int h, int vh, int row_base, int nch, int nv_last, int cidx0, const float* S0, float* ST, int dry = 0) {
    int tid_ = threadIdx.x; asm volatile("" : "+v"(tid_));
    const int tid = tid_, lane = tid & 63, w = __builtin_amdgcn_readfirstlane(tid >> 6), fr = lane & 15, fq = lane >> 4;
    LAS bf16* Qs = (LAS bf16*)lds; LAS bf16* Ks = (LAS bf16*)(lds + 17408); LAS bf16* KDT = (LAS bf16*)(lds + 34816); LAS bf16* VT = (LAS bf16*)(lds + 53248);
    LAS bf16* ATT = (LAS bf16*)(lds + 71680); LAS float* EL = (LAS float*)(lds + 80896);
    bf16* const U = (bf16*)(WSP + WS_U); const bf16* const KDg = (const bf16*)(WSP + WS_KD); const float* const ELg = (const float*)(WSP + WS_EL);
    f32x4 S[8];
#pragma unroll
    for (int kt = 0; kt < 8; ++kt)
#pragma unroll
        for (int e = 0; e < 4; ++e) S[kt][e] = S0 ? S0[(size_t)(16 * kt + 4 * fq + e) * 256 + 16 * w + fr] : 0.f;
    u32x4 pq[2], pk[2], pd[2], pv[2]; f32x4 pe = {0.f, 0.f, 0.f, 0.f};
#define GLA_LOADC(ci_) do { const int r0_ = row_base + (ci_) * 64, nv_ = ((ci_) == nch - 1) ? nv_last : 64; const size_t it_ = (size_t)(cidx0 + (ci_)) * 4 + h; \
        _Pragma("unroll") for (int p = 0; p < 2; ++p) { const int idx = tid + 512 * p, t = idx >> 4, seg = idx & 15, tv = idx & 63, sv = idx >> 6; \
            const u32x4 z4 = {0u, 0u, 0u, 0u}; pq[p] = z4; pk[p] = z4; pv[p] = z4; \
            if (t < nv_) { const bf16* up = U + (size_t)(r0_ + t) * NINP + h * 128 + 8 * seg; pq[p] = *(const u32x4*)(up + Q0); pk[p] = *(const u32x4*)(up + K0); } \
            pd[p] = *(const u32x4*)(KDg + it_ * 8192 + idx * 8); \
            if (tv < nv_) pv[p] = *(const u32x4*)(U + (size_t)(r0_ + tv) * NINP + V0 + h * 256 + vh * 128 + 8 * sv); } \
        if (tid < 32) pe = *(const f32x4*)(ELg + it_ * 128 + 4 * tid); } while (0)
    GLA_LOADC(0);
    for (int ci = 0; ci < nch; ++ci) {
        const int r0 = row_base + ci * 64, nv = (ci == nch - 1) ? nv_last : 64;
#pragma unroll
        for (int p = 0; p < 2; ++p) { const int idx = tid + 512 * p, t = idx >> 4, seg = idx & 15, tv = idx & 63, sv = idx >> 6;
            *(LAS u32x4*)(Qs + t * 136 + 8 * seg) = pq[p]; *(LAS u32x4*)(Ks + t * 136 + 8 * seg) = pk[p];
            *(LAS u32x4*)(KDT + (idx >> 3) * 72 + (idx & 7) * 8) = pd[p];
            LAS bf16* vp = VT + (8 * sv) * 72 + tv; const u32x4 vv = pv[p];
            vp[0] = (bf16)(vv.x & 0xffffu); vp[72] = (bf16)(vv.x >> 16); vp[144] = (bf16)(vv.y & 0xffffu); vp[216] = (bf16)(vv.y >> 16);
            vp[288] = (bf16)(vv.z & 0xffffu); vp[360] = (bf16)(vv.z >> 16); vp[432] = (bf16)(vv.w & 0xffffu); vp[504] = (bf16)(vv.w >> 16); }
        if (tid < 32) *(LAS f32x4*)(EL + 4 * tid) = pe;
        __syncthreads();
        if (ci + 1 < nch) GLA_LOADC(ci + 1);
        { const int it = w >> 1;
#pragma unroll
          for (int jj = 0; jj < 2; ++jj) { const int jt = (w & 1) * 2 + jj; f32x4 a4 = {0.f, 0.f, 0.f, 0.f};
#pragma unroll
            for (int ks = 0; ks < 4; ++ks) { const bf16x8 a = *(const LAS bf16x8*)(Ks + (16 * jt + fr) * 136 + 32 * ks + 8 * fq), b = *(const LAS bf16x8*)(Qs + (16 * it + fr) * 136 + 32 * ks + 8 * fq);
                a4 = MFMA16(a, b, a4); }
            const int i = 16 * it + fr;
#pragma unroll
            for (int e = 0; e < 4; ++e) if (16 * jt + 4 * fq + e > i) a4[e] = 0.f;
            u32x2 o2; o2.x = cvtpk(a4[0], a4[1]); o2.y = cvtpk(a4[2], a4[3]);
            *(LAS u32x2*)(ATT + i * 72 + 16 * jt + 4 * fq) = o2; } }
        __syncthreads();
        bf16x8 vb[2], Sp[4];
#pragma unroll
        for (int js = 0; js < 2; ++js) vb[js] = *(const LAS bf16x8*)(VT + (16 * w + fr) * 72 + 32 * js + 8 * fq);
#pragma unroll
        for (int ks = 0; ks < 4; ++ks) { u32x4 pk4; const f32x4 s0 = S[2 * ks], s1 = S[2 * ks + 1];
            pk4.x = cvtpk(s0[0], s0[1]); pk4.y = cvtpk(s0[2], s0[3]); pk4.z = cvtpk(s1[0], s1[1]); pk4.w = cvtpk(s1[2], s1[3]); Sp[ks] = __builtin_bit_cast(bf16x8, pk4); }
        f32x4 o[4];
#pragma unroll
        for (int it = 0; it < 4; ++it) { f32x4 oo = {0.f, 0.f, 0.f, 0.f};
#pragma unroll
            for (int js = 0; js < 2; ++js) if (2 * js <= it) { const bf16x8 aa = *(const LAS bf16x8*)(ATT + (16 * it + fr) * 72 + 32 * js + 8 * fq); oo = MFMA16(aa, vb[js], oo); }
#pragma unroll
            for (int ks = 0; ks < 4; ++ks) { const u32x2 lo = *(const LAS u32x2*)(Qs + (16 * it + fr) * 136 + 32 * ks + 4 * fq), hi = *(const LAS u32x2*)(Qs + (16 * it + fr) * 136 + 32 * ks + 16 + 4 * fq);
                u32x4 q4; q4.x = lo.x; q4.y = lo.y; q4.z = hi.x; q4.w = hi.y; oo = MFMA16(__builtin_bit_cast(bf16x8, q4), Sp[ks], oo); }
            o[it] = oo; }
#pragma unroll
        for (int kt = 0; kt < 8; ++kt) { const f32x4 el = *(const LAS f32x4*)(EL + 16 * kt + 4 * fq); S[kt] *= el; }
#pragma unroll
        for (int js = 0; js < 2; ++js)
#pragma unroll
            for (int kt = 0; kt < 8; ++kt) { const bf16x8 a = *(const LAS bf16x8*)(KDT + (16 * kt + fr) * 72 + 32 * js + 8 * fq); S[kt] = MFMA16(a, vb[js], S[kt]); }
#pragma unroll
        for (int it = 0; it < 4; ++it)
#pragma unroll
            for (int e = 0; e < 4; ++e) { const int row = 16 * it + 4 * fq + e;
                if (row < nv && (!dry || o[it][e] == 1.2345e30f)) U[(size_t)(r0 + row) * NINP + V0 + h * 256 + vh * 128 + 16 * w + fr] = f2bf1(o[it][e]); }
        __syncthreads();
    }
#undef GLA_LOADC
#pragma unroll
    for (int kt = 0; kt < 8; ++kt)
#pragma unroll
        for (int e = 0; e < 4; ++e) if (!dry || S[kt][e] == 1.2345e30f) ST[(size_t)(16 * kt + 4 * fq + e) * 256 + 16 * w + fr] = S[kt][e];
}
__device__ __forceinline__ void gla_fin_row(bf16* U, const float* gnorm, int row, int lane, int dry = 0) {
    const u32x4* op = (const u32x4*)(U + (size_t)row * NINP + V0 + 16 * lane); u32x4* rp = (u32x4*)(U + (size_t)row * NINP + R0 + 16 * lane);
    const u32x4 o0 = op[0], o1 = op[1], r0 = rp[0], r1 = rp[1];
    float ov[16] = {bflo(o0.x), bfhi(o0.x), bflo(o0.y), bfhi(o0.y), bflo(o0.z), bfhi(o0.z), bflo(o0.w), bfhi(o0.w), bflo(o1.x), bfhi(o1.x), bflo(o1.y), bfhi(o1.y), bflo(o1.z), bfhi(o1.z), bflo(o1.w), bfhi(o1.w)};
    const float rv[16] = {bflo(r0.x), bfhi(r0.x), bflo(r0.y), bfhi(r0.y), bflo(r0.z), bfhi(r0.z), bflo(r0.w), bfhi(r0.w), bflo(r1.x), bfhi(r1.x), bflo(r1.y), bfhi(r1.y), bflo(r1.z), bfhi(r1.z), bflo(r1.w), bfhi(r1.w)};
    float ss = 0.f;
#pragma unroll
    for (int i = 0; i < 16; ++i) ss += ov[i] * ov[i];
    ss += bperm(lane ^ 1, ss); ss += bperm(lane ^ 2, ss); ss += bperm(lane ^ 4, ss); ss += bperm(lane ^ 8, ss);
    const float rstd = 1.0f / sqrtf(ss * (1.0f / 256.0f) + EPS);
    const f32x4* gp = (const f32x4*)(gnorm + 16 * lane);
#pragma unroll
    for (int j = 0; j < 4; ++j) { const f32x4 g = gp[j];
#pragma unroll
        for (int e = 0; e < 4; ++e) ov[4 * j + e] = ov[4 * j + e] * rstd * g[e] * rv[4 * j + e]; }
    u32x4 w0, w1; w0.x = cvtpk(ov[0], ov[1]); w0.y = cvtpk(ov[2], ov[3]); w0.z = cvtpk(ov[4], ov[5]); w0.w = cvtpk(ov[6], ov[7]);
    w1.x = cvtpk(ov[8], ov[9]); w1.y = cvtpk(ov[10], ov[11]); w1.z = cvtpk(ov[12], ov[13]); w1.w = cvtpk(ov[14], ov[15]);
    if (!dry || w0.x == 0x12345u) { rp[0] = w0; rp[1] = w1; }
}

__device__ __forceinline__ void small_gemm(LAS unsigned char* lds, const bf16* A, int lda, const bf16* Bt, int ldb, int K, f32x4 (&acc)[2]) {
    int tid_ = threadIdx.x; asm volatile("" : "+v"(tid_));
    const int tid = tid_, lane = tid & 63, w = __builtin_amdgcn_readfirstlane(tid >> 6), fr = lane & 15, fq = lane >> 4, wr = w & 3, wc = w >> 2;
    const int r = tid >> 3, seg = tid & 7, ns = K >> 7;
    const bf16* ap = A + (size_t)r * lda + 8 * seg; const bf16* bp = Bt + (size_t)r * ldb + 8 * seg;
    u32x4 pa[3][2], pb[3][2];
#pragma unroll
    for (int u = 0; u < 3; ++u) if (u < ns) {
#pragma unroll
        for (int hh = 0; hh < 2; ++hh) { pa[u][hh] = *(const u32x4*)(ap + u * 128 + 64 * hh); pb[u][hh] = *(const u32x4*)(bp + u * 128 + 64 * hh); } }
    for (int s0 = 0; s0 < ns; s0 += 3) {
#pragma unroll
        for (int u = 0; u < 3; ++u) { const int st = s0 + u; if (st < ns) {
            LAS bf16* As = (LAS bf16*)(lds + u * 34816); LAS bf16* Bs = (LAS bf16*)(lds + u * 34816 + 17408);
#pragma unroll
            for (int hh = 0; hh < 2; ++hh) { *(LAS u32x4*)(As + r * 136 + 64 * hh + 8 * seg) = pa[u][hh]; *(LAS u32x4*)(Bs + r * 136 + 64 * hh + 8 * seg) = pb[u][hh]; }
            __syncthreads();
            if (st + 3 < ns) {
#pragma unroll
                for (int hh = 0; hh < 2; ++hh) { pa[u][hh] = *(const u32x4*)(ap + (st + 3) * 128 + 64 * hh); pb[u][hh] = *(const u32x4*)(bp + (st + 3) * 128 + 64 * hh); } }
#pragma unroll
            for (int kk = 0; kk < 4; ++kk) { const bf16x8 a = *(const LAS bf16x8*)(As + (16 * wr + fr) * 136 + 32 * kk + 8 * fq);
#pragma unroll
                for (int n = 0; n < 2; ++n) { const bf16x8 b = *(const LAS bf16x8*)(Bs + (32 * wc + 16 * n + fr) * 136 + 32 * kk + 8 * fq); acc[n] = MFMA16(a, b, acc[n]); } }
        } }
    }
    __syncthreads();
}

constexpr int N_PHASES = 23;
__global__ void __launch_bounds__(NTHR, 2) fwd(Args args) {
    extern __shared__ __attribute__((aligned(16))) unsigned char lds_raw[];
    LAS unsigned char* lds = (LAS unsigned char*)lds_raw;
    cg::grid_group grid = cg::this_grid();
    const int G = gridDim.x, bx = blockIdx.x;
#define PHASE_LOCALS int t_ = threadIdx.x; asm volatile("" : "+v"(t_)); const int tid = t_, lane = tid & 63, wave = __builtin_amdgcn_readfirstlane(tid >> 6), gw = bx * NWAVES + wave, NGW = G * NWAVES; (void)tid; (void)lane; (void)gw; (void)NGW;
#define ws WSP
#define X (OUTP + O_Y)
#define HN ((bf16*)(WSP + WS_HN))
#define U ((bf16*)(WSP + WS_U))
#define FF ((bf16*)(WSP + WS_U))
#define PB ((float*)(WSP + WS_P))
#define MOD ((float*)(WSP + WS_MOD))
#define CS ((bf16*)(WSP + WS_CS))
    const int lo = args.ph_lo, hi = args.ph_hi;
#ifndef PROBE_PREP
#define PROBE_PREP 0
#endif
#ifndef PROBE_REC
#define PROBE_REC 0
#endif
#ifndef PROBE_FIN
#define PROBE_FIN 0
#endif
#ifndef REP
#define REP 1
#endif
#ifndef SCM
#define SCM 15
#endif
#ifndef DBG_MASK
#define DBG_MASK 0x7ffff
#endif
#define PHON(k) ((DBG_MASK >> ((k) < 10 ? (k) : (k) - 8)) & 1)
#define IN(k) (lo <= (k) && (k) < hi)
#define SEAM(k) do { if (lo <= (k) && (k) + 1 < hi) grid.sync(); } while (0)

    if (IN(0)) {
        PHASE_LOCALS
        LAS float* scr = (LAS float*)(lds + wave * 16384);
        constexpr int I_WIN = 16 * 248, I_PA = 20 * 32, I_PB = 16 * 32, I_WO = 16 * 32, I_W1 = 16 * 176, I_W2 = 44 * 32, I_ADA = 16 * 192;
        constexpr int I_L = I_WIN + I_PA + I_PB + I_WO + I_W1 + I_W2 + I_ADA;
        for (int it = gw; it < 2 * I_L; it += NGW) {
            const int l = it / I_L; int r = it % I_L;
            if (r < I_WIN) { transpose_item(inp(11) + (size_t)l * D * 7696, D, 7696, (bf16*)(ws + WS_WIN + l * SZ_WIN), D, 0, 248, 1, scr, r, lane); continue; } r -= I_WIN;
            if (r < I_PA) { transpose_item(inp(22) + (size_t)l * DR * D, DR, D, (bf16*)(ws + WS_WPJ + l * SZ_WPJ), DR + DVT, 0, 32, 0, scr, r, lane); continue; } r -= I_PA;
            if (r < I_PB) { transpose_item(inp(23) + (size_t)l * DVT * D, DVT, D, (bf16*)(ws + WS_WPJ + l * SZ_WPJ), DR + DVT, DR, 32, 0, scr, r, lane); continue; } r -= I_PB;
            if (r < I_WO) { transpose_item(inp(24) + (size_t)l * D * D, D, D, (bf16*)(ws + WS_WOUT + l * SZ_WOUT), D, 0, 32, 0, scr, r, lane); continue; } r -= I_WO;
            if (r < I_W1) { transpose_item(inp(25) + (size_t)l * D * 2 * DFF, D, 2 * DFF, (bf16*)(ws + WS_W1 + l * SZ_W1), D, 0, 176, 2, scr, r, lane); continue; } r -= I_W1;
            if (r < I_W2) { transpose_item(inp(26) + (size_t)l * DFF * D, DFF, D, (bf16*)(ws + WS_W2 + l * SZ_W2), DFF, 0, 32, 0, scr, r, lane); continue; } r -= I_W2;
            transpose_item(inp(9) + (size_t)l * D * NMOD, D, NMOD, (bf16*)(ws + WS_ADA + l * SZ_ADA), D, 0, 192, 0, scr, r, lane);
        }
        bf16* WG = (bf16*)(ws + WS_WG);
        for (int idx = bx * NTHR + tid; idx < 2 * 10 * 256 * 128; idx += G * NTHR) {
            const int l = idx / 327680, r = idx % 327680, n = r >> 15, vv = (r >> 7) & 255, wi = r & 127;
            const float* src = (vv < 128 ? inp(14) : inp(16)) + ((size_t)(l * 10 + n) * 128 + wi) * 128 + (vv & 127);
            WG[idx] = f2bf1(*src);
        }
        for (int idx = bx * NTHR + tid; idx < 256 * D; idx += G * NTHR) {
            const int row = idx >> 10, col = idx & 1023; float v = 0.f;
            if (row < 8) v = inp(2)[row * D + col]; else if (row < NB) v = inp(3)[(row - 8) * D + col];
            CS[idx] = f2bf1(v * fsigmoid(v));
        }
    }
    SEAM(0);
    if (IN(1)) {
        for (int l = 0; l < 2; ++l) {
            pg8::Gemm g{CS, (const bf16*)(ws + WS_ADA + l * SZ_ADA), 256, NMOD, D, D, D}; pg8::StaticOrder S; S.init(256, NMOD, G, (bx + 128 * l) % G);
            pg8::EpiMod E{MOD + (size_t)l * NB * NMOD, inp(10) + (size_t)l * NMOD};
            pg8::gemm_phase<pg8::EpiMod, pg8::StaticOrder, true, true>(lds, g, S, E);
        }
    }
    SEAM(1);
    for (int l = 0; l < 2; ++l) {
        const int pb = 2 + 10 * l;
#define modl (MOD + (size_t)l * NB * NMOD)
        if (IN(pb)) {
            PHASE_LOCALS
            for (int row = gw; row < M; row += NGW) {
                const float* xr = l == 0 ? (row < MP ? inp(0) + (size_t)row * D : inp(1) + (size_t)(row - MP) * D) : X + (size_t)row * D;
                const float* mb = modl + (size_t)row_batch(row) * NMOD;
                norm_row(xr, inp(7) + l * D, mb + 1024, mb, HN + (size_t)row * D, nullptr, lane);
            }
        }
        SEAM(pb);
        if (IN(pb + 1)) {
            pg8::Gemm g{HN, (const bf16*)(ws + WS_WIN + l * SZ_WIN), M, NINP, D, D, D}; pg8::StaticOrder S; S.init(M, NINP, G, bx);
            pg8::EpiWin E{U};
            pg8::gemm_phase<pg8::EpiWin, pg8::StaticOrder, true, true>(lds, g, S, E);
        }
        SEAM(pb + 1);
        if (IN(pb + 2)) {
            const int nrep = 1 + (PROBE_PREP ? (hi > 22) : 0);
            for (int rp_ = 0; rp_ < nrep; ++rp_) { const int dry = rp_ < nrep - 1;
            for (int item = bx; item < 1536; item += G) gla_prep(lds, l, item, dry); }
        }
        SEAM(pb + 2);
        if (IN(pb + 3)) {
            ScanP P; P.l = l;
            float* const o_gla_p = OUTP + O_GLAP + (size_t)l * 8 * 4 * 32768; float* const o_gla_s = OUTP + O_GLAS + (size_t)l * 128 * 4 * 32768;
            const int nrep = 1 + (PROBE_REC ? (hi > 22) : 0);
            for (int rp_ = 0; rp_ < nrep; ++rp_) { const int dry = rp_ < nrep - 1; const int dryg = dry | (PROBE_REC == 2 && nrep == 2), dryl = dry | (PROBE_REC == 3 && nrep == 2), drys = dry | (PROBE_REC == 4 && nrep == 2); (void)dryg; (void)dryl; (void)drys;
            if (bx < 64) { if (PROBE_REC <= 1 || PROBE_REC == 2 || !dry) { const int b = bx >> 3, h = (bx >> 1) & 3, vh = bx & 1; gla_rec(lds, l, h, vh, b * SEQ, SEQ / 64, 64, b * 32, nullptr, o_gla_p + (size_t)(b * 4 + h) * 32768 + vh * 128, dry); } }
            else if (bx < 144) { if (PROBE_REC <= 1 || PROBE_REC == 3 || !dry) lru_item<false>(lds, P, bx - 64, dry); }
            else if (PROBE_REC <= 1 || PROBE_REC == 4 || !dry) {
                for (int j = bx - 144; j < 1104; j += (G - 144)) {
                    if (j < 1024) { const int b = j >> 3, h = (j >> 1) & 3, vh = j & 1;
                        gla_rec(lds, l, h, vh, MP + b * 4, 1, 4, 256 + b, inp(6) + (size_t)l * 128 * 4 * 32768 + (size_t)(b * 4 + h) * 32768 + vh * 128, o_gla_s + (size_t)(b * 4 + h) * 32768 + vh * 128, dry); }
                    else lru_item<true>(lds, P, j - 1024, dry);
                }
            }
            if (nrep > 1) __syncthreads(); }
        }
        SEAM(pb + 3);
        if (IN(pb + 4)) {
            PHASE_LOCALS
            const int nrep = 1 + (PROBE_FIN ? (hi > 22) : 0);
            for (int rp_ = 0; rp_ < nrep; ++rp_) { const int dry = rp_ < nrep - 1;
            for (int row = gw; row < M; row += NGW) gla_fin_row(U, inp(21) + (size_t)l * DVT, row, lane, dry); }
        }
        SEAM(pb + 4);
        if (IN(pb + 5)) {
            const bf16* wpj = (const bf16*)(ws + WS_WPJ + l * SZ_WPJ);
            { pg8::Gemm g{U + G0, wpj, MP, D, DR, NINP, DR + DVT}; pg8::StaticOrder S; S.init(MP, D, G, bx); pg8::EpiProj E{U, PB, HN, 0};
              pg8::gemm_phase<pg8::EpiProj, pg8::StaticOrder, true, true>(lds, g, S, E); }
            { pg8::Gemm g{U + R0, wpj + DR, MP, D, DVT, NINP, DR + DVT}; pg8::StaticOrder S; S.init(MP, D, G, bx); pg8::EpiProj E{U, PB, HN, 1};
              pg8::gemm_phase<pg8::EpiProj, pg8::StaticOrder, true, true>(lds, g, S, E); }
            if (bx >= G - 128) {
                const int j = G - 1 - bx, rt = j >> 4, ct = j & 15; const int rowt = MP + 64 * rt, colt = 64 * ct;
                f32x4 aa[2] = {{0.f, 0.f, 0.f, 0.f}, {0.f, 0.f, 0.f, 0.f}}, ab[2] = {{0.f, 0.f, 0.f, 0.f}, {0.f, 0.f, 0.f, 0.f}};
                small_gemm(lds, U + (size_t)rowt * NINP + G0, NINP, wpj + (size_t)colt * (DR + DVT), DR + DVT, DR, aa);
                small_gemm(lds, U + (size_t)rowt * NINP + R0, NINP, wpj + (size_t)colt * (DR + DVT) + DR, DR + DVT, DVT, ab);
                int t_ = threadIdx.x; asm volatile("" : "+v"(t_)); const int lane = t_ & 63, w = t_ >> 6, fr = lane & 15, fq = lane >> 4;
#pragma unroll
                for (int n = 0; n < 2; ++n)
#pragma unroll
                    for (int e = 0; e < 4; ++e) { const int row = rowt + 16 * (w & 3) + 4 * fq + e, col = colt + 32 * (w >> 2) + 16 * n + fr; const bf16* up = U + (size_t)row * NINP + col;
                        HN[(size_t)row * D + col] = f2bf1(bf2f(up[GA0]) * aa[n][e] + bf2f(up[GB0]) * ab[n][e]); }
            }
        }
        SEAM(pb + 5);
        if (IN(pb + 6)) {
            pg8::Gemm g{HN, (const bf16*)(ws + WS_WOUT + l * SZ_WOUT), MP, D, D, D, D}; pg8::StaticOrder S; S.init(MP, D, G, bx);
            pg8::EpiRes E{l == 0 ? inp(0) : X, l == 0 ? inp(1) : X + (size_t)MP * D, X, modl + 2048};
            pg8::gemm_phase<pg8::EpiRes, pg8::StaticOrder, true, true>(lds, g, S, E);
            if (bx >= G - 128) { const int j = G - 1 - bx, rt = j >> 4, ct = j & 15; const int rowt = MP + 64 * rt, colt = 64 * ct;
                f32x4 aa[2] = {{0.f, 0.f, 0.f, 0.f}, {0.f, 0.f, 0.f, 0.f}};
                small_gemm(lds, HN + (size_t)rowt * D, D, (const bf16*)(ws + WS_WOUT + l * SZ_WOUT) + (size_t)colt * D, D, D, aa);
                int t_ = threadIdx.x; asm volatile("" : "+v"(t_)); const int lane = t_ & 63, w = t_ >> 6, fr = lane & 15, fq = lane >> 4;
                const float* bs = l == 0 ? inp(1) : X + (size_t)MP * D;
#pragma unroll
                for (int n = 0; n < 2; ++n)
#pragma unroll
                    for (int e = 0; e < 4; ++e) { const int row = rowt + 16 * (w & 3) + 4 * fq + e, col = colt + 32 * (w >> 2) + 16 * n + fr;
                        X[(size_t)row * D + col] = bs[(size_t)(row - MP) * D + col] + (modl + 2048)[(size_t)row_batch(row) * NMOD + col] * aa[n][e]; }
            }
        }
        SEAM(pb + 6);
        if (IN(pb + 7)) {
            PHASE_LOCALS
            for (int row = gw; row < M; row += NGW) {
                const float* mb = modl + (size_t)row_batch(row) * NMOD;
                norm_row(X + (size_t)row * D, inp(8) + l * D, mb + 4096, mb + 3072, HN + (size_t)row * D, nullptr, lane);
            }
        }
        SEAM(pb + 7);
        if (IN(pb + 8)) {
            pg8::Gemm g{HN, (const bf16*)(ws + WS_W1 + l * SZ_W1), M, 2 * DFF, D, D, D}; pg8::StaticOrder S; S.init(M, 2 * DFF, G, bx);
            pg8::EpiSwiglu E{FF};
            pg8::gemm_phase<pg8::EpiSwiglu, pg8::StaticOrder, true, true>(lds, g, S, E);
        }
        SEAM(pb + 8);
        if (IN(pb + 9)) {
            pg8::Gemm g{FF, (const bf16*)(ws + WS_W2 + l * SZ_W2), MP, D, DFF, DFF, DFF}; pg8::StaticOrder S; S.init(MP, D, G, bx);
            pg8::EpiRes E{X, X + (size_t)MP * D, X, modl + 5120};
            pg8::gemm_phase<pg8::EpiRes, pg8::StaticOrder, true, true>(lds, g, S, E);
            if (bx >= G - 128) { const int j = G - 1 - bx, rt = j >> 4, ct = j & 15; const int rowt = MP + 64 * rt, colt = 64 * ct;
                f32x4 aa[2] = {{0.f, 0.f, 0.f, 0.f}, {0.f, 0.f, 0.f, 0.f}};
                small_gemm(lds, FF + (size_t)rowt * DFF, DFF, (const bf16*)(ws + WS_W2 + l * SZ_W2) + (size_t)colt * DFF, DFF, DFF, aa);
                int t_ = threadIdx.x; asm volatile("" : "+v"(t_)); const int lane = t_ & 63, w = t_ >> 6, fr = lane & 15, fq = lane >> 4;
#pragma unroll
                for (int n = 0; n < 2; ++n)
#pragma unroll
                    for (int e = 0; e < 4; ++e) { const int row = rowt + 16 * (w & 3) + 4 * fq + e, col = colt + 32 * (w >> 2) + 16 * n + fr;
                        float* xp_ = X + (size_t)row * D + col; *xp_ = *xp_ + (modl + 5120)[(size_t)row_batch(row) * NMOD + col] * aa[n][e]; }
            }
        }
        SEAM(pb + 9);
    }
    if (IN(22)) {
        PHASE_LOCALS
        for (int row = gw; row < M; row += NGW) norm_row(X + (size_t)row * D, inp(27), nullptr, nullptr, nullptr, X + (size_t)row * D, lane);
    }
#undef IN
#undef SEAM
#undef ws
#undef X
#undef HN
#undef U
#undef FF
#undef PB
#undef MOD
#undef CS
#undef modl
}

#ifndef MK_SPLIT
#define MK_SPLIT 0
#endif
extern "C" void kernel_launch(void* const* d_in, const int* in_sizes, int n_in, void* d_out, int out_size, void* d_ws, size_t ws_size, hipStream_t stream) {
    static int grid = 0;
    if (grid == 0) {
        if (n_in != 28 || (size_t)out_size != O_END || ws_size < WS_END) { fprintf(stderr, "kernel_launch: unexpected shapes (n_in %d, out %d, ws %zu, need %zu); nothing launched\n", n_in, out_size, ws_size, (size_t)WS_END); grid = -1; return; }
        int dev = 0, cus = 0, per_cu = 0;
        (void)hipGetDevice(&dev); (void)hipDeviceGetAttribute(&cus, hipDeviceAttributeMultiprocessorCount, dev);
        if (hipFuncSetAttribute((const void*)fwd, hipFuncAttributeMaxDynamicSharedMemorySize, LDS_BYTES) != hipSuccess) { fprintf(stderr, "kernel_launch: hipFuncSetAttribute failed\n"); grid = -1; return; }
        if (hipOccupancyMaxActiveBlocksPerMultiprocessor(&per_cu, (const void*)fwd, NTHR, LDS_BYTES) != hipSuccess || per_cu < 1) { fprintf(stderr, "kernel_launch: occupancy query says %d\n", per_cu); per_cu = 1; }
        (void)hipGetLastError();
        grid = 256;
        if (cus * per_cu < 256) { fprintf(stderr, "kernel_launch: device holds only %d x %d workgroups; this kernel needs 256 co-resident\n", cus, per_cu); grid = -1; return; }
    }
    if (grid < 0) return;
    Args a{};
    for (int i = 0; i < 28; ++i) a.in[i] = (const float*)d_in[i];
    a.out = (float*)d_out; a.ws = (unsigned char*)d_ws;
#if MK_SPLIT
    for (int p = 0; p < N_PHASES; ++p) { a.ph_lo = p; a.ph_hi = p + 1; void* kargs[] = {&a};
        hipError_t e = hipLaunchCooperativeKernel((const void*)fwd, dim3(grid), dim3(NTHR), kargs, LDS_BYTES, stream);
        if (e != hipSuccess) { fprintf(stderr, "kernel_launch: launch failed: %s\n", hipGetErrorString(e)); break; } }
#else
    a.ph_lo = 0; a.ph_hi = N_PHASES; void* kargs[] = {&a};
    hipError_t e = hipLaunchCooperativeKernel((const void*)fwd, dim3(grid), dim3(NTHR), kargs, LDS_BYTES, stream);
    if (e != hipSuccess) fprintf(stderr, "kernel_launch: cooperative launch failed: %s (grid %d)\n", hipGetErrorString(e), grid);
#endif
}
```

```cpp
#include <hip/hip_runtime.h>
#include <hip/hip_cooperative_groups.h>
#include <cstdio>
#include <cstdint>
namespace cg = cooperative_groups;

constexpr int D = 1024, MP = 16384, MS = 512, M = MP + MS, NB = 136, SEQ = 2048;
constexpr int DR = 1280, DKT = 512, DVT = 1024, DFF = 2816, NINP = 7936, NMOD = 6144;
constexpr int X0 = 0, G0 = 1280, Q0 = 2560, K0 = 3072, V0 = 3584, R0 = 4608, GA0 = 5632, GB0 = 6656, LR0 = 7680;
constexpr float EPS = 1e-6f;

namespace pg8 {
#define PG8_LAS __attribute__((address_space(3)))
typedef unsigned short bf16_t;
typedef short bf16x8 __attribute__((ext_vector_type(8)));
typedef float f32x4 __attribute__((ext_vector_type(4)));
typedef unsigned u32x4 __attribute__((ext_vector_type(4)));
constexpr int BM = 256, BK = 64, HALF = 128, HTB = HALF * BK * 2  , STAGE_BYTES = 8 * HTB, NXCD = 8, WGM = 8;

__host__ __device__ __forceinline__ int lds_byte(int r, int c) { const int st = (r >> 4) * 2 + (c >> 5), rr = r & 15, cc = c & 31, ob = rr * 64 + cc * 2; return st * 1024 + (ob ^ (((ob >> 9) & 1) << 5)); }
__host__ __device__ __forceinline__ void stage_rc(int b, int& R, int& C) { const int st = b / 1024, sb = b % 1024, swz = sb ^ (((sb >> 9) & 1) << 5); R = (st >> 1) * 16 + swz / 64; C = (st & 1) * 32 + (swz % 64) / 2; }
__host__ __device__ __forceinline__ int perm32(int rho) { const int n = rho >> 4, i = rho & 15; return 8 * (i >> 2) + 4 * n + (i & 3); }

struct Unit { int pm, pn; };
struct Gemm { const bf16_t* A; const bf16_t* Bt; int M, N, K, lda, ldb; };

struct StaticOrder {
    int nM, nN, nwg, G, c;
    __host__ __device__ void init(int M, int N, int G_, int c_) { nM = M / BM; nN = N / BM; nwg = nM * nN; G = G_; c = c_; }
    __host__ __device__ bool next(int i, Unit& u) const {
        const long L = (long)i * G + c; if (L >= nwg) return false;
        int wgid = (int)L; { const int q = nwg / NXCD, r = nwg % NXCD, xcd = wgid % NXCD, off = wgid / NXCD; wgid = (xcd < r ? xcd * (q + 1) : r * (q + 1) + (xcd - r) * q) + off; }
        const int nig = WGM * nN, gid = wgid / nig, fm = gid * WGM, gsz = (nM - fm) < WGM ? (nM - fm) : WGM;
        u.pm = fm + ((wgid % nig) % gsz); u.pn = (wgid % nig) / gsz; return true;
    }
    __device__ __forceinline__ void a_ready(const Unit&) const {}
    __device__ __forceinline__ void done(const Unit&) const {}
};


typedef __bf16 bf16x2_t __attribute__((ext_vector_type(2)));
typedef float f32x2_t __attribute__((ext_vector_type(2)));
typedef unsigned u32x2 __attribute__((ext_vector_type(2)));
__device__ __forceinline__ unsigned cvtpk(float lo, float hi) { f32x2_t v = {lo, hi}; bf16x2_t b = __builtin_convertvector(v, bf16x2_t); return __builtin_bit_cast(unsigned, b); }
__device__ __forceinline__ float bflo(unsigned w) { return __uint_as_float(w << 16); }
__device__ __forceinline__ float bfhi(unsigned w) { return __uint_as_float(w & 0xffff0000u); }
__device__ __forceinline__ float bf2f(bf16_t h) { return __uint_as_float(((unsigned)h) << 16); }
__device__ __forceinline__ float fsigmoid(float z) { return __builtin_amdgcn_rcpf(1.0f + __builtin_amdgcn_exp2f(-1.4426950408889634f * z)); }
__device__ __forceinline__ float fexp(float z) { return __builtin_amdgcn_exp2f(1.4426950408889634f * z); }
__device__ __forceinline__ float act_apply(float x, int mode) {
    if (mode == 1) { const float z = 1.5957691216057308f * (x + 0.044715f * x * x * x); return x * fsigmoid(z); }
    if (mode == 2) return x * 0.08838834764831845f;
    if (mode == 3) return x * fsigmoid(x);
    if (mode == 4) return fsigmoid(x);
    return x;
}
__device__ __forceinline__ int row_batch(int row) { return row < MP ? (row >> 11) : 8 + ((row - MP) >> 2); }

struct EpiWin {
    static constexpr bool PERM = true, AFTER_DRAIN = false;
    bf16_t* U;
    __device__ __forceinline__ void operator()(const f32x4 (&acc)[2][2][4][2], const Unit& u, int wr, int wc, int fr, int fq) const {
        const int row0 = u.pm * BM + wr * 64 + fr, colt = u.pn * BM;
        int mode = 0;
        if (colt >= G0 && colt < Q0) mode = 1; else if (colt >= Q0 && colt < K0) mode = 2; else if (colt >= R0 && colt < GA0) mode = 3; else if (colt >= GA0 && colt < LR0) mode = 4;
        const int col0 = colt + wc * 32 + 8 * fq;
#pragma unroll
        for (int ai = 0; ai < 2; ++ai)
#pragma unroll
            for (int m = 0; m < 4; ++m) { bf16_t* rowp = U + (size_t)(row0 + ai * HALF + m * 16) * NINP + col0;
#pragma unroll
                for (int bj = 0; bj < 2; ++bj) { f32x4 v0 = acc[ai][bj][m][0], v1 = acc[ai][bj][m][1];
#pragma unroll
                    for (int e = 0; e < 4; ++e) { v0[e] = act_apply(v0[e], mode); v1[e] = act_apply(v1[e], mode); }
                    u32x4 w; w.x = cvtpk(v0[0], v0[1]); w.y = cvtpk(v0[2], v0[3]); w.z = cvtpk(v1[0], v1[1]); w.w = cvtpk(v1[2], v1[3]);
                    *(u32x4*)(rowp + bj * HALF) = w; }
                __builtin_amdgcn_sched_barrier(0); }
    }
};
struct EpiProj {
    static constexpr bool PERM = true, AFTER_DRAIN = false;
    const bf16_t* U; float* P; bf16_t* Mo; int second;
    __device__ __forceinline__ void operator()(const f32x4 (&acc)[2][2][4][2], const Unit& u, int wr, int wc, int fr, int fq) const {
        const int row0 = u.pm * BM + wr * 64 + fr, col0 = u.pn * BM + wc * 32 + 8 * fq; const int goff = second ? GB0 : GA0;
#pragma unroll
        for (int ai = 0; ai < 2; ++ai)
#pragma unroll
            for (int m = 0; m < 4; ++m) { const int row = row0 + ai * HALF + m * 16;
#pragma unroll
                for (int bj = 0; bj < 2; ++bj) { const int col = col0 + bj * HALF;
                    const u32x4 gw = *(const u32x4*)(U + (size_t)row * NINP + goff + col);
                    f32x4 g0 = {bflo(gw.x), bfhi(gw.x), bflo(gw.y), bfhi(gw.y)}, g1 = {bflo(gw.z), bfhi(gw.z), bflo(gw.w), bfhi(gw.w)};
                    f32x4 v0 = acc[ai][bj][m][0] * g0, v1 = acc[ai][bj][m][1] * g1;
                    float* pp = P + (size_t)row * D + col;
                    if (!second) { *(f32x4*)pp = v0; *(f32x4*)(pp + 4) = v1; }
                    else { v0 += *(const f32x4*)pp; v1 += *(const f32x4*)(pp + 4);
                        u32x4 w; w.x = cvtpk(v0[0], v0[1]); w.y = cvtpk(v0[2], v0[3]); w.z = cvtpk(v1[0], v1[1]); w.w = cvtpk(v1[2], v1[3]);
                        *(u32x4*)(Mo + (size_t)row * D + col) = w; } }
                __builtin_amdgcn_sched_barrier(0); }
    }
};
struct EpiRes {
    static constexpr bool PERM = false, AFTER_DRAIN = false;
    const float* base_p; const float* base_s; float* out; const float* gate; int dry;
    __device__ __forceinline__ void operator()(const f32x4 (&acc)[2][2][4][2], const Unit& u, int wr, int wc, int fr, int fq) const {
        const int row0 = u.pm * BM + wr * 64 + fr, col0 = u.pn * BM + wc * 32 + 4 * fq;
#pragma unroll
        for (int ai = 0; ai < 2; ++ai)
#pragma unroll
            for (int m = 0; m < 4; ++m) { const int row = row0 + ai * HALF + m * 16; const float* bp = row < MP ? base_p + (size_t)row * D : base_s + (size_t)(row - MP) * D;
                const float* gp = gate + (size_t)row_batch(row) * NMOD; float* op = out + (size_t)row * D;
#pragma unroll
                for (int bj = 0; bj < 2; ++bj)
#pragma unroll
                    for (int n = 0; n < 2; ++n) { const int col = col0 + bj * HALF + n * 16;
                        const f32x4 b = *(const f32x4*)(bp + col), g = *(const f32x4*)(gp + col);
                        const f32x4 rr = b + g * acc[ai][bj][m][n]; if (!dry || rr.x == 1.2345e30f) *(f32x4*)(op + col) = rr; }
                __builtin_amdgcn_sched_barrier(0); }
    }
};
struct EpiSwiglu {
    static constexpr bool PERM = true, AFTER_DRAIN = false;
    bf16_t* O;
    __device__ __forceinline__ void operator()(const f32x4 (&acc)[2][2][4][2], const Unit& u, int wr, int wc, int fr, int fq) const {
        const int row0 = u.pm * BM + wr * 64 + fr, col0 = u.pn * HALF + wc * 32 + 8 * fq;
#pragma unroll
        for (int ai = 0; ai < 2; ++ai)
#pragma unroll
            for (int m = 0; m < 4; ++m) { f32x4 v0, v1;
#pragma unroll
                for (int e = 0; e < 4; ++e) { const float a0 = acc[ai][0][m][0][e], a1 = acc[ai][0][m][1][e]; v0[e] = a0 * fsigmoid(a0) * acc[ai][1][m][0][e]; v1[e] = a1 * fsigmoid(a1) * acc[ai][1][m][1][e]; }
                u32x4 w; w.x = cvtpk(v0[0], v0[1]); w.y = cvtpk(v0[2], v0[3]); w.z = cvtpk(v1[0], v1[1]); w.w = cvtpk(v1[2], v1[3]);
                *(u32x4*)(O + (size_t)(row0 + ai * HALF + m * 16) * DFF + col0) = w;
                __builtin_amdgcn_sched_barrier(0); }
    }
};
struct EpiMod {
    static constexpr bool PERM = false, AFTER_DRAIN = false;
    float* out; const float* bias;
    __device__ __forceinline__ void operator()(const f32x4 (&acc)[2][2][4][2], const Unit& u, int wr, int wc, int fr, int fq) const {
        const int row0 = u.pm * BM + wr * 64 + fr, col0 = u.pn * BM + wc * 32 + 4 * fq;
#pragma unroll
        for (int ai = 0; ai < 2; ++ai)
#pragma unroll
            for (int m = 0; m < 4; ++m) { const int row = row0 + ai * HALF + m * 16; if (row < NB) {
#pragma unroll
                for (int bj = 0; bj < 2; ++bj)
#pragma unroll
                    for (int n = 0; n < 2; ++n) { const int col = col0 + bj * HALF + n * 16;
                        *(f32x4*)(out + (size_t)row * NMOD + col) = acc[ai][bj][m][n] + *(const f32x4*)(bias + col); } } }
    }
};

template <class Epi, class Sched, bool ALIGN_EPI = false, bool SP2 = false>
__device__ __forceinline__ void gemm_phase(PG8_LAS unsigned char* lds, const Gemm g, const Sched& S, const Epi& E) {
    int tid_ = threadIdx.x; asm volatile("" : "+v"(tid_));
    const int tid = tid_, wid = __builtin_amdgcn_readfirstlane(tid >> 6), lane = tid & 63, wr = wid >> 2, wc = wid & 3, fr = lane & 15, fq = lane >> 4;
    const int K = g.K, nt = K / BK;
    unsigned voffA[2], voffB[2];
#pragma unroll
    for (int i = 0; i < 2; ++i) { int R, C; stage_rc(tid * 16 + i * 8192, R, C); const int Rb = Epi::PERM ? ((R & ~31) + perm32(R & 31)) : R;
        voffA[i] = (unsigned)(R * g.lda + C) * 2u; voffB[i] = (unsigned)(Rb * g.ldb + C) * 2u; }
    const size_t kstep = (size_t)(BK * 2);
    const size_t hstepA = (size_t)HALF * g.lda * 2, hstepB = (size_t)HALF * g.ldb * 2;
    const size_t tstepA = 2 * hstepA, tstepB = 2 * hstepB;
    const unsigned ldsw = (unsigned)wid * 1024u;
    const int aoff = lds_byte(wr * 64 + fr, fq * 8), boff = lds_byte(wc * 32 + fr, fq * 8);
#define PG8_SA(b, h) (((b) * 2 + (h)) * HTB)
#define PG8_SB(b, h) ((4 + (b) * 2 + (h)) * HTB)
#define PG8_STAGE(bufoff, gbase, voff) do { _Pragma("unroll") for (int _i = 0; _i < 2; ++_i) \
        __builtin_amdgcn_global_load_lds((const unsigned*)((const char*)(gbase) + (voff)[_i]), (PG8_LAS unsigned*)(lds + (bufoff) + ldsw + _i * 8192), 16, 0, 0); } while (0)
#define PG8_LDA(dst, b, h) do { _Pragma("unroll") for (int m = 0; m < 4; ++m) _Pragma("unroll") for (int k = 0; k < 2; ++k) dst[m][k] = *(const PG8_LAS bf16x8*)(lds + PG8_SA(b, h) + aoff + m * 2048 + k * 1024); } while (0)
#define PG8_LDB(dst, b, h) do { _Pragma("unroll") for (int n = 0; n < 2; ++n) _Pragma("unroll") for (int k = 0; k < 2; ++k) dst[n][k] = *(const PG8_LAS bf16x8*)(lds + PG8_SB(b, h) + boff + n * 2048 + k * 1024); } while (0)
#define PG8_MMA(ai, bj, At, Bt) do { __builtin_amdgcn_s_setprio(1); _Pragma("unroll") for (int m = 0; m < 4; ++m) _Pragma("unroll") for (int n = 0; n < 2; ++n) _Pragma("unroll") for (int k = 0; k < 2; ++k) \
        acc[ai][bj][m][n] = __builtin_amdgcn_mfma_f32_16x16x32_bf16(Bt[n][k], At[m][k], acc[ai][bj][m][n], 0, 0, 0); __builtin_amdgcn_s_setprio(0); } while (0)
#define PG8_WAIT_V(n) asm volatile("s_waitcnt vmcnt(" #n ")" ::: "memory")
#define PG8_WAIT_L(n) asm volatile("s_waitcnt lgkmcnt(" #n ")" ::: "memory")
#define PG8_BAR __builtin_amdgcn_s_barrier()
#define PG8_SCHED __builtin_amdgcn_sched_barrier(0)
    Unit cur, nxt; int ui = 0;
    if (!S.next(0, cur)) return;
    f32x4 acc[2][2][4][2];
#pragma unroll
    for (int a = 0; a < 2; ++a)
#pragma unroll
        for (int b = 0; b < 2; ++b)
#pragma unroll
            for (int m = 0; m < 4; ++m)
#pragma unroll
                for (int n = 0; n < 2; ++n) acc[a][b][m][n] = (f32x4){0.f, 0.f, 0.f, 0.f};
    bf16x8 At[4][2], B0[2][2], B1[2][2];
    const char* cA = (const char*)g.A + (size_t)cur.pm * tstepA; const char* cB = (const char*)g.Bt + (size_t)cur.pn * tstepB;
    S.a_ready(cur);
    if constexpr (SP2) {
        PG8_STAGE(PG8_SB(0, 0), cB, voffB); PG8_STAGE(PG8_SB(0, 1), cB + hstepB, voffB); PG8_STAGE(PG8_SA(0, 0), cA, voffA); PG8_STAGE(PG8_SA(0, 1), cA + hstepA, voffA);
        if (wr == 1) PG8_BAR;
        PG8_WAIT_V(2); PG8_BAR;
        PG8_STAGE(PG8_SB(1, 0), cB + kstep, voffB); PG8_STAGE(PG8_SA(1, 0), cA + kstep, voffA); PG8_STAGE(PG8_SB(1, 1), cB + hstepB + kstep, voffB);
        PG8_WAIT_V(6); PG8_BAR;
    } else {
        PG8_STAGE(PG8_SB(0, 0), cB, voffB); PG8_STAGE(PG8_SA(0, 0), cA, voffA); PG8_STAGE(PG8_SB(0, 1), cB + hstepB, voffB); PG8_STAGE(PG8_SA(0, 1), cA + hstepA, voffA);
        if (wr == 1) PG8_BAR;
        PG8_WAIT_V(4); PG8_BAR;
        PG8_STAGE(PG8_SB(1, 0), cB + kstep, voffB); PG8_STAGE(PG8_SA(1, 0), cA + kstep, voffA); PG8_STAGE(PG8_SB(1, 1), cB + hstepB + kstep, voffB);
        PG8_WAIT_V(6); PG8_BAR;
    }
    for (;;) {
        const bool has_next = S.next(ui + 1, nxt);
        const char* nA = has_next ? (const char*)g.A + (size_t)nxt.pm * tstepA : cA; const char* nB = has_next ? (const char*)g.Bt + (size_t)nxt.pn * tstepB : cB;
        for (int t = 0; t < nt; t += 2) {
            const bool last = (t == nt - 2);
            const char* a1 = cA + (size_t)(t + 1) * kstep;
            const char* a2 = last ? nA : cA + (size_t)(t + 2) * kstep; const char* b2 = last ? nB : cB + (size_t)(t + 2) * kstep;
            const char* a3 = a2 + kstep; const char* b3 = b2 + kstep;
            if (last && has_next) S.a_ready(nxt);
            if constexpr (SP2) {
            PG8_LDB(B0, 0, 0); PG8_LDB(B1, 0, 1); PG8_SCHED; PG8_LDA(At, 0, 0); PG8_STAGE(PG8_SA(1, 1), a1 + hstepA, voffA);
            PG8_WAIT_V(8); PG8_WAIT_L(0); PG8_BAR; PG8_MMA(0, 0, At, B0); PG8_MMA(0, 1, At, B1); PG8_BAR; PG8_SCHED;
            PG8_LDA(At, 0, 1); PG8_STAGE(PG8_SB(0, 0), b2, voffB); PG8_STAGE(PG8_SB(0, 1), b2 + hstepB, voffB); PG8_STAGE(PG8_SA(0, 0), a2, voffA);
            PG8_WAIT_V(8); PG8_WAIT_L(0); PG8_BAR; PG8_MMA(1, 0, At, B0); PG8_MMA(1, 1, At, B1); PG8_BAR; PG8_SCHED;
            PG8_LDB(B0, 1, 0); PG8_LDB(B1, 1, 1); PG8_SCHED; PG8_LDA(At, 1, 0); PG8_STAGE(PG8_SA(0, 1), a2 + hstepA, voffA);
            PG8_WAIT_V(8); PG8_WAIT_L(0); PG8_BAR; PG8_MMA(0, 0, At, B0); PG8_MMA(0, 1, At, B1); PG8_BAR; PG8_SCHED;
            PG8_LDA(At, 1, 1); PG8_STAGE(PG8_SB(1, 0), b3, voffB); PG8_STAGE(PG8_SB(1, 1), b3 + hstepB, voffB); PG8_STAGE(PG8_SA(1, 0), a3, voffA);
            PG8_WAIT_V(8); PG8_WAIT_L(0); PG8_BAR; PG8_MMA(1, 0, At, B0); PG8_MMA(1, 1, At, B1); PG8_BAR; PG8_SCHED;
            } else {
            PG8_LDB(B0, 0, 0); PG8_SCHED; PG8_LDA(At, 0, 0); PG8_STAGE(PG8_SA(1, 1), a1 + hstepA, voffA);
            PG8_WAIT_L(8); PG8_BAR; PG8_WAIT_L(0); PG8_MMA(0, 0, At, B0); PG8_BAR; PG8_SCHED;
            PG8_LDB(B1, 0, 1); PG8_STAGE(PG8_SB(0, 0), b2, voffB);
            PG8_BAR; PG8_WAIT_L(0); PG8_MMA(0, 1, At, B1); PG8_BAR;
            PG8_LDA(At, 0, 1); PG8_STAGE(PG8_SA(0, 0), a2, voffA);
            PG8_BAR; PG8_WAIT_L(0); PG8_MMA(1, 0, At, B0); PG8_BAR; PG8_SCHED;
            PG8_STAGE(PG8_SB(0, 1), b2 + hstepB, voffB);
            PG8_WAIT_V(6); PG8_BAR; PG8_MMA(1, 1, At, B1); PG8_BAR;
            PG8_LDB(B0, 1, 0); PG8_SCHED; PG8_LDA(At, 1, 0); PG8_STAGE(PG8_SA(0, 1), a2 + hstepA, voffA);
            PG8_WAIT_L(8); PG8_BAR; PG8_WAIT_L(0); PG8_MMA(0, 0, At, B0); PG8_BAR; PG8_SCHED;
            PG8_LDB(B1, 1, 1); PG8_STAGE(PG8_SB(1, 0), b3, voffB);
            PG8_BAR; PG8_WAIT_L(0); PG8_MMA(0, 1, At, B1); PG8_BAR;
            PG8_LDA(At, 1, 1); PG8_STAGE(PG8_SA(1, 0), a3, voffA);
            PG8_BAR; PG8_WAIT_L(0); PG8_MMA(1, 0, At, B0); PG8_BAR; PG8_SCHED;
            PG8_STAGE(PG8_SB(1, 1), b3 + hstepB, voffB);
            PG8_WAIT_V(6); PG8_BAR; PG8_MMA(1, 1, At, B1); PG8_BAR;
            }
        }
        if constexpr (ALIGN_EPI) { if (wr == 0) PG8_BAR; }
        if constexpr (!Epi::AFTER_DRAIN) { E(acc, cur, wr, wc, fr, fq); S.done(cur); }
        if (!has_next) break;
#pragma unroll
        for (int a = 0; a < 2; ++a)
#pragma unroll
            for (int b = 0; b < 2; ++b)
#pragma unroll
                for (int m = 0; m < 4; ++m)
#pragma unroll
                    for (int n = 0; n < 2; ++n) acc[a][b][m][n] = (f32x4){0.f, 0.f, 0.f, 0.f};
        cur = nxt; cA = nA; cB = nB; ++ui;
        if constexpr (ALIGN_EPI) { if (wr == 1) PG8_BAR; }
    }
    PG8_WAIT_V(0);
    if constexpr (!ALIGN_EPI) { if (wr == 0) PG8_BAR; }
    PG8_BAR;
    if constexpr (Epi::AFTER_DRAIN) { E.fused(acc, cur, wr, wc, fr, fq, lds, wid, lane); S.done(cur); }
#undef PG8_SA
#undef PG8_SB
#undef PG8_STAGE
#undef PG8_LDA
#undef PG8_LDB
#undef PG8_MMA
#undef PG8_WAIT_V
#undef PG8_WAIT_L
#undef PG8_BAR
#undef PG8_SCHED
}
}

#define LAS __attribute__((address_space(3)))
typedef unsigned short bf16;
typedef float f32x4 __attribute__((ext_vector_type(4)));
typedef short bf16x8 __attribute__((ext_vector_type(8)));
typedef short bf16x4 __attribute__((ext_vector_type(4)));
typedef unsigned u32x4 __attribute__((ext_vector_type(4)));
typedef unsigned u32x2 __attribute__((ext_vector_type(2)));
using pg8::cvtpk; using pg8::bflo; using pg8::bfhi; using pg8::bf2f; using pg8::fsigmoid; using pg8::fexp; using pg8::row_batch;
constexpr int NWAVES = 8, NTHR = 512, LDS_BYTES = 147456;
constexpr size_t MiB = 1u << 20;
constexpr size_t WS_BAR = 0;
constexpr size_t WS_WIN = 1 * MiB;
constexpr size_t SZ_WIN = (size_t)NINP * D * 2;
constexpr size_t WS_WPJ = WS_WIN + 2 * SZ_WIN;
constexpr size_t SZ_WPJ = (size_t)D * (DR + DVT) * 2;
constexpr size_t WS_WOUT = WS_WPJ + 2 * SZ_WPJ;
constexpr size_t SZ_WOUT = (size_t)D * D * 2;
constexpr size_t WS_W1 = WS_WOUT + 2 * SZ_WOUT;
constexpr size_t SZ_W1 = (size_t)2 * DFF * D * 2;
constexpr size_t WS_W2 = WS_W1 + 2 * SZ_W1;
constexpr size_t SZ_W2 = (size_t)D * DFF * 2;
constexpr size_t WS_ADA = WS_W2 + 2 * SZ_W2;
constexpr size_t SZ_ADA = (size_t)NMOD * D * 2;
constexpr size_t WS_WG = WS_ADA + 2 * SZ_ADA;
constexpr size_t SZ_WG = (size_t)10 * 256 * 128 * 2;
constexpr size_t WS_CS = WS_WG + 2 * SZ_WG;
constexpr size_t WS_MOD = WS_CS + (size_t)256 * D * 2;
constexpr size_t SZ_MOD = (size_t)NB * NMOD * 4;
constexpr size_t WS_HN = ((WS_MOD + 2 * SZ_MOD + MiB - 1) / MiB) * MiB;
constexpr size_t WS_U = WS_HN + (size_t)M * D * 2;
constexpr size_t WS_P = WS_U + (size_t)M * NINP * 2;
constexpr size_t WS_END = WS_P + (size_t)M * D * 4;
constexpr size_t WS_KD = WS_P;
constexpr size_t WS_EL = WS_P + 32 * MiB;
static_assert(WS_KD + (size_t)1536 * 16384 <= WS_EL && WS_EL + (size_t)1536 * 512 <= WS_END, "KD/EL overlay P");

struct Args {
    const float* in[28]; float* out; unsigned char* ws; int ph_lo, ph_hi;
};
constexpr size_t O_Y = 0, O_CONVP = (size_t)M * D, O_LRUP = O_CONVP + 2 * 8 * 3 * DR, O_GLAP = O_LRUP + 2 * 8 * DR, O_CONVS = O_GLAP + (size_t)2 * 8 * 4 * 128 * 256,
                 O_LRUS = O_CONVS + (size_t)2 * 128 * 3 * DR, O_GLAS = O_LRUS + (size_t)2 * 128 * DR, O_END = O_GLAS + (size_t)2 * 128 * 4 * 128 * 256;

__device__ __forceinline__ float bperm(int srclane, float v) { return __int_as_float(__builtin_amdgcn_ds_bpermute(srclane << 2, __float_as_int(v))); }
__device__ __forceinline__ float wave_sum(float v, int lane) {
#pragma unroll
    for (int o = 1; o < 64; o <<= 1) v += bperm(lane ^ o, v);
    return v;
}
__device__ __forceinline__ int src_col(int np, int mapmode) {
    if (mapmode == 1) { if (np < GA0) return np; if (np < LR0) return np + 16; if (np < LR0 + 16) return np - LR0 + 5632; return -1; }
    if (mapmode == 2) { const int pn = np >> 8, bj = (np >> 7) & 1, j = np & 127; return bj * DFF + pn * 128 + j; }
    return np;
}
__device__ __forceinline__ void transpose_item(const float* W, int K, int N, bf16* WT, int ldt, int koff, int nblk, int mapmode, LAS float* scr, int item, int lane) {
    const int kb = item / nblk, nb = item % nblk, k0 = 64 * kb, n0 = 32 * nb;
    const int sc = src_col(n0 + (lane & 31), mapmode);
#pragma unroll 8
    for (int i = 0; i < 32; ++i) { const int kk = 2 * i + (lane >> 5); scr[kk * 33 + (lane & 31)] = sc >= 0 ? W[(size_t)(k0 + kk) * N + sc] : 0.f; }
    asm volatile("s_waitcnt lgkmcnt(0)" ::: "memory");
    const int c = lane & 7;
#pragma unroll
    for (int j = 0; j < 4; ++j) { const int n = (lane >> 3) + 8 * j; const LAS float* s = scr + (8 * c) * 33 + n;
        u32x4 o; o.x = cvtpk(s[0 * 33], s[1 * 33]); o.y = cvtpk(s[2 * 33], s[3 * 33]); o.z = cvtpk(s[4 * 33], s[5 * 33]); o.w = cvtpk(s[6 * 33], s[7 * 33]);
        *(u32x4*)(WT + (size_t)(n0 + n) * ldt + koff + k0 + 8 * c) = o; }
    asm volatile("s_waitcnt lgkmcnt(0)" ::: "memory");
}
__device__ __forceinline__ void norm_row(const float* xrow, const float* g, const float* sc, const float* sh, bf16* orow, float* orow_f, int lane) {
    const f32x4* xr = (const f32x4*)xrow + lane; f32x4 v[4]; float s = 0.f;
#pragma unroll
    for (int j = 0; j < 4; ++j) { v[j] = xr[64 * j]; s += (v[j].x * v[j].x + v[j].y * v[j].y) + (v[j].z * v[j].z + v[j].w * v[j].w); }
    const float rstd = 1.0f / sqrtf(wave_sum(s, lane) * (1.0f / D) + EPS);
#pragma unroll
    for (int j = 0; j < 4; ++j) { const int col = 4 * lane + 256 * j; const f32x4 gg = *(const f32x4*)(g + col);
        f32x4 o = v[j] * rstd * gg;
        if (orow_f) { *(f32x4*)(orow_f + col) = o; }
        else { const f32x4 a = *(const f32x4*)(sc + col), b = *(const f32x4*)(sh + col); o = o * (a + 1.0f) + b;
            u32x2 w; w.x = cvtpk(o.x, o.y); w.y = cvtpk(o.z, o.w); *(u32x2*)(orow + col) = w; } }
}

struct ScanP { int l; };
typedef const float* fptr_t;
__device__ __forceinline__ fptr_t inp(int i) {
    const __attribute__((address_space(4))) unsigned char* kp = (const __attribute__((address_space(4))) unsigned char*)__builtin_amdgcn_kernarg_segment_ptr();
    asm volatile("" : "+s"(kp));
    return *(const __attribute__((address_space(4))) fptr_t*)(kp + 8 * i);
}
#define WSP ((unsigned char*)inp(29))
#define OUTP ((float*)inp(28))
__device__ __forceinline__ bf16 f2bf1(float x) { return (bf16)(cvtpk(x, 0.f) & 0xffffu); }
#define MFMA16(a, b, c) __builtin_amdgcn_mfma_f32_16x16x32_bf16((a), (b), (c), 0, 0, 0)

template <bool SAMPLE>
__device__ __forceinline__ void lru_item(LAS unsigned char* lds, const ScanP& P, int item, int dry = 0) {
    int tid_ = threadIdx.x; asm volatile("" : "+v"(tid_));
    const int tid = tid_, lane = tid & 63, w = __builtin_amdgcn_readfirstlane(tid >> 6), fr = lane & 15, fq = lane >> 4;
    const int n = item % 10, bb = item / 10;
    const int row0 = SAMPLE ? MP + bb * 64 : bb * SEQ;
    const int nch = SAMPLE ? 1 : SEQ / 64;
    LAS bf16* XC = (LAS bf16*)lds;
    const int l = P.l; bf16* const U = (bf16*)(WSP + WS_U);
    const bf16* wg = (const bf16*)(WSP + WS_WG + l * SZ_WG) + (size_t)n * 256 * 128;
    bf16x8 Bw[2][4];
#pragma unroll
    for (int nt = 0; nt < 2; ++nt)
#pragma unroll
        for (int ks = 0; ks < 4; ++ks) Bw[nt][ks] = *(const bf16x8*)(wg + (size_t)(nt * 128 + 16 * w + fr) * 128 + 32 * ks + 8 * fq);
    const int ch = n * 128 + 16 * w + fr;
    const float ba = (inp(15) + (size_t)l * DR)[ch], bx = (inp(17) + (size_t)l * DR)[ch], lam = (inp(18) + (size_t)l * DR)[ch];
    const float cl = -8.0f * log1pf(expf(-lam));
    const int cg = tid & 15, tt = tid >> 4, cch = n * 128 + 8 * cg;
    float cw[4][8], cb[8];
#pragma unroll
    for (int i = 0; i < 4; ++i)
#pragma unroll
        for (int j = 0; j < 8; ++j) cw[i][j] = (inp(12) + (size_t)l * 4 * DR)[i * DR + cch + j];
#pragma unroll
    for (int j = 0; j < 8; ++j) cb[j] = (inp(13) + (size_t)l * DR)[cch + j];
    const float* const st_conv = SAMPLE ? inp(4) + (size_t)l * 128 * 3 * DR : nullptr; const float* const st_lru = SAMPLE ? inp(5) + (size_t)l * 128 * DR : nullptr;
    float* const o_lru_s = OUTP + O_LRUS + (size_t)l * 128 * DR;
    float hc = 0.f;
    u32x4 uq[2][4];
#define LRU_LOADC(c_) do { _Pragma("unroll") for (int p = 0; p < 2; ++p) _Pragma("unroll") for (int d = 0; d < 4; ++d) { const int tl_ = tt + 32 * p; const u32x4 z4 = {0u, 0u, 0u, 0u}; uq[p][d] = z4; \
        if ((c_) * 64 + tl_ - d >= 0) uq[p][d] = *(const u32x4*)(U + (size_t)(row0 + (c_) * 64 + tl_ - d) * NINP + X0 + cch); } } while (0)
    if (!SAMPLE) LRU_LOADC(0);
    for (int c = 0; c < nch; ++c) {
        const int r0 = row0 + c * 64;
#pragma unroll
        for (int p = 0; p < 2; ++p) {
            const int tl = tt + 32 * p; float xc[8];
#pragma unroll
            for (int j = 0; j < 8; ++j) xc[j] = cb[j];
#pragma unroll
            for (int d = 0; d < 4; ++d) {
                float uv[8];
                bool from_u, zero = false;
                if (!SAMPLE) { from_u = (c * 64 + tl - d) >= 0; zero = !from_u; } else { from_u = ((tl & 3) - d) >= 0; }
                if (!SAMPLE) { const u32x4 q = uq[p][d];
                    uv[0] = bflo(q.x); uv[1] = bfhi(q.x); uv[2] = bflo(q.y); uv[3] = bfhi(q.y); uv[4] = bflo(q.z); uv[5] = bfhi(q.z); uv[6] = bflo(q.w); uv[7] = bfhi(q.w); }
                else if (from_u) { const u32x4 q = *(const u32x4*)(U + (size_t)(r0 + tl - d) * NINP + X0 + cch);
                    uv[0] = bflo(q.x); uv[1] = bfhi(q.x); uv[2] = bflo(q.y); uv[3] = bfhi(q.y); uv[4] = bflo(q.z); uv[5] = bfhi(q.z); uv[6] = bflo(q.w); uv[7] = bfhi(q.w); }
                else if (zero) {
#pragma unroll
                    for (int j = 0; j < 8; ++j) uv[j] = 0.f; }
                else { const int b = bb * 16 + (tl >> 2); const float* sp = st_conv + ((size_t)b * 3 + (3 + (tl & 3) - d)) * DR + cch;
                    const f32x4 s0 = *(const f32x4*)sp, s1 = *(const f32x4*)(sp + 4);
                    uv[0] = s0.x; uv[1] = s0.y; uv[2] = s0.z; uv[3] = s0.w; uv[4] = s1.x; uv[5] = s1.y; uv[6] = s1.z; uv[7] = s1.w; }
#pragma unroll
                for (int j = 0; j < 8; ++j) xc[j] += cw[3 - d][j] * uv[j];
            }
            u32x4 o; o.x = cvtpk(xc[0], xc[1]); o.y = cvtpk(xc[2], xc[3]); o.z = cvtpk(xc[4], xc[5]); o.w = cvtpk(xc[6], xc[7]);
            *(LAS u32x4*)(XC + tl * 136 + 8 * cg) = o;
        }
        __syncthreads();
        if (!SAMPLE && c + 1 < nch) LRU_LOADC(c + 1);
        bf16 gv[4][4];
#pragma unroll
        for (int mt = 0; mt < 4; ++mt)
#pragma unroll
            for (int e = 0; e < 4; ++e) gv[mt][e] = U[(size_t)(r0 + 16 * mt + 4 * fq + e) * NINP + G0 + ch];
        f32x4 acc[4][2];
#pragma unroll
        for (int mt = 0; mt < 4; ++mt) { acc[mt][0] = (f32x4){0.f, 0.f, 0.f, 0.f}; acc[mt][1] = (f32x4){0.f, 0.f, 0.f, 0.f};
#pragma unroll
            for (int ks = 0; ks < 4; ++ks) { const bf16x8 a = *(const LAS bf16x8*)(XC + (16 * mt + fr) * 136 + 32 * ks + 8 * fq);
                acc[mt][0] = MFMA16(a, Bw[0][ks], acc[mt][0]); acc[mt][1] = MFMA16(a, Bw[1][ks], acc[mt][1]); } }
#pragma unroll
        for (int mt = 0; mt < 4; ++mt) {
            float Pe[4], Qe[4];
#pragma unroll
            for (int e = 0; e < 4; ++e) { const int tl = 16 * mt + 4 * fq + e;
                const float r = fsigmoid(acc[mt][0][e] + ba), ii = fsigmoid(acc[mt][1][e] + bx), la = cl * r, a = fexp(la), x2 = 2.0f * la;
                const float om = (x2 > -0.1f) ? -x2 * (1.0f + x2 * (0.5f + x2 * (0.16666667f + x2 * 0.041666668f))) : 1.0f - a * a;
                const float xcv = bf2f(XC[tl * 136 + 16 * w + fr]), bv = __builtin_amdgcn_sqrtf(om) * ii * xcv;
                if (e == 0) { Pe[0] = a; Qe[0] = bv; } else { Pe[e] = a * Pe[e - 1]; Qe[e] = a * Qe[e - 1] + bv; } }
            float hin;
            if (!SAMPLE) {
                float Pi = Pe[3], Qi = Qe[3];
                { const float Pp = bperm(lane - 16, Pi), Qp = bperm(lane - 16, Qi); if (fq >= 1) { Qi = Pi * Qp + Qi; Pi = Pi * Pp; } }
                { const float Pp = bperm(lane - 32, Pi), Qp = bperm(lane - 32, Qi); if (fq >= 2) { Qi = Pi * Qp + Qi; Pi = Pi * Pp; } }
                float Px = bperm(lane - 16, Pi), Qx = bperm(lane - 16, Qi); if (fq == 0) { Px = 1.f; Qx = 0.f; }
                hin = Px * hc + Qx;
            } else { hin = st_lru[(size_t)(bb * 16 + 4 * mt + fq) * DR + ch]; }
            float hv[4];
#pragma unroll
            for (int e = 0; e < 4; ++e) hv[e] = Pe[e] * hin + Qe[e];
            if (!SAMPLE) hc = bperm(48 + fr, hv[3]); else if (!dry) o_lru_s[(size_t)(bb * 16 + 4 * mt + fq) * DR + ch] = hv[3];
#pragma unroll
            for (int e = 0; e < 4; ++e) if (!dry || hv[e] == 1.2345e30f) U[(size_t)(r0 + 16 * mt + 4 * fq + e) * NINP + G0 + ch] = f2bf1(hv[e] * bf2f(gv[mt][e]));
        }
        __syncthreads();
    }
#undef LRU_LOADC
    if (dry) return;
    if (!SAMPLE) {
        if (fq == 0) (OUTP + O_LRUP + (size_t)l * 8 * DR)[(size_t)bb * DR + ch] = hc;
        if (tid < 384) { const int j = tid >> 7, cc = tid & 127; (OUTP + O_CONVP + (size_t)l * 8 * 3 * DR)[((size_t)bb * 3 + j) * DR + n * 128 + cc] = bf2f(U[(size_t)(row0 + SEQ - 3 + j) * NINP + X0 + n * 128 + cc]); }
    } else {
        for (int idx = tid; idx < 6144; idx += NTHR) { const int s = idx / 384, rem = idx % 384, j = rem >> 7, cc = rem & 127;
            (OUTP + O_CONVS + (size_t)l * 128 * 3 * DR)[((size_t)(bb * 16 + s) * 3 + j) * DR + n * 128 + cc] = bf2f(U[(size_t)(row0 + 4 * s + 1 + j) * NINP + X0 + n * 128 + cc]); }
    }
}

__device__ __forceinline__ void gla_prep(LAS unsigned char* lds, int l, int item, int dry = 0) {
    int tid_ = threadIdx.x; asm volatile("" : "+v"(tid_));
    const int tid = tid_;
    LAS float* LRS = (LAS float*)lds; LAS float* TOT = (LAS float*)(lds + 4096);
    const int cidx = item >> 2, h = item & 3;
    const int r0 = cidx < 256 ? (cidx >> 5) * SEQ + (cidx & 31) * 64 : MP + 4 * (cidx - 256), nv = cidx < 256 ? 64 : 4;
    const int c = tid & 127, tg = tid >> 7;
    bf16* const U = (bf16*)(WSP + WS_U);
    float wa2c[16];
#pragma unroll
    for (int r = 0; r < 16; ++r) wa2c[r] = (inp(19) + (size_t)l * 16 * DKT)[r * DKT + h * 128 + c];
    const float gba = (inp(20) + (size_t)l * DKT)[h * 128 + c];
    if (tid < 128) { const int t = tid >> 1, hf = tid & 1; u32x4 a = {0u, 0u, 0u, 0u};
        if (t < nv) a = *(const u32x4*)(U + (size_t)(r0 + t) * NINP + LR0 + 8 * hf);
        const f32x4 l0 = {bflo(a.x), bfhi(a.x), bflo(a.y), bfhi(a.y)}, l1 = {bflo(a.z), bfhi(a.z), bflo(a.w), bfhi(a.w)};
        *(LAS f32x4*)(LRS + t * 16 + 8 * hf) = l0; *(LAS f32x4*)(LRS + t * 16 + 8 * hf + 4) = l1; }
    float qv[16], kv[16];
#pragma unroll
    for (int i = 0; i < 16; ++i) { const int t = 16 * tg + i; qv[i] = 0.f; kv[i] = 0.f;
        if (t < nv) { const bf16* up = U + (size_t)(r0 + t) * NINP + h * 128 + c; qv[i] = bf2f(up[Q0]); kv[i] = bf2f(up[K0]); } }
    __syncthreads();
    float bc[16]; float run = 0.f;
#pragma unroll
    for (int i = 0; i < 16; ++i) { const int t = 16 * tg + i; float g = 0.f;
        if (t < nv) { const LAS f32x4* lp = (const LAS f32x4*)(LRS + t * 16); const f32x4 a = lp[0], b = lp[1], cc = lp[2], d = lp[3];
            float pre = gba;
            pre += wa2c[0] * a.x + wa2c[1] * a.y + wa2c[2] * a.z + wa2c[3] * a.w + wa2c[4] * b.x + wa2c[5] * b.y + wa2c[6] * b.z + wa2c[7] * b.w;
            pre += wa2c[8] * cc.x + wa2c[9] * cc.y + wa2c[10] * cc.z + wa2c[11] * cc.w + wa2c[12] * d.x + wa2c[13] * d.y + wa2c[14] * d.z + wa2c[15] * d.w;
            g = (fminf(pre, 0.f) - __logf(1.0f + fexp(-fabsf(pre)))) * 0.0625f; }
        run += g; bc[i] = run; }
    TOT[tg * 128 + c] = run;
    __syncthreads();
    float off = 0.f, blast = 0.f;
#pragma unroll
    for (int j = 0; j < 4; ++j) { const float v = TOT[j * 128 + c]; blast += v; if (j < tg) off += v; }
    float kdv[16];
#pragma unroll
    for (int i = 0; i < 16; ++i) { const int t = 16 * tg + i; const float bci = bc[i] + off;
        if (t < nv && !dry) { bf16* up = U + (size_t)(r0 + t) * NINP + h * 128 + c; up[Q0] = f2bf1(qv[i] * fexp(bci)); up[K0] = f2bf1(kv[i] * fexp(-bci)); }
        kdv[i] = kv[i] * fexp(blast - bci); }
    { u32x4 k0, k1; k0.x = cvtpk(kdv[0], kdv[1]); k0.y = cvtpk(kdv[2], kdv[3]); k0.z = cvtpk(kdv[4], kdv[5]); k0.w = cvtpk(kdv[6], kdv[7]);
      k1.x = cvtpk(kdv[8], kdv[9]); k1.y = cvtpk(kdv[10], kdv[11]); k1.z = cvtpk(kdv[12], kdv[13]); k1.w = cvtpk(kdv[14], kdv[15]);
      bf16* kd = (bf16*)(WSP + WS_KD) + (size_t)item * 8192 + c * 64 + 16 * tg; if (!dry || k0.x == 0x12345u) { *(u32x4*)kd = k0; *(u32x4*)(kd + 8) = k1; } }
    if (tg == 0 && !dry) ((float*)(WSP + WS_EL))[(size_t)item * 128 + c] = fexp(blast);
    __syncthreads();
}

__device__ __forceinline__ void gla_rec(LAS unsigned char* lds, int l, int h, int vh, int row_base, int nch, int nv_last, int cidx0, const float* S0, float* ST, int dry = 0) {
    int tid_ = threadIdx.x; asm volatile("" : "+v"(tid_));
    const int tid = tid_, lane = tid & 63, w = __builtin_amdgcn_readfirstlane(tid >> 6), fr = lane & 15, fq = lane >> 4;
    LAS bf16* Qs = (LAS bf16*)lds; LAS bf16* Ks = (LAS bf16*)(lds + 17408); LAS bf16* KDT = (LAS bf16*)(lds + 34816); LAS bf16* VT = (LAS bf16*)(lds + 53248);
    LAS bf16* ATT = (LAS bf16*)(lds + 71680); LAS float* EL = (LAS float*)(lds + 80896);
    bf16* const U = (bf16*)(WSP + WS_U); const bf16* const KDg = (const bf16*)(WSP + WS_KD); const float* const ELg = (const float*)(WSP + WS_EL);
    f32x4 S[8];
#pragma unroll
    for (int kt = 0; kt < 8; ++kt)
#pragma unroll
        for (int e = 0; e < 4; ++e) S[kt][e] = S0 ? S0[(size_t)(16 * kt + 4 * fq + e) * 256 + 16 * w + fr] : 0.f;
    u32x4 pq[2], pk[2], pd[2], pv[2]; f32x4 pe = {0.f, 0.f, 0.f, 0.f};
#define GLA_LOADC(ci_) do { const int r0_ = row_base + (ci_) * 64, nv_ = ((ci_) == nch - 1) ? nv_last : 64; const size_t it_ = (size_t)(cidx0 + (ci_)) * 4 + h; \
        _Pragma("unroll") for (int p = 0; p < 2; ++p) { const int idx = tid + 512 * p, t = idx >> 4, seg = idx & 15, tv = idx & 63, sv = idx >> 6; \
            const u32x4 z4 = {0u, 0u, 0u, 0u}; pq[p] = z4; pk[p] = z4; pv[p] = z4; \
            if (t < nv_) { const bf16* up = U + (size_t)(r0_ + t) * NINP + h * 128 + 8 * seg; pq[p] = *(const u32x4*)(up + Q0); pk[p] = *(const u32x4*)(up + K0); } \
            pd[p] = *(const u32x4*)(KDg + it_ * 8192 + idx * 8); \
            if (tv < nv_) pv[p] = *(const u32x4*)(U + (size_t)(r0_ + tv) * NINP + V0 + h * 256 + vh * 128 + 8 * sv); } \
        if (tid < 32) pe = *(const f32x4*)(ELg + it_ * 128 + 4 * tid); } while (0)
    GLA_LOADC(0);
    for (int ci = 0; ci < nch; ++ci) {
        const int r0 = row_base + ci * 64, nv = (ci == nch - 1) ? nv_last : 64;
#pragma unroll
        for (int p = 0; p < 2; ++p) { const int idx = tid + 512 * p, t = idx >> 4, seg = idx & 15, tv = idx & 63, sv = idx >> 6;
            *(LAS u32x4*)(Qs + t * 136 + 8 * seg) = pq[p]; *(LAS u32x4*)(Ks + t * 136 + 8 * seg) = pk[p];
            *(LAS u32x4*)(KDT + (idx >> 3) * 72 + (idx & 7) * 8) = pd[p];
            LAS bf16* vp = VT + (8 * sv) * 72 + tv; const u32x4 vv = pv[p];
            vp[0] = (bf16)(vv.x & 0xffffu); vp[72] = (bf16)(vv.x >> 16); vp[144] = (bf16)(vv.y & 0xffffu); vp[216] = (bf16)(vv.y >> 16);
            vp[288] = (bf16)(vv.z & 0xffffu); vp[360] = (bf16)(vv.z >> 16); vp[432] = (bf16)(vv.w & 0xffffu); vp[504] = (bf16)(vv.w >> 16); }
        if (tid < 32) *(LAS f32x4*)(EL + 4 * tid) = pe;
        __syncthreads();
        if (ci + 1 < nch) GLA_LOADC(ci + 1);
        { const int it = w >> 1;
#pragma unroll
          for (int jj = 0; jj < 2; ++jj) { const int jt = (w & 1) * 2 + jj; f32x4 a4 = {0.f, 0.f, 0.f, 0.f};
#pragma unroll
            for (int ks = 0; ks < 4; ++ks) { const bf16x8 a = *(const LAS bf16x8*)(Ks + (16 * jt + fr) * 136 + 32 * ks + 8 * fq), b = *(const LAS bf16x8*)(Qs + (16 * it + fr) * 136 + 32 * ks + 8 * fq);
                a4 = MFMA16(a, b, a4); }
            const int i = 16 * it + fr;
#pragma unroll
            for (int e = 0; e < 4; ++e) if (16 * jt + 4 * fq + e > i) a4[e] = 0.f;
            u32x2 o2; o2.x = cvtpk(a4[0], a4[1]); o2.y = cvtpk(a4[2], a4[3]);
            *(LAS u32x2*)(ATT + i * 72 + 16 * jt + 4 * fq) = o2; } }
        __syncthreads();
        bf16x8 vb[2], Sp[4];
#pragma unroll
        for (int js = 0; js < 2; ++js) vb[js] = *(const LAS bf16x8*)(VT + (16 * w + fr) * 72 + 32 * js + 8 * fq);
#pragma unroll
        for (int ks = 0; ks < 4; ++ks) { u32x4 pk4; const f32x4 s0 = S[2 * ks], s1 = S[2 * ks + 1];
            pk4.x = cvtpk(s0[0], s0[1]); pk4.y = cvtpk(s0[2], s0[3]); pk4.z = cvtpk(s1[0], s1[1]); pk4.w = cvtpk(s1[2], s1[3]); Sp[ks] = __builtin_bit_cast(bf16x8, pk4); }
        f32x4 o[4];
#pragma unroll
        for (int it = 0; it < 4; ++it) { f32x4 oo = {0.f, 0.f, 0.f, 0.f};
#pragma unroll
            for (int js = 0; js < 2; ++js) if (2 * js <= it) { const bf16x8 aa = *(const LAS bf16x8*)(ATT + (16 * it + fr) * 72 + 32 * js + 8 * fq); oo = MFMA16(aa, vb[js], oo); }
#pragma unroll
            for (int ks = 0; ks < 4; ++ks) { const u32x2 lo = *(const LAS u32x2*)(Qs + (16 * it + fr) * 136 + 32 * ks + 4 * fq), hi = *(const LAS u32x2*)(Qs + (16 * it + fr) * 136 + 32 * ks + 16 + 4 * fq);
                u32x4 q4; q4.x = lo.x; q4.y = lo.y; q4.z = hi.x; q4.w = hi.y; oo = MFMA16(__builtin_bit_cast(bf16x8, q4), Sp[ks], oo); }
            o[it] = oo; }
#pragma unroll
        for (int kt = 0; kt < 8; ++kt) { const f32x4 el = *(const LAS f32x4*)(EL + 16 * kt + 4 * fq); S[kt] *= el; }
#pragma unroll
        for (int js = 0; js < 2; ++js)
#pragma unroll
            for (int kt = 0; kt < 8; ++kt) { const bf16x8 a = *(const LAS bf16x8*)(KDT + (16 * kt + fr) * 72 + 32 * js + 8 * fq); S[kt] = MFMA16(a, vb[js], S[kt]); }
#pragma unroll
        for (int it = 0; it < 4; ++it)
#pragma unroll
            for (int e = 0; e < 4; ++e) { const int row = 16 * it + 4 * fq + e;
                if (row < nv && (!dry || o[it][e] == 1.2345e30f)) U[(size_t)(r0 + row) * NINP + V0 + h * 256 + vh * 128 + 16 * w + fr] = f2bf1(o[it][e]); }
        __syncthreads();
    }
#undef GLA_LOADC
#pragma unroll
    for (int kt = 0; kt < 8; ++kt)
#pragma unroll
        for (int e = 0; e < 4; ++e) if (!dry || S[kt][e] == 1.2345e30f) ST[(size_t)(16 * kt + 4 * fq + e) * 256 + 16 * w + fr] = S[kt][e];
}
__device__ __forceinline__ void gla_fin_row(bf16* U, const float* gnorm, int row, int lane, int dry = 0) {
    const u32x4* op = (const u32x4*)(U + (size_t)row * NINP + V0 + 16 * lane); u32x4* rp = (u32x4*)(U + (size_t)row * NINP + R0 + 16 * lane);
    const u32x4 o0 = op[0], o1 = op[1], r0 = rp[0], r1 = rp[1];
    float ov[16] = {bflo(o0.x), bfhi(o0.x), bflo(o0.y), bfhi(o0.y), bflo(o0.z), bfhi(o0.z), bflo(o0.w), bfhi(o0.w), bflo(o1.x), bfhi(o1.x), bflo(o1.y), bfhi(o1.y), bflo(o1.z), bfhi(o1.z), bflo(o1.w), bfhi(o1.w)};
    const float rv[16] = {bflo(r0.x), bfhi(r0.x), bflo(r0.y), bfhi(r0.y), bflo(r0.z), bfhi(r0.z), bflo(r0.w), bfhi(r0.w), bflo(r1.x), bfhi(r1.x), bflo(r1.y), bfhi(r1.y), bflo(r1.z), bfhi(r1.z), bflo(r1.w), bfhi(r1.w)};
    float ss = 0.f;
#pragma unroll
    for (int i = 0; i < 16; ++i) ss += ov[i] * ov[i];
    ss += bperm(lane ^ 1, ss); ss += bperm(lane ^ 2, ss); ss += bperm(lane ^ 4, ss); ss += bperm(lane ^ 8, ss);
    const float rstd = 1.0f / sqrtf(ss * (1.0f / 256.0f) + EPS);
    const f32x4* gp = (const f32x4*)(gnorm + 16 * lane);
#pragma unroll
    for (int j = 0; j < 4; ++j) { const f32x4 g = gp[j];
#pragma unroll
        for (int e = 0; e < 4; ++e) ov[4 * j + e] = ov[4 * j + e] * rstd * g[e] * rv[4 * j + e]; }
    u32x4 w0, w1; w0.x = cvtpk(ov[0], ov[1]); w0.y = cvtpk(ov[2], ov[3]); w0.z = cvtpk(ov[4], ov[5]); w0.w = cvtpk(ov[6], ov[7]);
    w1.x = cvtpk(ov[8], ov[9]); w1.y = cvtpk(ov[10], ov[11]); w1.z = cvtpk(ov[12], ov[13]); w1.w = cvtpk(ov[14], ov[15]);
    if (!dry || w0.x == 0x12345u) { rp[0] = w0; rp[1] = w1; }
}

__device__ __forceinline__ void small_gemm(LAS unsigned char* lds, const bf16* A, int lda, const bf16* Bt, int ldb, int K, f32x4 (&acc)[2]) {
    int tid_ = threadIdx.x; asm volatile("" : "+v"(tid_));
    const int tid = tid_, lane = tid & 63, w = __builtin_amdgcn_readfirstlane(tid >> 6), fr = lane & 15, fq = lane >> 4, wr = w & 3, wc = w >> 2;
    const int r = tid >> 3, seg = tid & 7, ns = K >> 7;
    const bf16* ap = A + (size_t)r * lda + 8 * seg; const bf16* bp = Bt + (size_t)r * ldb + 8 * seg;
    u32x4 pa[3][2], pb[3][2];
#pragma unroll
    for (int u = 0; u < 3; ++u) if (u < ns) {
#pragma unroll
        for (int hh = 0; hh < 2; ++hh) { pa[u][hh] = *(const u32x4*)(ap + u * 128 + 64 * hh); pb[u][hh] = *(const u32x4*)(bp + u * 128 + 64 * hh); } }
    for (int s0 = 0; s0 < ns; s0 += 3) {
#pragma unroll
        for (int u = 0; u < 3; ++u) { const int st = s0 + u; if (st < ns) {
            LAS bf16* As = (LAS bf16*)(lds + u * 34816); LAS bf16* Bs = (LAS bf16*)(lds + u * 34816 + 17408);
#pragma unroll
            for (int hh = 0; hh < 2; ++hh) { *(LAS u32x4*)(As + r * 136 + 64 * hh + 8 * seg) = pa[u][hh]; *(LAS u32x4*)(Bs + r * 136 + 64 * hh + 8 * seg) = pb[u][hh]; }
            __syncthreads();
            if (st + 3 < ns) {
#pragma unroll
                for (int hh = 0; hh < 2; ++hh) { pa[u][hh] = *(const u32x4*)(ap + (st + 3) * 128 + 64 * hh); pb[u][hh] = *(const u32x4*)(bp + (st + 3) * 128 + 64 * hh); } }
#pragma unroll
            for (int kk = 0; kk < 4; ++kk) { const bf16x8 a = *(const LAS bf16x8*)(As + (16 * wr + fr) * 136 + 32 * kk + 8 * fq);
#pragma unroll
                for (int n = 0; n < 2; ++n) { const bf16x8 b = *(const LAS bf16x8*)(Bs + (32 * wc + 16 * n + fr) * 136 + 32 * kk + 8 * fq); acc[n] = MFMA16(a, b, acc[n]); } }
        } }
    }
    __syncthreads();
}

#define XB_TMO      128
#define XB_XCNT(j)  (256  + 64 * (j))
#define XB_XSUB(j)  (1280 + 64 * (j))
#define XB_XGEN(j)  (2304 + 64 * (j))
#define XB_TOP      3328
#define XB_TOPGEN   3392
#define XCD_BAR_WORDS 3456
#define XB_SPIN_CAP (1u << 18)

__device__ __forceinline__ unsigned xb_ld(unsigned* p)              { return __hip_atomic_load(p, __ATOMIC_RELAXED, __HIP_MEMORY_SCOPE_AGENT); }
__device__ __forceinline__ unsigned xb_add(unsigned* p, unsigned v) { return __hip_atomic_fetch_add(p, v, __ATOMIC_RELAXED, __HIP_MEMORY_SCOPE_AGENT); }
__device__ __forceinline__ unsigned xb_xcc_id() { return (unsigned)__builtin_amdgcn_s_getreg((3 << 11) | 20) & 0xFu; }
#define XB_SPIN(cond, bar) do { unsigned _sp = 0; while (cond) { __builtin_amdgcn_s_sleep(1); \
    if ((++_sp & 255u) == 0u) { if (xb_ld(&(bar)[XB_TMO])) break; if (_sp > XB_SPIN_CAP) { atomicAdd(&(bar)[XB_TMO], 1u); break; } } } } while (0)

struct XcdBarrier {
    unsigned* bar; unsigned x;
    volatile LAS unsigned* st;
};

__device__ __forceinline__ XcdBarrier xcd_barrier_post(unsigned* bar, volatile LAS unsigned* st) {
    XcdBarrier b; b.bar = bar; b.x = xb_xcc_id(); b.st = st;
    if (threadIdx.x == 0) (void)xb_add(&bar[XB_XCNT(b.x)], 1u);
    return b;
}
__device__ __forceinline__ void xcd_barrier_complete(unsigned* bar, unsigned x, unsigned& nloc, unsigned& nx) {
    const unsigned G = gridDim.x * gridDim.y * gridDim.z;
    unsigned sum, cnt, mine, sp = 0u;
    for (;;) {
        sum = 0u; cnt = 0u; mine = 0u;
#pragma unroll
        for (unsigned j = 0; j < 16; ++j) { const unsigned c = xb_ld(&bar[XB_XCNT(j)]); sum += c; cnt += (c > 0u) ? 1u : 0u; mine = (j == x) ? c : mine; }
        if (sum == G) break;
        __builtin_amdgcn_s_sleep(1);
        if ((++sp & 255u) == 0u) { if (xb_ld(&bar[XB_TMO])) break; if (sp > XB_SPIN_CAP) { atomicAdd(&bar[XB_TMO], 1u); break; } }
    }
    nloc = mine > 0u ? mine : 1u; nx = cnt > 0u ? cnt : 1u;
}

__device__ __forceinline__ void xcd_barrier(const XcdBarrier& b) {
    asm volatile("s_waitcnt vmcnt(0)" ::: "memory");
    __syncthreads();
    if (threadIdx.x == 0) {
        unsigned* bar = b.bar;
        __builtin_amdgcn_s_waitcnt(0);
        unsigned nloc = b.st[0], nx = b.st[1];
        if (nloc == 0u) { xcd_barrier_complete(bar, b.x, nloc, nx); b.st[0] = nloc; b.st[1] = nx; }
        const unsigned old = xb_add(&bar[XB_XSUB(b.x)], 1u);
        const unsigned gen = old / nloc;
        if (old + 1u == (gen + 1u) * nloc) {
            __builtin_amdgcn_fence(__ATOMIC_RELEASE, "agent");
            asm volatile("s_waitcnt vmcnt(0)" ::: "memory");
            const unsigned og = xb_add(&bar[XB_TOP], 1u);
            const unsigned tg = og / nx;
            if (og + 1u == (tg + 1u) * nx) xb_add(&bar[XB_TOPGEN], 1u);
            else XB_SPIN(xb_ld(&bar[XB_TOPGEN]) == tg, bar);
            __builtin_amdgcn_fence(__ATOMIC_ACQUIRE, "agent");
            xb_add(&bar[XB_XGEN(b.x)], 1u);
            asm volatile("s_waitcnt vmcnt(0)" ::: "memory");
        } else {
            XB_SPIN(xb_ld(&bar[XB_XGEN(b.x)]) == gen, bar);
            __builtin_amdgcn_fence(__ATOMIC_ACQUIRE, "agent");
            asm volatile("s_waitcnt vmcnt(0)" ::: "memory");
        }
    }
    __syncthreads();
}

constexpr int N_PHASES = 23;
__global__ void __launch_bounds__(NTHR, 2) fwd(Args args) {
    extern __shared__ __attribute__((aligned(16))) unsigned char lds_raw[];
    LAS unsigned char* lds = (LAS unsigned char*)lds_raw;
    cg::grid_group grid = cg::this_grid();
    { volatile LAS unsigned* st0 = (volatile LAS unsigned*)(lds + 131072 + 64); if (threadIdx.x < 2) st0[threadIdx.x] = 0u; __syncthreads(); }
    const XcdBarrier xbar = xcd_barrier_post((unsigned*)(args.ws + WS_BAR), (volatile LAS unsigned*)(lds + 131072 + 64));
    const int G = gridDim.x, bx = blockIdx.x;
#define PHASE_LOCALS int t_ = threadIdx.x; asm volatile("" : "+v"(t_)); const int tid = t_, lane = tid & 63, wave = __builtin_amdgcn_readfirstlane(tid >> 6), gw = bx * NWAVES + wave, NGW = G * NWAVES; (void)tid; (void)lane; (void)gw; (void)NGW;
#define ws WSP
#define X (OUTP + O_Y)
#define HN ((bf16*)(WSP + WS_HN))
#define U ((bf16*)(WSP + WS_U))
#define FF ((bf16*)(WSP + WS_U))
#define PB ((float*)(WSP + WS_P))
#define MOD ((float*)(WSP + WS_MOD))
#define CS ((bf16*)(WSP + WS_CS))
    const int lo = args.ph_lo, hi = args.ph_hi;
#ifndef PROBE_P0
#define PROBE_P0 0
#endif
#ifndef PROBE_SYNC
#define PROBE_SYNC 0
#endif
#ifndef PROBE_RES
#define PROBE_RES 0
#endif
#ifndef PROBE_PREP
#define PROBE_PREP 0
#endif
#ifndef PROBE_REC
#define PROBE_REC 0
#endif
#ifndef PROBE_FIN
#define PROBE_FIN 0
#endif
#ifndef REP
#define REP 1
#endif
#ifndef SCM
#define SCM 15
#endif
#ifndef DBG_MASK
#define DBG_MASK 0x7ffff
#endif
#define PHON(k) ((DBG_MASK >> ((k) < 10 ? (k) : (k) - 8)) & 1)
#define IN(k) (lo <= (k) && (k) < hi)
#define SEAM(k) do { if (lo <= (k) && (k) + 1 < hi) { if ((k) == 0) grid.sync(); else xcd_barrier(xbar); } } while (0)

    for (int rp0_ = 0; rp0_ < 1 + (PROBE_P0 ? (hi > 22) : 0); ++rp0_) if (IN(0)) {
        PHASE_LOCALS
        LAS float* scr = (LAS float*)(lds + wave * 16384);
        constexpr int I_WIN = 16 * 248, I_PA = 20 * 32, I_PB = 16 * 32, I_WO = 16 * 32, I_W1 = 16 * 176, I_W2 = 44 * 32, I_ADA = 16 * 192;
        constexpr int I_L = I_WIN + I_PA + I_PB + I_WO + I_W1 + I_W2 + I_ADA;
        for (int it = gw; it < 2 * I_L; it += NGW) {
            const int l = it / I_L; int r = it % I_L;
            if (r < I_WIN) { transpose_item(inp(11) + (size_t)l * D * 7696, D, 7696, (bf16*)(ws + WS_WIN + l * SZ_WIN), D, 0, 248, 1, scr, r, lane); continue; } r -= I_WIN;
            if (r < I_PA) { transpose_item(inp(22) + (size_t)l * DR * D, DR, D, (bf16*)(ws + WS_WPJ + l * SZ_WPJ), DR + DVT, 0, 32, 0, scr, r, lane); continue; } r -= I_PA;
            if (r < I_PB) { transpose_item(inp(23) + (size_t)l * DVT * D, DVT, D, (bf16*)(ws + WS_WPJ + l * SZ_WPJ), DR + DVT, DR, 32, 0, scr, r, lane); continue; } r -= I_PB;
            if (r < I_WO) { transpose_item(inp(24) + (size_t)l * D * D, D, D, (bf16*)(ws + WS_WOUT + l * SZ_WOUT), D, 0, 32, 0, scr, r, lane); continue; } r -= I_WO;
            if (r < I_W1) { transpose_item(inp(25) + (size_t)l * D * 2 * DFF, D, 2 * DFF, (bf16*)(ws + WS_W1 + l * SZ_W1), D, 0, 176, 2, scr, r, lane); continue; } r -= I_W1;
            if (r < I_W2) { transpose_item(inp(26) + (size_t)l * DFF * D, DFF, D, (bf16*)(ws + WS_W2 + l * SZ_W2), DFF, 0, 32, 0, scr, r, lane); continue; } r -= I_W2;
            transpose_item(inp(9) + (size_t)l * D * NMOD, D, NMOD, (bf16*)(ws + WS_ADA + l * SZ_ADA), D, 0, 192, 0, scr, r, lane);
        }
        bf16* WG = (bf16*)(ws + WS_WG);
        for (int idx = bx * NTHR + tid; idx < 2 * 10 * 256 * 128; idx += G * NTHR) {
            const int l = idx / 327680, r = idx % 327680, n = r >> 15, vv = (r >> 7) & 255, wi = r & 127;
            const float* src = (vv < 128 ? inp(14) : inp(16)) + ((size_t)(l * 10 + n) * 128 + wi) * 128 + (vv & 127);
            WG[idx] = f2bf1(*src);
        }
        for (int idx = bx * NTHR + tid; idx < 256 * D; idx += G * NTHR) {
            const int row = idx >> 10, col = idx & 1023; float v = 0.f;
            if (row < 8) v = inp(2)[row * D + col]; else if (row < NB) v = inp(3)[(row - 8) * D + col];
            CS[idx] = f2bf1(v * fsigmoid(v));
        }
    }
    SEAM(0);
    for (int rp1_ = 0; rp1_ < 1 + (PROBE_P0 ? (hi > 22) : 0); ++rp1_) if (IN(1)) {
        for (int l = 0; l < 2; ++l) {
            pg8::Gemm g{CS, (const bf16*)(ws + WS_ADA + l * SZ_ADA), 256, NMOD, D, D, D}; pg8::StaticOrder S; S.init(256, NMOD, G, (bx + 128 * l) % G);
            pg8::EpiMod E{MOD + (size_t)l * NB * NMOD, inp(10) + (size_t)l * NMOD};
            pg8::gemm_phase<pg8::EpiMod, pg8::StaticOrder, true, true>(lds, g, S, E);
        }
    }
    SEAM(1);
    for (int l = 0; l < 2; ++l) {
        const int pb = 2 + 10 * l;
#define modl (MOD + (size_t)l * NB * NMOD)
        if (IN(pb)) {
            PHASE_LOCALS
            for (int row = gw; row < M; row += NGW) {
                const float* xr = l == 0 ? (row < MP ? inp(0) + (size_t)row * D : inp(1) + (size_t)(row - MP) * D) : X + (size_t)row * D;
                const float* mb = modl + (size_t)row_batch(row) * NMOD;
                norm_row(xr, inp(7) + l * D, mb + 1024, mb, HN + (size_t)row * D, nullptr, lane);
            }
        }
        SEAM(pb);
        if (IN(pb + 1)) {
            pg8::Gemm g{HN, (const bf16*)(ws + WS_WIN + l * SZ_WIN), M, NINP, D, D, D}; pg8::StaticOrder S; S.init(M, NINP, G, bx);
            pg8::EpiWin E{U};
            pg8::gemm_phase<pg8::EpiWin, pg8::StaticOrder, true, true>(lds, g, S, E);
        }
        SEAM(pb + 1);
        if (IN(pb + 2)) {
            const int nrep = 1 + (PROBE_PREP ? (hi > 22) : 0);
            for (int rp_ = 0; rp_ < nrep; ++rp_) { const int dry = rp_ < nrep - 1;
            for (int item = bx; item < 1536; item += G) gla_prep(lds, l, item, dry); }
        }
        SEAM(pb + 2);
        if (IN(pb + 3)) {
            ScanP P; P.l = l;
            float* const o_gla_p = OUTP + O_GLAP + (size_t)l * 8 * 4 * 32768; float* const o_gla_s = OUTP + O_GLAS + (size_t)l * 128 * 4 * 32768;
            const int nrep = 1 + (PROBE_REC ? (hi > 22) : 0);
            for (int rp_ = 0; rp_ < nrep; ++rp_) { const int dry = rp_ < nrep - 1; const int dryg = dry | (PROBE_REC == 2 && nrep == 2), dryl = dry | (PROBE_REC == 3 && nrep == 2), drys = dry | (PROBE_REC == 4 && nrep == 2); (void)dryg; (void)dryl; (void)drys;
            if (bx < 64) { if (PROBE_REC <= 1 || PROBE_REC == 2 || !dry) { const int b = bx >> 3, h = (bx >> 1) & 3, vh = bx & 1; gla_rec(lds, l, h, vh, b * SEQ, SEQ / 64, 64, b * 32, nullptr, o_gla_p + (size_t)(b * 4 + h) * 32768 + vh * 128, dry); } }
            else if (bx < 144) { if (PROBE_REC <= 1 || PROBE_REC == 3 || !dry) lru_item<false>(lds, P, bx - 64, dry); }
            else if (PROBE_REC <= 1 || PROBE_REC == 4 || !dry) {
                for (int j = bx - 144; j < 1104; j += (G - 144)) {
                    if (j < 1024) { const int b = j >> 3, h = (j >> 1) & 3, vh = j & 1;
                        gla_rec(lds, l, h, vh, MP + b * 4, 1, 4, 256 + b, inp(6) + (size_t)l * 128 * 4 * 32768 + (size_t)(b * 4 + h) * 32768 + vh * 128, o_gla_s + (size_t)(b * 4 + h) * 32768 + vh * 128, dry); }
                    else lru_item<true>(lds, P, j - 1024, dry);
                }
            }
            if (nrep > 1) __syncthreads(); }
        }
        SEAM(pb + 3);
        if (IN(pb + 4)) {
            PHASE_LOCALS
            const int nrep = 1 + (PROBE_FIN ? (hi > 22) : 0);
            for (int rp_ = 0; rp_ < nrep; ++rp_) { const int dry = rp_ < nrep - 1;
            for (int row = gw; row < M; row += NGW) gla_fin_row(U, inp(21) + (size_t)l * DVT, row, lane, dry); }
        }
        SEAM(pb + 4);
        if (IN(pb + 5)) {
            const bf16* wpj = (const bf16*)(ws + WS_WPJ + l * SZ_WPJ);
            { pg8::Gemm g{U + G0, wpj, MP, D, DR, NINP, DR + DVT}; pg8::StaticOrder S; S.init(MP, D, G, bx); pg8::EpiProj E{U, PB, HN, 0};
              pg8::gemm_phase<pg8::EpiProj, pg8::StaticOrder, true, true>(lds, g, S, E); }
            { pg8::Gemm g{U + R0, wpj + DR, MP, D, DVT, NINP, DR + DVT}; pg8::StaticOrder S; S.init(MP, D, G, bx); pg8::EpiProj E{U, PB, HN, 1};
              pg8::gemm_phase<pg8::EpiProj, pg8::StaticOrder, true, true>(lds, g, S, E); }
            if (bx >= G - 128) {
                const int j = G - 1 - bx, rt = j >> 4, ct = j & 15; const int rowt = MP + 64 * rt, colt = 64 * ct;
                f32x4 aa[2] = {{0.f, 0.f, 0.f, 0.f}, {0.f, 0.f, 0.f, 0.f}}, ab[2] = {{0.f, 0.f, 0.f, 0.f}, {0.f, 0.f, 0.f, 0.f}};
                small_gemm(lds, U + (size_t)rowt * NINP + G0, NINP, wpj + (size_t)colt * (DR + DVT), DR + DVT, DR, aa);
                small_gemm(lds, U + (size_t)rowt * NINP + R0, NINP, wpj + (size_t)colt * (DR + DVT) + DR, DR + DVT, DVT, ab);
                int t_ = threadIdx.x; asm volatile("" : "+v"(t_)); const int lane = t_ & 63, w = t_ >> 6, fr = lane & 15, fq = lane >> 4;
#pragma unroll
                for (int n = 0; n < 2; ++n)
#pragma unroll
                    for (int e = 0; e < 4; ++e) { const int row = rowt + 16 * (w & 3) + 4 * fq + e, col = colt + 32 * (w >> 2) + 16 * n + fr; const bf16* up = U + (size_t)row * NINP + col;
                        HN[(size_t)row * D + col] = f2bf1(bf2f(up[GA0]) * aa[n][e] + bf2f(up[GB0]) * ab[n][e]); }
            }
        }
        SEAM(pb + 5);
        if (IN(pb + 6)) {
            pg8::Gemm g{HN, (const bf16*)(ws + WS_WOUT + l * SZ_WOUT), MP, D, D, D, D}; pg8::StaticOrder S; S.init(MP, D, G, bx);
            const int nrep = 1 + (PROBE_RES ? (hi > 22) : 0);
            for (int rp_ = 0; rp_ < nrep; ++rp_) {
            pg8::EpiRes E{l == 0 ? inp(0) : X, l == 0 ? inp(1) : X + (size_t)MP * D, X, modl + 2048, rp_ < nrep - 1};
            pg8::gemm_phase<pg8::EpiRes, pg8::StaticOrder, true, true>(lds, g, S, E); }
            if (bx >= G - 128) { const int j = G - 1 - bx, rt = j >> 4, ct = j & 15; const int rowt = MP + 64 * rt, colt = 64 * ct;
                f32x4 aa[2] = {{0.f, 0.f, 0.f, 0.f}, {0.f, 0.f, 0.f, 0.f}};
                small_gemm(lds, HN + (size_t)rowt * D, D, (const bf16*)(ws + WS_WOUT + l * SZ_WOUT) + (size_t)colt * D, D, D, aa);
                int t_ = threadIdx.x; asm volatile("" : "+v"(t_)); const int lane = t_ & 63, w = t_ >> 6, fr = lane & 15, fq = lane >> 4;
                const float* bs = l == 0 ? inp(1) : X + (size_t)MP * D;
#pragma unroll
                for (int n = 0; n < 2; ++n)
#pragma unroll
                    for (int e = 0; e < 4; ++e) { const int row = rowt + 16 * (w & 3) + 4 * fq + e, col = colt + 32 * (w >> 2) + 16 * n + fr;
                        X[(size_t)row * D + col] = bs[(size_t)(row - MP) * D + col] + (modl + 2048)[(size_t)row_batch(row) * NMOD + col] * aa[n][e]; }
            }
        }
        SEAM(pb + 6);
        if (IN(pb + 7)) {
            PHASE_LOCALS
            for (int row = gw; row < M; row += NGW) {
                const float* mb = modl + (size_t)row_batch(row) * NMOD;
                norm_row(X + (size_t)row * D, inp(8) + l * D, mb + 4096, mb + 3072, HN + (size_t)row * D, nullptr, lane);
            }
        }
        SEAM(pb + 7);
        if (IN(pb + 8)) {
            pg8::Gemm g{HN, (const bf16*)(ws + WS_W1 + l * SZ_W1), M, 2 * DFF, D, D, D}; pg8::StaticOrder S; S.init(M, 2 * DFF, G, bx);
            pg8::EpiSwiglu E{FF};
            pg8::gemm_phase<pg8::EpiSwiglu, pg8::StaticOrder, true, true>(lds, g, S, E);
        }
        SEAM(pb + 8);
        if (IN(pb + 9)) {
            pg8::Gemm g{FF, (const bf16*)(ws + WS_W2 + l * SZ_W2), MP, D, DFF, DFF, DFF}; pg8::StaticOrder S; S.init(MP, D, G, bx);
            const int nrep = 1 + (PROBE_RES ? (hi > 22) : 0);
            for (int rp_ = 0; rp_ < nrep; ++rp_) {
            pg8::EpiRes E{X, X + (size_t)MP * D, X, modl + 5120, rp_ < nrep - 1};
            pg8::gemm_phase<pg8::EpiRes, pg8::StaticOrder, true, true>(lds, g, S, E); }
            if (bx >= G - 128) { const int j = G - 1 - bx, rt = j >> 4, ct = j & 15; const int rowt = MP + 64 * rt, colt = 64 * ct;
                f32x4 aa[2] = {{0.f, 0.f, 0.f, 0.f}, {0.f, 0.f, 0.f, 0.f}};
                small_gemm(lds, FF + (size_t)rowt * DFF, DFF, (const bf16*)(ws + WS_W2 + l * SZ_W2) + (size_t)colt * DFF, DFF, DFF, aa);
                int t_ = threadIdx.x; asm volatile("" : "+v"(t_)); const int lane = t_ & 63, w = t_ >> 6, fr = lane & 15, fq = lane >> 4;
#pragma unroll
                for (int n = 0; n < 2; ++n)
#pragma unroll
                    for (int e = 0; e < 4; ++e) { const int row = rowt + 16 * (w & 3) + 4 * fq + e, col = colt + 32 * (w >> 2) + 16 * n + fr;
                        float* xp_ = X + (size_t)row * D + col; *xp_ = *xp_ + (modl + 5120)[(size_t)row_batch(row) * NMOD + col] * aa[n][e]; }
            }
        }
        SEAM(pb + 9);
    }
    if (IN(22)) {
        PHASE_LOCALS
        for (int row = gw; row < M; row += NGW) norm_row(X + (size_t)row * D, inp(27), nullptr, nullptr, nullptr, X + (size_t)row * D, lane);
    }
#undef IN
#undef SEAM
#undef ws
#undef X
#undef HN
#undef U
#undef FF
#undef PB
#undef MOD
#undef CS
#undef modl
}

#ifndef MK_SPLIT
#define MK_SPLIT 0
#endif
extern "C" void kernel_launch(void* const* d_in, const int* in_sizes, int n_in, void* d_out, int out_size, void* d_ws, size_t ws_size, hipStream_t stream) {
    static int grid = 0;
    if (grid == 0) {
        if (n_in != 28 || (size_t)out_size != O_END || ws_size < WS_END) { fprintf(stderr, "kernel_launch: unexpected shapes (n_in %d, out %d, ws %zu, need %zu); nothing launched\n", n_in, out_size, ws_size, (size_t)WS_END); grid = -1; return; }
        int dev = 0, cus = 0, per_cu = 0;
        (void)hipGetDevice(&dev); (void)hipDeviceGetAttribute(&cus, hipDeviceAttributeMultiprocessorCount, dev);
        if (hipFuncSetAttribute((const void*)fwd, hipFuncAttributeMaxDynamicSharedMemorySize, LDS_BYTES) != hipSuccess) { fprintf(stderr, "kernel_launch: hipFuncSetAttribute failed\n"); grid = -1; return; }
        if (hipOccupancyMaxActiveBlocksPerMultiprocessor(&per_cu, (const void*)fwd, NTHR, LDS_BYTES) != hipSuccess || per_cu < 1) { fprintf(stderr, "kernel_launch: occupancy query says %d\n", per_cu); per_cu = 1; }
        (void)hipGetLastError();
        grid = 256;
        if (cus * per_cu < 256) { fprintf(stderr, "kernel_launch: device holds only %d x %d workgroups; this kernel needs 256 co-resident\n", cus, per_cu); grid = -1; return; }
    }
    if (grid < 0) return;
    if (hipMemsetAsync((char*)d_ws + WS_BAR, 0, 65536, stream) != hipSuccess) { fprintf(stderr, "kernel_launch: memset of barrier words failed\n"); return; }
    Args a{};
    for (int i = 0; i < 28; ++i) a.in[i] = (const float*)d_in[i];
    a.out = (float*)d_out; a.ws = (unsigned char*)d_ws;
#if MK_SPLIT
    for (int p = 0; p < N_PHASES; ++p) { a.ph_lo = p; a.ph_hi = p + 1; void* kargs[] = {&a};
        hipError_t e = hipLaunchCooperativeKernel((const void*)fwd, dim3(grid), dim3(NTHR), kargs, LDS_BYTES, stream);
        if (e != hipSuccess) { fprintf(stderr, "kernel_launch: launch failed: %s\n", hipGetErrorString(e)); break; } }
#else
    a.ph_lo = 0; a.ph_hi = N_PHASES; void* kargs[] = {&a};
    hipError_t e = hipLaunchCooperativeKernel((const void*)fwd, dim3(grid), dim3(NTHR), kargs, LDS_BYTES, stream);
    if (e != hipSuccess) fprintf(stderr, "kernel_launch: cooperative launch failed: %s (grid %d)\n", hipGetErrorString(e), grid);
#endif
}
```

```cpp
#include <hip/hip_runtime.h>
#include <hip/hip_cooperative_groups.h>
#include <cstdio>
#include <cstdint>
namespace cg = cooperative_groups;

constexpr int D = 1024, MP = 16384, MS = 512, M = MP + MS, NB = 136, SEQ = 2048;
constexpr int DR = 1280, DKT = 512, DVT = 1024, DFF = 2816, NINP = 7936, NMOD = 6144;
constexpr int X0 = 0, G0 = 1280, Q0 = 2560, K0 = 3072, V0 = 3584, R0 = 4608, GA0 = 5632, GB0 = 6656, LR0 = 7680;
constexpr float EPS = 1e-6f;

namespace pg8 {
#define PG8_LAS __attribute__((address_space(3)))
typedef unsigned short bf16_t;
typedef short bf16x8 __attribute__((ext_vector_type(8)));
typedef float f32x4 __attribute__((ext_vector_type(4)));
typedef unsigned u32x4 __attribute__((ext_vector_type(4)));
constexpr int BM = 256, BK = 64, HALF = 128, HTB = HALF * BK * 2  , STAGE_BYTES = 8 * HTB, NXCD = 8, WGM = 8;

__host__ __device__ __forceinline__ int lds_byte(int r, int c) { const int st = (r >> 4) * 2 + (c >> 5), rr = r & 15, cc = c & 31, ob = rr * 64 + cc * 2; return st * 1024 + (ob ^ (((ob >> 9) & 1) << 5)); }
__host__ __device__ __forceinline__ void stage_rc(int b, int& R, int& C) { const int st = b / 1024, sb = b % 1024, swz = sb ^ (((sb >> 9) & 1) << 5); R = (st >> 1) * 16 + swz / 64; C = (st & 1) * 32 + (swz % 64) / 2; }
__host__ __device__ __forceinline__ int perm32(int rho) { const int n = rho >> 4, i = rho & 15; return 8 * (i >> 2) + 4 * n + (i & 3); }

struct Unit { int pm, pn; };
struct Gemm { const bf16_t* A; const bf16_t* Bt; int M, N, K, lda, ldb; };

struct StaticOrder {
    int nM, nN, nwg, G, c;
    __host__ __device__ void init(int M, int N, int G_, int c_) { nM = M / BM; nN = N / BM; nwg = nM * nN; G = G_; c = c_; }
    __host__ __device__ bool next(int i, Unit& u) const {
        const long L = (long)i * G + c; if (L >= nwg) return false;
        int wgid = (int)L; { const int q = nwg / NXCD, r = nwg % NXCD, xcd = wgid % NXCD, off = wgid / NXCD; wgid = (xcd < r ? xcd * (q + 1) : r * (q + 1) + (xcd - r) * q) + off; }
        const int nig = WGM * nN, gid = wgid / nig, fm = gid * WGM, gsz = (nM - fm) < WGM ? (nM - fm) : WGM;
        u.pm = fm + ((wgid % nig) % gsz); u.pn = (wgid % nig) / gsz; return true;
    }
    __device__ __forceinline__ void a_ready(const Unit&) const {}
    __device__ __forceinline__ void done(const Unit&) const {}
};


typedef __bf16 bf16x2_t __attribute__((ext_vector_type(2)));
typedef float f32x2_t __attribute__((ext_vector_type(2)));
typedef unsigned u32x2 __attribute__((ext_vector_type(2)));
__device__ __forceinline__ unsigned cvtpk(float lo, float hi) { f32x2_t v = {lo, hi}; bf16x2_t b = __builtin_convertvector(v, bf16x2_t); return __builtin_bit_cast(unsigned, b); }
__device__ __forceinline__ float bflo(unsigned w) { return __uint_as_float(w << 16); }
__device__ __forceinline__ float bfhi(unsigned w) { return __uint_as_float(w & 0xffff0000u); }
__device__ __forceinline__ float bf2f(bf16_t h) { return __uint_as_float(((unsigned)h) << 16); }
__device__ __forceinline__ float fsigmoid(float z) { return __builtin_amdgcn_rcpf(1.0f + __builtin_amdgcn_exp2f(-1.4426950408889634f * z)); }
__device__ __forceinline__ float fexp(float z) { return __builtin_amdgcn_exp2f(1.4426950408889634f * z); }
__device__ __forceinline__ float act_apply(float x, int mode) {
    if (mode == 1) { const float z = 1.5957691216057308f * (x + 0.044715f * x * x * x); return x * fsigmoid(z); }
    if (mode == 2) return x * 0.08838834764831845f;
    if (mode == 3) return x * fsigmoid(x);
    if (mode == 4) return fsigmoid(x);
    return x;
}
__device__ __forceinline__ int row_batch(int row) { return row < MP ? (row >> 11) : 8 + ((row - MP) >> 2); }

struct EpiWin {
    static constexpr bool PERM = true, AFTER_DRAIN = false;
    bf16_t* U;
    __device__ __forceinline__ void operator()(const f32x4 (&acc)[2][2][4][2], const Unit& u, int wr, int wc, int fr, int fq) const {
        const int row0 = u.pm * BM + wr * 64 + fr, colt = u.pn * BM;
        int mode = 0;
        if (colt >= G0 && colt < Q0) mode = 1; else if (colt >= Q0 && colt < K0) mode = 2; else if (colt >= R0 && colt < GA0) mode = 3; else if (colt >= GA0 && colt < LR0) mode = 4;
        const int col0 = colt + wc * 32 + 8 * fq;
#pragma unroll
        for (int ai = 0; ai < 2; ++ai)
#pragma unroll
            for (int m = 0; m < 4; ++m) { bf16_t* rowp = U + (size_t)(row0 + ai * HALF + m * 16) * NINP + col0;
#pragma unroll
                for (int bj = 0; bj < 2; ++bj) { f32x4 v0 = acc[ai][bj][m][0], v1 = acc[ai][bj][m][1];
#pragma unroll
                    for (int e = 0; e < 4; ++e) { v0[e] = act_apply(v0[e], mode); v1[e] = act_apply(v1[e], mode); }
                    u32x4 w; w.x = cvtpk(v0[0], v0[1]); w.y = cvtpk(v0[2], v0[3]); w.z = cvtpk(v1[0], v1[1]); w.w = cvtpk(v1[2], v1[3]);
                    *(u32x4*)(rowp + bj * HALF) = w; }
                __builtin_amdgcn_sched_barrier(0); }
    }
};
struct EpiProj {
    static constexpr bool PERM = true, AFTER_DRAIN = false;
    const bf16_t* U; float* P; bf16_t* Mo; int second;
    __device__ __forceinline__ void operator()(const f32x4 (&acc)[2][2][4][2], const Unit& u, int wr, int wc, int fr, int fq) const {
        const int row0 = u.pm * BM + wr * 64 + fr, col0 = u.pn * BM + wc * 32 + 8 * fq; const int goff = second ? GB0 : GA0;
#pragma unroll
        for (int ai = 0; ai < 2; ++ai)
#pragma unroll
            for (int m = 0; m < 4; ++m) { const int row = row0 + ai * HALF + m * 16;
#pragma unroll
                for (int bj = 0; bj < 2; ++bj) { const int col = col0 + bj * HALF;
                    const u32x4 gw = *(const u32x4*)(U + (size_t)row * NINP + goff + col);
                    f32x4 g0 = {bflo(gw.x), bfhi(gw.x), bflo(gw.y), bfhi(gw.y)}, g1 = {bflo(gw.z), bfhi(gw.z), bflo(gw.w), bfhi(gw.w)};
                    f32x4 v0 = acc[ai][bj][m][0] * g0, v1 = acc[ai][bj][m][1] * g1;
                    float* pp = P + (size_t)row * D + col;
                    if (!second) { *(f32x4*)pp = v0; *(f32x4*)(pp + 4) = v1; }
                    else { v0 += *(const f32x4*)pp; v1 += *(const f32x4*)(pp + 4);
                        u32x4 w; w.x = cvtpk(v0[0], v0[1]); w.y = cvtpk(v0[2], v0[3]); w.z = cvtpk(v1[0], v1[1]); w.w = cvtpk(v1[2], v1[3]);
                        *(u32x4*)(Mo + (size_t)row * D + col) = w; } }
                __builtin_amdgcn_sched_barrier(0); }
    }
};
struct EpiRes {
    static constexpr bool PERM = false, AFTER_DRAIN = false;
    const float* base_p; const float* base_s; float* out; const float* gate; int dry;
    __device__ __forceinline__ void operator()(const f32x4 (&acc)[2][2][4][2], const Unit& u, int wr, int wc, int fr, int fq) const {
        const int row0 = u.pm * BM + wr * 64 + fr, col0 = u.pn * BM + wc * 32 + 4 * fq;
#pragma unroll
        for (int ai = 0; ai < 2; ++ai)
#pragma unroll
            for (int m = 0; m < 4; ++m) { const int row = row0 + ai * HALF + m * 16; const float* bp = row < MP ? base_p + (size_t)row * D : base_s + (size_t)(row - MP) * D;
                const float* gp = gate + (size_t)row_batch(row) * NMOD; float* op = out + (size_t)row * D;
#pragma unroll
                for (int bj = 0; bj < 2; ++bj)
#pragma unroll
                    for (int n = 0; n < 2; ++n) { const int col = col0 + bj * HALF + n * 16;
                        const f32x4 b = *(const f32x4*)(bp + col), g = *(const f32x4*)(gp + col);
                        const f32x4 rr = b + g * acc[ai][bj][m][n]; if (!dry || rr.x == 1.2345e30f) *(f32x4*)(op + col) = rr; }
                __builtin_amdgcn_sched_barrier(0); }
    }
};
struct EpiSwiglu {
    static constexpr bool PERM = true, AFTER_DRAIN = false;
    bf16_t* O;
    __device__ __forceinline__ void operator()(const f32x4 (&acc)[2][2][4][2], const Unit& u, int wr, int wc, int fr, int fq) const {
        const int row0 = u.pm * BM + wr * 64 + fr, col0 = u.pn * HALF + wc * 32 + 8 * fq;
#pragma unroll
        for (int ai = 0; ai < 2; ++ai)
#pragma unroll
            for (int m = 0; m < 4; ++m) { f32x4 v0, v1;
#pragma unroll
                for (int e = 0; e < 4; ++e) { const float a0 = acc[ai][0][m][0][e], a1 = acc[ai][0][m][1][e]; v0[e] = a0 * fsigmoid(a0) * acc[ai][1][m][0][e]; v1[e] = a1 * fsigmoid(a1) * acc[ai][1][m][1][e]; }
                u32x4 w; w.x = cvtpk(v0[0], v0[1]); w.y = cvtpk(v0[2], v0[3]); w.z = cvtpk(v1[0], v1[1]); w.w = cvtpk(v1[2], v1[3]);
                *(u32x4*)(O + (size_t)(row0 + ai * HALF + m * 16) * DFF + col0) = w;
                __builtin_amdgcn_sched_barrier(0); }
    }
};
struct EpiMod {
    static constexpr bool PERM = false, AFTER_DRAIN = false;
    float* out; const float* bias;
    __device__ __forceinline__ void operator()(const f32x4 (&acc)[2][2][4][2], const Unit& u, int wr, int wc, int fr, int fq) const {
        const int row0 = u.pm * BM + wr * 64 + fr, col0 = u.pn * BM + wc * 32 + 4 * fq;
#pragma unroll
        for (int ai = 0; ai < 2; ++ai)
#pragma unroll
            for (int m = 0; m < 4; ++m) { const int row = row0 + ai * HALF + m * 16; if (row < NB) {
#pragma unroll
                for (int bj = 0; bj < 2; ++bj)
#pragma unroll
                    for (int n = 0; n < 2; ++n) { const int col = col0 + bj * HALF + n * 16;
                        *(f32x4*)(out + (size_t)row * NMOD + col) = acc[ai][bj][m][n] + *(const f32x4*)(bias + col); } } }
    }
};

template <class Epi, class Sched, bool ALIGN_EPI = false, bool SP2 = false>
__device__ __forceinline__ void gemm_phase(PG8_LAS unsigned char* lds, const Gemm g, const Sched& S, const Epi& E) {
    int tid_ = threadIdx.x; asm volatile("" : "+v"(tid_));
    const int tid = tid_, wid = __builtin_amdgcn_readfirstlane(tid >> 6), lane = tid & 63, wr = wid >> 2, wc = wid & 3, fr = lane & 15, fq = lane >> 4;
    const int K = g.K, nt = K / BK;
    unsigned voffA[2], voffB[2];
#pragma unroll
    for (int i = 0; i < 2; ++i) { int R, C; stage_rc(tid * 16 + i * 8192, R, C); const int Rb = Epi::PERM ? ((R & ~31) + perm32(R & 31)) : R;
        voffA[i] = (unsigned)(R * g.lda + C) * 2u; voffB[i] = (unsigned)(Rb * g.ldb + C) * 2u; }
    const size_t kstep = (size_t)(BK * 2);
    const size_t hstepA = (size_t)HALF * g.lda * 2, hstepB = (size_t)HALF * g.ldb * 2;
    const size_t tstepA = 2 * hstepA, tstepB = 2 * hstepB;
    const unsigned ldsw = (unsigned)wid * 1024u;
    const int aoff = lds_byte(wr * 64 + fr, fq * 8), boff = lds_byte(wc * 32 + fr, fq * 8);
#define PG8_SA(b, h) (((b) * 2 + (h)) * HTB)
#define PG8_SB(b, h) ((4 + (b) * 2 + (h)) * HTB)
#define PG8_STAGE(bufoff, gbase, voff) do { _Pragma("unroll") for (int _i = 0; _i < 2; ++_i) \
        __builtin_amdgcn_global_load_lds((const unsigned*)((const char*)(gbase) + (voff)[_i]), (PG8_LAS unsigned*)(lds + (bufoff) + ldsw + _i * 8192), 16, 0, 0); } while (0)
#define PG8_LDA(dst, b, h) do { _Pragma("unroll") for (int m = 0; m < 4; ++m) _Pragma("unroll") for (int k = 0; k < 2; ++k) dst[m][k] = *(const PG8_LAS bf16x8*)(lds + PG8_SA(b, h) + aoff + m * 2048 + k * 1024); } while (0)
#define PG8_LDB(dst, b, h) do { _Pragma("unroll") for (int n = 0; n < 2; ++n) _Pragma("unroll") for (int k = 0; k < 2; ++k) dst[n][k] = *(const PG8_LAS bf16x8*)(lds + PG8_SB(b, h) + boff + n * 2048 + k * 1024); } while (0)
#define PG8_MMA(ai, bj, At, Bt) do { __builtin_amdgcn_s_setprio(1); _Pragma("unroll") for (int m = 0; m < 4; ++m) _Pragma("unroll") for (int n = 0; n < 2; ++n) _Pragma("unroll") for (int k = 0; k < 2; ++k) \
        acc[ai][bj][m][n] = __builtin_amdgcn_mfma_f32_16x16x32_bf16(Bt[n][k], At[m][k], acc[ai][bj][m][n], 0, 0, 0); __builtin_amdgcn_s_setprio(0); } while (0)
#define PG8_WAIT_V(n) asm volatile("s_waitcnt vmcnt(" #n ")" ::: "memory")
#define PG8_WAIT_L(n) asm volatile("s_waitcnt lgkmcnt(" #n ")" ::: "memory")
#define PG8_BAR __builtin_amdgcn_s_barrier()
#define PG8_SCHED __builtin_amdgcn_sched_barrier(0)
    Unit cur, nxt; int ui = 0;
    if (!S.next(0, cur)) return;
    f32x4 acc[2][2][4][2];
#pragma unroll
    for (int a = 0; a < 2; ++a)
#pragma unroll
        for (int b = 0; b < 2; ++b)
#pragma unroll
            for (int m = 0; m < 4; ++m)
#pragma unroll
                for (int n = 0; n < 2; ++n) acc[a][b][m][n] = (f32x4){0.f, 0.f, 0.f, 0.f};
    bf16x8 At[4][2], B0[2][2], B1[2][2];
    const char* cA = (const char*)g.A + (size_t)cur.pm * tstepA; const char* cB = (const char*)g.Bt + (size_t)cur.pn * tstepB;
    S.a_ready(cur);
    if constexpr (SP2) {
        PG8_STAGE(PG8_SB(0, 0), cB, voffB); PG8_STAGE(PG8_SB(0, 1), cB + hstepB, voffB); PG8_STAGE(PG8_SA(0, 0), cA, voffA); PG8_STAGE(PG8_SA(0, 1), cA + hstepA, voffA);
        if (wr == 1) PG8_BAR;
        PG8_WAIT_V(2); PG8_BAR;
        PG8_STAGE(PG8_SB(1, 0), cB + kstep, voffB); PG8_STAGE(PG8_SA(1, 0), cA + kstep, voffA); PG8_STAGE(PG8_SB(1, 1), cB + hstepB + kstep, voffB);
        PG8_WAIT_V(6); PG8_BAR;
    } else {
        PG8_STAGE(PG8_SB(0, 0), cB, voffB); PG8_STAGE(PG8_SA(0, 0), cA, voffA); PG8_STAGE(PG8_SB(0, 1), cB + hstepB, voffB); PG8_STAGE(PG8_SA(0, 1), cA + hstepA, voffA);
        if (wr == 1) PG8_BAR;
        PG8_WAIT_V(4); PG8_BAR;
        PG8_STAGE(PG8_SB(1, 0), cB + kstep, voffB); PG8_STAGE(PG8_SA(1, 0), cA + kstep, voffA); PG8_STAGE(PG8_SB(1, 1), cB + hstepB + kstep, voffB);
        PG8_WAIT_V(6); PG8_BAR;
    }
    for (;;) {
        const bool has_next = S.next(ui + 1, nxt);
        const char* nA = has_next ? (const char*)g.A + (size_t)nxt.pm * tstepA : cA; const char* nB = has_next ? (const char*)g.Bt + (size_t)nxt.pn * tstepB : cB;
        for (int t = 0; t < nt; t += 2) {
            const bool last = (t == nt - 2);
            const char* a1 = cA + (size_t)(t + 1) * kstep;
            const char* a2 = last ? nA : cA + (size_t)(t + 2) * kstep; const char* b2 = last ? nB : cB + (size_t)(t + 2) * kstep;
            const char* a3 = a2 + kstep; const char* b3 = b2 + kstep;
            if (last && has_next) S.a_ready(nxt);
            if constexpr (SP2) {
            PG8_LDB(B0, 0, 0); PG8_LDB(B1, 0, 1); PG8_SCHED; PG8_LDA(At, 0, 0); PG8_STAGE(PG8_SA(1, 1), a1 + hstepA, voffA);
            PG8_WAIT_V(8); PG8_WAIT_L(0); PG8_BAR; PG8_MMA(0, 0, At, B0); PG8_MMA(0, 1, At, B1); PG8_BAR; PG8_SCHED;
            PG8_LDA(At, 0, 1); PG8_STAGE(PG8_SB(0, 0), b2, voffB); PG8_STAGE(PG8_SB(0, 1), b2 + hstepB, voffB); PG8_STAGE(PG8_SA(0, 0), a2, voffA);
            PG8_WAIT_V(8); PG8_WAIT_L(0); PG8_BAR; PG8_MMA(1, 0, At, B0); PG8_MMA(1, 1, At, B1); PG8_BAR; PG8_SCHED;
            PG8_LDB(B0, 1, 0); PG8_LDB(B1, 1, 1); PG8_SCHED; PG8_LDA(At, 1, 0); PG8_STAGE(PG8_SA(0, 1), a2 + hstepA, voffA);
            PG8_WAIT_V(8); PG8_WAIT_L(0); PG8_BAR; PG8_MMA(0, 0, At, B0); PG8_MMA(0, 1, At, B1); PG8_BAR; PG8_SCHED;
            PG8_LDA(At, 1, 1); PG8_STAGE(PG8_SB(1, 0), b3, voffB); PG8_STAGE(PG8_SB(1, 1), b3 + hstepB, voffB); PG8_STAGE(PG8_SA(1, 0), a3, voffA);
            PG8_WAIT_V(8); PG8_WAIT_L(0); PG8_BAR; PG8_MMA(1, 0, At, B0); PG8_MMA(1, 1, At, B1); PG8_BAR; PG8_SCHED;
            } else {
            PG8_LDB(B0, 0, 0); PG8_SCHED; PG8_LDA(At, 0, 0); PG8_STAGE(PG8_SA(1, 1), a1 + hstepA, voffA);
            PG8_WAIT_L(8); PG8_BAR; PG8_WAIT_L(0); PG8_MMA(0, 0, At, B0); PG8_BAR; PG8_SCHED;
            PG8_LDB(B1, 0, 1); PG8_STAGE(PG8_SB(0, 0), b2, voffB);
            PG8_BAR; PG8_WAIT_L(0); PG8_MMA(0, 1, At, B1); PG8_BAR;
            PG8_LDA(At, 0, 1); PG8_STAGE(PG8_SA(0, 0), a2, voffA);
            PG8_BAR; PG8_WAIT_L(0); PG8_MMA(1, 0, At, B0); PG8_BAR; PG8_SCHED;
            PG8_STAGE(PG8_SB(0, 1), b2 + hstepB, voffB);
            PG8_WAIT_V(6); PG8_BAR; PG8_MMA(1, 1, At, B1); PG8_BAR;
            PG8_LDB(B0, 1, 0); PG8_SCHED; PG8_LDA(At, 1, 0); PG8_STAGE(PG8_SA(0, 1), a2 + hstepA, voffA);
            PG8_WAIT_L(8); PG8_BAR; PG8_WAIT_L(0); PG8_MMA(0, 0, At, B0); PG8_BAR; PG8_SCHED;
            PG8_LDB(B1, 1, 1); PG8_STAGE(PG8_SB(1, 0), b3, voffB);
            PG8_BAR; PG8_WAIT_L(0); PG8_MMA(0, 1, At, B1); PG8_BAR;
            PG8_LDA(At, 1, 1); PG8_STAGE(PG8_SA(1, 0), a3, voffA);
            PG8_BAR; PG8_WAIT_L(0); PG8_MMA(1, 0, At, B0); PG8_BAR; PG8_SCHED;
            PG8_STAGE(PG8_SB(1, 1), b3 + hstepB, voffB);
            PG8_WAIT_V(6); PG8_BAR; PG8_MMA(1, 1, At, B1); PG8_BAR;
            }
        }
        if constexpr (ALIGN_EPI) { if (wr == 0) PG8_BAR; }
        if constexpr (!Epi::AFTER_DRAIN) { E(acc, cur, wr, wc, fr, fq); S.done(cur); }
        if (!has_next) break;
#pragma unroll
        for (int a = 0; a < 2; ++a)
#pragma unroll
            for (int b = 0; b < 2; ++b)
#pragma unroll
                for (int m = 0; m < 4; ++m)
#pragma unroll
                    for (int n = 0; n < 2; ++n) acc[a][b][m][n] = (f32x4){0.f, 0.f, 0.f, 0.f};
        cur = nxt; cA = nA; cB = nB; ++ui;
        if constexpr (ALIGN_EPI) { if (wr == 1) PG8_BAR; }
    }
    PG8_WAIT_V(0);
    if constexpr (!ALIGN_EPI) { if (wr == 0) PG8_BAR; }
    PG8_BAR;
    if constexpr (Epi::AFTER_DRAIN) { E.fused(acc, cur, wr, wc, fr, fq, lds, wid, lane); S.done(cur); }
#undef PG8_SA
#undef PG8_SB
#undef PG8_STAGE
#undef PG8_LDA
#undef PG8_LDB
#undef PG8_MMA
#undef PG8_WAIT_V
#undef PG8_WAIT_L
#undef PG8_BAR
#undef PG8_SCHED
}
}

#define LAS __attribute__((address_space(3)))
typedef unsigned short bf16;
typedef float f32x4 __attribute__((ext_vector_type(4)));
typedef short bf16x8 __attribute__((ext_vector_type(8)));
typedef short bf16x4 __attribute__((ext_vector_type(4)));
typedef unsigned u32x4 __attribute__((ext_vector_type(4)));
typedef unsigned u32x2 __attribute__((ext_vector_type(2)));
using pg8::cvtpk; using pg8::bflo; using pg8::bfhi; using pg8::bf2f; using pg8::fsigmoid; using pg8::fexp; using pg8::row_batch;
constexpr int NWAVES = 8, NTHR = 512, LDS_BYTES = 147456;
constexpr size_t MiB = 1u << 20;
constexpr size_t WS_BAR = 0;
constexpr size_t WS_WIN = 1 * MiB;
constexpr size_t SZ_WIN = (size_t)NINP * D * 2;
constexpr size_t WS_WPJ = WS_WIN + 2 * SZ_WIN;
constexpr size_t SZ_WPJ = (size_t)D * (DR + DVT) * 2;
constexpr size_t WS_WOUT = WS_WPJ + 2 * SZ_WPJ;
constexpr size_t SZ_WOUT = (size_t)D * D * 2;
constexpr size_t WS_W1 = WS_WOUT + 2 * SZ_WOUT;
constexpr size_t SZ_W1 = (size_t)2 * DFF * D * 2;
constexpr size_t WS_W2 = WS_W1 + 2 * SZ_W1;
constexpr size_t SZ_W2 = (size_t)D * DFF * 2;
constexpr size_t WS_ADA = WS_W2 + 2 * SZ_W2;
constexpr size_t SZ_ADA = (size_t)NMOD * D * 2;
constexpr size_t WS_WG = WS_ADA + 2 * SZ_ADA;
constexpr size_t SZ_WG = (size_t)10 * 256 * 128 * 2;
constexpr size_t WS_CS = WS_WG + 2 * SZ_WG;
constexpr size_t WS_MOD = WS_CS + (size_t)256 * D * 2;
constexpr size_t SZ_MOD = (size_t)NB * NMOD * 4;
constexpr size_t WS_HN = ((WS_MOD + 2 * SZ_MOD + MiB - 1) / MiB) * MiB;
constexpr size_t WS_U = WS_HN + (size_t)M * D * 2;
constexpr size_t WS_P = WS_U + (size_t)M * NINP * 2;
constexpr size_t WS_END = WS_P + (size_t)M * D * 4;
constexpr size_t WS_KD = WS_P;
constexpr size_t WS_EL = WS_P + 32 * MiB;
static_assert(WS_KD + (size_t)1536 * 16384 <= WS_EL && WS_EL + (size_t)1536 * 512 <= WS_END, "KD/EL overlay P");

struct Args {
    const float* in[28]; float* out; unsigned char* ws; int ph_lo, ph_hi;
};
constexpr size_t O_Y = 0, O_CONVP = (size_t)M * D, O_LRUP = O_CONVP + 2 * 8 * 3 * DR, O_GLAP = O_LRUP + 2 * 8 * DR, O_CONVS = O_GLAP + (size_t)2 * 8 * 4 * 128 * 256,
                 O_LRUS = O_CONVS + (size_t)2 * 128 * 3 * DR, O_GLAS = O_LRUS + (size_t)2 * 128 * DR, O_END = O_GLAS + (size_t)2 * 128 * 4 * 128 * 256;

__device__ __forceinline__ float bperm(int srclane, float v) { return __int_as_float(__builtin_amdgcn_ds_bpermute(srclane << 2, __float_as_int(v))); }
__device__ __forceinline__ float wave_sum(float v, int lane) {
#pragma unroll
    for (int o = 1; o < 64; o <<= 1) v += bperm(lane ^ o, v);
    return v;
}
__device__ __forceinline__ int src_col(int np, int mapmode) {
    if (mapmode == 1) { if (np < GA0) return np; if (np < LR0) return np + 16; if (np < LR0 + 16) return np - LR0 + 5632; return -1; }
    if (mapmode == 2) { const int pn = np >> 8, bj = (np >> 7) & 1, j = np & 127; return bj * DFF + pn * 128 + j; }
    return np;
}
__device__ __forceinline__ void transpose_item(const float* W, int K, int N, bf16* WT, int ldt, int koff, int nblk, int mapmode, LAS float* scr, int item, int lane) {
    const int kb = item / nblk, nb = item % nblk, k0 = 64 * kb, n0 = 32 * nb;
    const int sc = src_col(n0 + (lane & 31), mapmode);
    float v[32];
#pragma unroll
    for (int i = 0; i < 32; ++i) { const int kk = 2 * i + (lane >> 5); v[i] = sc >= 0 ? W[(size_t)(k0 + kk) * N + sc] : 0.f; }
#pragma unroll
    for (int i = 0; i < 32; ++i) { const int kk = 2 * i + (lane >> 5); scr[kk * 33 + (lane & 31)] = v[i]; }
    asm volatile("s_waitcnt lgkmcnt(0)" ::: "memory");
    const int c = lane & 7;
#pragma unroll
    for (int j = 0; j < 4; ++j) { const int n = (lane >> 3) + 8 * j; const LAS float* s = scr + (8 * c) * 33 + n;
        u32x4 o; o.x = cvtpk(s[0 * 33], s[1 * 33]); o.y = cvtpk(s[2 * 33], s[3 * 33]); o.z = cvtpk(s[4 * 33], s[5 * 33]); o.w = cvtpk(s[6 * 33], s[7 * 33]);
        *(u32x4*)(WT + (size_t)(n0 + n) * ldt + koff + k0 + 8 * c) = o; }
    asm volatile("s_waitcnt lgkmcnt(0)" ::: "memory");
}
__device__ __forceinline__ void norm_row(const float* xrow, const float* g, const float* sc, const float* sh, bf16* orow, float* orow_f, int lane) {
    const f32x4* xr = (const f32x4*)xrow + lane; f32x4 v[4]; float s = 0.f;
#pragma unroll
    for (int j = 0; j < 4; ++j) { v[j] = xr[64 * j]; s += (v[j].x * v[j].x + v[j].y * v[j].y) + (v[j].z * v[j].z + v[j].w * v[j].w); }
    const float rstd = 1.0f / sqrtf(wave_sum(s, lane) * (1.0f / D) + EPS);
#pragma unroll
    for (int j = 0; j < 4; ++j) { const int col = 4 * lane + 256 * j; const f32x4 gg = *(const f32x4*)(g + col);
        f32x4 o = v[j] * rstd * gg;
        if (orow_f) { *(f32x4*)(orow_f + col) = o; }
        else { const f32x4 a = *(const f32x4*)(sc + col), b = *(const f32x4*)(sh + col); o = o * (a + 1.0f) + b;
            u32x2 w; w.x = cvtpk(o.x, o.y); w.y = cvtpk(o.z, o.w); *(u32x2*)(orow + col) = w; } }
}

struct ScanP { int l; };
typedef const float* fptr_t;
__device__ __forceinline__ fptr_t inp(int i) {
    const __attribute__((address_space(4))) unsigned char* kp = (const __attribute__((address_space(4))) unsigned char*)__builtin_amdgcn_kernarg_segment_ptr();
    asm volatile("" : "+s"(kp));
    return *(const __attribute__((address_space(4))) fptr_t*)(kp + 8 * i);
}
#define WSP ((unsigned char*)inp(29))
#define OUTP ((float*)inp(28))
__device__ __forceinline__ bf16 f2bf1(float x) { return (bf16)(cvtpk(x, 0.f) & 0xffffu); }
#define MFMA16(a, b, c) __builtin_amdgcn_mfma_f32_16x16x32_bf16((a), (b), (c), 0, 0, 0)

template <bool SAMPLE>
__device__ __forceinline__ void lru_item(LAS unsigned char* lds, const ScanP& P, int item, int dry = 0) {
    int tid_ = threadIdx.x; asm volatile("" : "+v"(tid_));
    const int tid = tid_, lane = tid & 63, w = __builtin_amdgcn_readfirstlane(tid >> 6), fr = lane & 15, fq = lane >> 4;
    const int n = item % 10, bb = item / 10;
    const int row0 = SAMPLE ? MP + bb * 64 : bb * SEQ;
    const int nch = SAMPLE ? 1 : SEQ / 64;
    LAS bf16* XC = (LAS bf16*)lds;
    const int l = P.l; bf16* const U = (bf16*)(WSP + WS_U);
    const bf16* wg = (const bf16*)(WSP + WS_WG + l * SZ_WG) + (size_t)n * 256 * 128;
    bf16x8 Bw[2][4];
#pragma unroll
    for (int nt = 0; nt < 2; ++nt)
#pragma unroll
        for (int ks = 0; ks < 4; ++ks) Bw[nt][ks] = *(const bf16x8*)(wg + (size_t)(nt * 128 + 16 * w + fr) * 128 + 32 * ks + 8 * fq);
    const int ch = n * 128 + 16 * w + fr;
    const float ba = (inp(15) + (size_t)l * DR)[ch], bx = (inp(17) + (size_t)l * DR)[ch], lam = (inp(18) + (size_t)l * DR)[ch];
    const float cl = -8.0f * log1pf(expf(-lam));
    const int cg = tid & 15, tt = tid >> 4, cch = n * 128 + 8 * cg;
    float cw[4][8], cb[8];
#pragma unroll
    for (int i = 0; i < 4; ++i)
#pragma unroll
        for (int j = 0; j < 8; ++j) cw[i][j] = (inp(12) + (size_t)l * 4 * DR)[i * DR + cch + j];
#pragma unroll
    for (int j = 0; j < 8; ++j) cb[j] = (inp(13) + (size_t)l * DR)[cch + j];
    const float* const st_conv = SAMPLE ? inp(4) + (size_t)l * 128 * 3 * DR : nullptr; const float* const st_lru = SAMPLE ? inp(5) + (size_t)l * 128 * DR : nullptr;
    float* const o_lru_s = OUTP + O_LRUS + (size_t)l * 128 * DR;
    float hc = 0.f;
    u32x4 uq[2][4];
#define LRU_LOADC(c_) do { _Pragma("unroll") for (int p = 0; p < 2; ++p) _Pragma("unroll") for (int d = 0; d < 4; ++d) { const int tl_ = tt + 32 * p; const u32x4 z4 = {0u, 0u, 0u, 0u}; uq[p][d] = z4; \
        if ((c_) * 64 + tl_ - d >= 0) uq[p][d] = *(const u32x4*)(U + (size_t)(row0 + (c_) * 64 + tl_ - d) * NINP + X0 + cch); } } while (0)
    if (!SAMPLE) LRU_LOADC(0);
    for (int c = 0; c < nch; ++c) {
        const int r0 = row0 + c * 64;
#pragma unroll
        for (int p = 0; p < 2; ++p) {
            const int tl = tt + 32 * p; float xc[8];
#pragma unroll
            for (int j = 0; j < 8; ++j) xc[j] = cb[j];
#pragma unroll
            for (int d = 0; d < 4; ++d) {
                float uv[8];
                bool from_u, zero = false;
                if (!SAMPLE) { from_u = (c * 64 + tl - d) >= 0; zero = !from_u; } else { from_u = ((tl & 3) - d) >= 0; }
                if (!SAMPLE) { const u32x4 q = uq[p][d];
                    uv[0] = bflo(q.x); uv[1] = bfhi(q.x); uv[2] = bflo(q.y); uv[3] = bfhi(q.y); uv[4] = bflo(q.z); uv[5] = bfhi(q.z); uv[6] = bflo(q.w); uv[7] = bfhi(q.w); }
                else if (from_u) { const u32x4 q = *(const u32x4*)(U + (size_t)(r0 + tl - d) * NINP + X0 + cch);
                    uv[0] = bflo(q.x); uv[1] = bfhi(q.x); uv[2] = bflo(q.y); uv[3] = bfhi(q.y); uv[4] = bflo(q.z); uv[5] = bfhi(q.z); uv[6] = bflo(q.w); uv[7] = bfhi(q.w); }
                else if (zero) {
#pragma unroll
                    for (int j = 0; j < 8; ++j) uv[j] = 0.f; }
                else { const int b = bb * 16 + (tl >> 2); const float* sp = st_conv + ((size_t)b * 3 + (3 + (tl & 3) - d)) * DR + cch;
                    const f32x4 s0 = *(const f32x4*)sp, s1 = *(const f32x4*)(sp + 4);
                    uv[0] = s0.x; uv[1] = s0.y; uv[2] = s0.z; uv[3] = s0.w; uv[4] = s1.x; uv[5] = s1.y; uv[6] = s1.z; uv[7] = s1.w; }
#pragma unroll
                for (int j = 0; j < 8; ++j) xc[j] += cw[3 - d][j] * uv[j];
            }
            u32x4 o; o.x = cvtpk(xc[0], xc[1]); o.y = cvtpk(xc[2], xc[3]); o.z = cvtpk(xc[4], xc[5]); o.w = cvtpk(xc[6], xc[7]);
            *(LAS u32x4*)(XC + tl * 136 + 8 * cg) = o;
        }
        __syncthreads();
        if (!SAMPLE && c + 1 < nch) LRU_LOADC(c + 1);
        bf16 gv[4][4];
#pragma unroll
        for (int mt = 0; mt < 4; ++mt)
#pragma unroll
            for (int e = 0; e < 4; ++e) gv[mt][e] = U[(size_t)(r0 + 16 * mt + 4 * fq + e) * NINP + G0 + ch];
        f32x4 acc[4][2];
#pragma unroll
        for (int mt = 0; mt < 4; ++mt) { acc[mt][0] = (f32x4){0.f, 0.f, 0.f, 0.f}; acc[mt][1] = (f32x4){0.f, 0.f, 0.f, 0.f};
#pragma unroll
            for (int ks = 0; ks < 4; ++ks) { const bf16x8 a = *(const LAS bf16x8*)(XC + (16 * mt + fr) * 136 + 32 * ks + 8 * fq);
                acc[mt][0] = MFMA16(a, Bw[0][ks], acc[mt][0]); acc[mt][1] = MFMA16(a, Bw[1][ks], acc[mt][1]); } }
#pragma unroll
        for (int mt = 0; mt < 4; ++mt) {
            float Pe[4], Qe[4];
#pragma unroll
            for (int e = 0; e < 4; ++e) { const int tl = 16 * mt + 4 * fq + e;
                const float r = fsigmoid(acc[mt][0][e] + ba), ii = fsigmoid(acc[mt][1][e] + bx), la = cl * r, a = fexp(la), x2 = 2.0f * la;
                const float om = (x2 > -0.1f) ? -x2 * (1.0f + x2 * (0.5f + x2 * (0.16666667f + x2 * 0.041666668f))) : 1.0f - a * a;
                const float xcv = bf2f(XC[tl * 136 + 16 * w + fr]), bv = __builtin_amdgcn_sqrtf(om) * ii * xcv;
                if (e == 0) { Pe[0] = a; Qe[0] = bv; } else { Pe[e] = a * Pe[e - 1]; Qe[e] = a * Qe[e - 1] + bv; } }
            float hin;
            if (!SAMPLE) {
                float Pi = Pe[3], Qi = Qe[3];
                { const float Pp = bperm(lane - 16, Pi), Qp = bperm(lane - 16, Qi); if (fq >= 1) { Qi = Pi * Qp + Qi; Pi = Pi * Pp; } }
                { const float Pp = bperm(lane - 32, Pi), Qp = bperm(lane - 32, Qi); if (fq >= 2) { Qi = Pi * Qp + Qi; Pi = Pi * Pp; } }
                float Px = bperm(lane - 16, Pi), Qx = bperm(lane - 16, Qi); if (fq == 0) { Px = 1.f; Qx = 0.f; }
                hin = Px * hc + Qx;
            } else { hin = st_lru[(size_t)(bb * 16 + 4 * mt + fq) * DR + ch]; }
            float hv[4];
#pragma unroll
            for (int e = 0; e < 4; ++e) hv[e] = Pe[e] * hin + Qe[e];
            if (!SAMPLE) hc = bperm(48 + fr, hv[3]); else if (!dry) o_lru_s[(size_t)(bb * 16 + 4 * mt + fq) * DR + ch] = hv[3];
#pragma unroll
            for (int e = 0; e < 4; ++e) if (!dry || hv[e] == 1.2345e30f) U[(size_t)(r0 + 16 * mt + 4 * fq + e) * NINP + G0 + ch] = f2bf1(hv[e] * bf2f(gv[mt][e]));
        }
        __syncthreads();
    }
#undef LRU_LOADC
    if (dry) return;
    if (!SAMPLE) {
        if (fq == 0) (OUTP + O_LRUP + (size_t)l * 8 * DR)[(size_t)bb * DR + ch] = hc;
        if (tid < 384) { const int j = tid >> 7, cc = tid & 127; (OUTP + O_CONVP + (size_t)l * 8 * 3 * DR)[((size_t)bb * 3 + j) * DR + n * 128 + cc] = bf2f(U[(size_t)(row0 + SEQ - 3 + j) * NINP + X0 + n * 128 + cc]); }
    } else {
        for (int idx = tid; idx < 6144; idx += NTHR) { const int s = idx / 384, rem = idx % 384, j = rem >> 7, cc = rem & 127;
            (OUTP + O_CONVS + (size_t)l * 128 * 3 * DR)[((size_t)(bb * 16 + s) * 3 + j) * DR + n * 128 + cc] = bf2f(U[(size_t)(row0 + 4 * s + 1 + j) * NINP + X0 + n * 128 + cc]); }
    }
}

__device__ __forceinline__ void lru_half_item(LAS unsigned char* lds, int l, int item) {
    int tid_ = threadIdx.x; asm volatile("" : "+v"(tid_));
    const int tid = tid_, lane = tid & 63, w = __builtin_amdgcn_readfirstlane(tid >> 6), fr = lane & 15, fq = lane >> 4, ct = w & 3, rh = w >> 2;
    const int hf = item & 1, n = (item >> 1) % 10, bb = (item >> 1) / 10;
    const int row0 = bb * SEQ; constexpr int nch = SEQ / 64;
    LAS bf16* XC = (LAS bf16*)lds; LAS float* HX = (LAS float*)(lds + 17408); LAS float* HC = (LAS float*)(lds + 17664);
    bf16* const U = (bf16*)(WSP + WS_U);
    const bf16* wg = (const bf16*)(WSP + WS_WG + l * SZ_WG) + (size_t)n * 256 * 128;
    bf16x8 Bw[2][4];
#pragma unroll
    for (int nt = 0; nt < 2; ++nt)
#pragma unroll
        for (int ks = 0; ks < 4; ++ks) Bw[nt][ks] = *(const bf16x8*)(wg + (size_t)(nt * 128 + hf * 64 + 16 * ct + fr) * 128 + 32 * ks + 8 * fq);
    const int chl = hf * 64 + 16 * ct + fr, ch = n * 128 + chl;
    const float ba = (inp(15) + (size_t)l * DR)[ch], bx = (inp(17) + (size_t)l * DR)[ch], lam = (inp(18) + (size_t)l * DR)[ch];
    const float cl = -8.0f * log1pf(expf(-lam));
    const int cg = tid & 15, tt = tid >> 4, cch = n * 128 + 8 * cg;
    float cw[4][8], cb[8];
#pragma unroll
    for (int i = 0; i < 4; ++i)
#pragma unroll
        for (int j = 0; j < 8; ++j) cw[i][j] = (inp(12) + (size_t)l * 4 * DR)[i * DR + cch + j];
#pragma unroll
    for (int j = 0; j < 8; ++j) cb[j] = (inp(13) + (size_t)l * DR)[cch + j];
    if (tid < 64) HC[tid] = 0.f;
    float hlast = 0.f;
    u32x4 uq[2][4];
#define LRU_LOADC(c_) do { _Pragma("unroll") for (int p = 0; p < 2; ++p) _Pragma("unroll") for (int d = 0; d < 4; ++d) { const int tl_ = tt + 32 * p; const u32x4 z4 = {0u, 0u, 0u, 0u}; uq[p][d] = z4; \
        if ((c_) * 64 + tl_ - d >= 0) uq[p][d] = *(const u32x4*)(U + (size_t)(row0 + (c_) * 64 + tl_ - d) * NINP + X0 + cch); } } while (0)
    LRU_LOADC(0);
    for (int c = 0; c < nch; ++c) {
        const int r0 = row0 + c * 64;
#pragma unroll
        for (int p = 0; p < 2; ++p) {
            const int tl = tt + 32 * p; float xc[8];
#pragma unroll
            for (int j = 0; j < 8; ++j) xc[j] = cb[j];
#pragma unroll
            for (int d = 0; d < 4; ++d) { const u32x4 q = uq[p][d];
                const float uv[8] = {bflo(q.x), bfhi(q.x), bflo(q.y), bfhi(q.y), bflo(q.z), bfhi(q.z), bflo(q.w), bfhi(q.w)};
#pragma unroll
                for (int j = 0; j < 8; ++j) xc[j] += cw[3 - d][j] * uv[j]; }
            u32x4 o; o.x = cvtpk(xc[0], xc[1]); o.y = cvtpk(xc[2], xc[3]); o.z = cvtpk(xc[4], xc[5]); o.w = cvtpk(xc[6], xc[7]);
            *(LAS u32x4*)(XC + tl * 136 + 8 * cg) = o;
        }
        __syncthreads();
        if (c + 1 < nch) LRU_LOADC(c + 1);
        bf16 gv[2][4];
#pragma unroll
        for (int mi = 0; mi < 2; ++mi)
#pragma unroll
            for (int e = 0; e < 4; ++e) gv[mi][e] = U[(size_t)(r0 + 32 * rh + 16 * mi + 4 * fq + e) * NINP + G0 + ch];
        f32x4 acc[2][2];
#pragma unroll
        for (int mi = 0; mi < 2; ++mi) { acc[mi][0] = (f32x4){0.f, 0.f, 0.f, 0.f}; acc[mi][1] = (f32x4){0.f, 0.f, 0.f, 0.f};
#pragma unroll
            for (int ks = 0; ks < 4; ++ks) { const bf16x8 a = *(const LAS bf16x8*)(XC + (32 * rh + 16 * mi + fr) * 136 + 32 * ks + 8 * fq);
                acc[mi][0] = MFMA16(a, Bw[0][ks], acc[mi][0]); acc[mi][1] = MFMA16(a, Bw[1][ks], acc[mi][1]); } }
        float Pe[2][4], Qe[2][4], Px[2], Qx[2], PT[2], QT[2];
#pragma unroll
        for (int mi = 0; mi < 2; ++mi) {
#pragma unroll
            for (int e = 0; e < 4; ++e) { const int tl = 32 * rh + 16 * mi + 4 * fq + e;
                const float r = fsigmoid(acc[mi][0][e] + ba), ii = fsigmoid(acc[mi][1][e] + bx), la = cl * r, a = fexp(la), x2 = 2.0f * la;
                const float om = (x2 > -0.1f) ? -x2 * (1.0f + x2 * (0.5f + x2 * (0.16666667f + x2 * 0.041666668f))) : 1.0f - a * a;
                const float xcv = bf2f(XC[tl * 136 + chl]), bv = __builtin_amdgcn_sqrtf(om) * ii * xcv;
                if (e == 0) { Pe[mi][0] = a; Qe[mi][0] = bv; } else { Pe[mi][e] = a * Pe[mi][e - 1]; Qe[mi][e] = a * Qe[mi][e - 1] + bv; } }
            float Pi = Pe[mi][3], Qi = Qe[mi][3];
            { const float Pp = bperm(lane - 16, Pi), Qp = bperm(lane - 16, Qi); if (fq >= 1) { Qi = Pi * Qp + Qi; Pi = Pi * Pp; } }
            { const float Pp = bperm(lane - 32, Pi), Qp = bperm(lane - 32, Qi); if (fq >= 2) { Qi = Pi * Qp + Qi; Pi = Pi * Pp; } }
            float px = bperm(lane - 16, Pi), qx = bperm(lane - 16, Qi); if (fq == 0) { px = 1.f; qx = 0.f; }
            Px[mi] = px; Qx[mi] = qx;
            PT[mi] = bperm(48 + fr, Pi); QT[mi] = bperm(48 + fr, Qi);
        }
        const float P32 = PT[1] * PT[0], Q32 = PT[1] * QT[0] + QT[1];
        float hs = 0.f;
        if (rh == 0) { hs = HC[16 * ct + fr]; if (fq == 0) HX[16 * ct + fr] = P32 * hs + Q32; }
        __syncthreads();
        if (rh == 1) { hs = HX[16 * ct + fr]; hlast = P32 * hs + Q32; if (fq == 0) HC[16 * ct + fr] = hlast; }
        const float hs1 = PT[0] * hs + QT[0];
#pragma unroll
        for (int mi = 0; mi < 2; ++mi) { const float hin = Px[mi] * (mi == 0 ? hs : hs1) + Qx[mi];
#pragma unroll
            for (int e = 0; e < 4; ++e) U[(size_t)(r0 + 32 * rh + 16 * mi + 4 * fq + e) * NINP + G0 + ch] = f2bf1((Pe[mi][e] * hin + Qe[mi][e]) * bf2f(gv[mi][e])); }
    }
#undef LRU_LOADC
    if (rh == 1 && fq == 0) (OUTP + O_LRUP + (size_t)l * 8 * DR)[(size_t)bb * DR + ch] = hlast;
    if (tid < 192) { const int j = tid >> 6, cc = hf * 64 + (tid & 63); (OUTP + O_CONVP + (size_t)l * 8 * 3 * DR)[((size_t)bb * 3 + j) * DR + n * 128 + cc] = bf2f(U[(size_t)(row0 + SEQ - 3 + j) * NINP + X0 + n * 128 + cc]); }
    __syncthreads();
}

__device__ __forceinline__ void gla_prep(LAS unsigned char* lds, int l, int item, int dry = 0) {
    int tid_ = threadIdx.x; asm volatile("" : "+v"(tid_));
    const int tid = tid_;
    LAS float* LRS = (LAS float*)lds; LAS float* TOT = (LAS float*)(lds + 4096);
    const int cidx = item >> 2, h = item & 3;
    const int r0 = cidx < 256 ? (cidx >> 5) * SEQ + (cidx & 31) * 64 : MP + 4 * (cidx - 256), nv = cidx < 256 ? 64 : 4;
    const int c = tid & 127, tg = tid >> 7;
    bf16* const U = (bf16*)(WSP + WS_U);
    float wa2c[16];
#pragma unroll
    for (int r = 0; r < 16; ++r) wa2c[r] = (inp(19) + (size_t)l * 16 * DKT)[r * DKT + h * 128 + c];
    const float gba = (inp(20) + (size_t)l * DKT)[h * 128 + c];
    if (tid < 128) { const int t = tid >> 1, hf = tid & 1; u32x4 a = {0u, 0u, 0u, 0u};
        if (t < nv) a = *(const u32x4*)(U + (size_t)(r0 + t) * NINP + LR0 + 8 * hf);
        const f32x4 l0 = {bflo(a.x), bfhi(a.x), bflo(a.y), bfhi(a.y)}, l1 = {bflo(a.z), bfhi(a.z), bflo(a.w), bfhi(a.w)};
        *(LAS f32x4*)(LRS + t * 16 + 8 * hf) = l0; *(LAS f32x4*)(LRS + t * 16 + 8 * hf + 4) = l1; }
    float qv[16], kv[16];
#pragma unroll
    for (int i = 0; i < 16; ++i) { const int t = 16 * tg + i; qv[i] = 0.f; kv[i] = 0.f;
        if (t < nv) { const bf16* up = U + (size_t)(r0 + t) * NINP + h * 128 + c; qv[i] = bf2f(up[Q0]); kv[i] = bf2f(up[K0]); } }
    __syncthreads();
    float bc[16]; float run = 0.f;
#pragma unroll
    for (int i = 0; i < 16; ++i) { const int t = 16 * tg + i; float g = 0.f;
        if (t < nv) { const LAS f32x4* lp = (const LAS f32x4*)(LRS + t * 16); const f32x4 a = lp[0], b = lp[1], cc = lp[2], d = lp[3];
            float pre = gba;
            pre += wa2c[0] * a.x + wa2c[1] * a.y + wa2c[2] * a.z + wa2c[3] * a.w + wa2c[4] * b.x + wa2c[5] * b.y + wa2c[6] * b.z + wa2c[7] * b.w;
            pre += wa2c[8] * cc.x + wa2c[9] * cc.y + wa2c[10] * cc.z + wa2c[11] * cc.w + wa2c[12] * d.x + wa2c[13] * d.y + wa2c[14] * d.z + wa2c[15] * d.w;
            g = (fminf(pre, 0.f) - __logf(1.0f + fexp(-fabsf(pre)))) * 0.0625f; }
        run += g; bc[i] = run; }
    TOT[tg * 128 + c] = run;
    __syncthreads();
    float off = 0.f, blast = 0.f;
#pragma unroll
    for (int j = 0; j < 4; ++j) { const float v = TOT[j * 128 + c]; blast += v; if (j < tg) off += v; }
    float kdv[16];
#pragma unroll
    for (int i = 0; i < 16; ++i) { const int t = 16 * tg + i; const float bci = bc[i] + off;
        if (t < nv && !dry) { bf16* up = U + (size_t)(r0 + t) * NINP + h * 128 + c; up[Q0] = f2bf1(qv[i] * fexp(bci)); up[K0] = f2bf1(kv[i] * fexp(-bci)); }
        kdv[i] = kv[i] * fexp(blast - bci); }
    { u32x4 k0, k1; k0.x = cvtpk(kdv[0], kdv[1]); k0.y = cvtpk(kdv[2], kdv[3]); k0.z = cvtpk(kdv[4], kdv[5]); k0.w = cvtpk(kdv[6], kdv[7]);
      k1.x = cvtpk(kdv[8], kdv[9]); k1.y = cvtpk(kdv[10], kdv[11]); k1.z = cvtpk(kdv[12], kdv[13]); k1.w = cvtpk(kdv[14], kdv[15]);
      bf16* kd = (bf16*)(WSP + WS_KD) + (size_t)item * 8192 + c * 64 + 16 * tg; if (!dry || k0.x == 0x12345u) { *(u32x4*)kd = k0; *(u32x4*)(kd + 8) = k1; } }
    if (tg == 0 && !dry) ((float*)(WSP + WS_EL))[(size_t)item * 128 + c] = fexp(blast);
    __syncthreads();
}

__device__ __forceinline__ void gla_rec(LAS unsigned char* lds, int l, int h, int vh, int row_base, int nch, int nv_last, int cidx0, const float* S0, float* ST, int dry = 0) {
    int tid_ = threadIdx.x; asm volatile("" : "+v"(tid_));
    const int tid = tid_, lane = tid & 63, w = __builtin_amdgcn_readfirstlane(tid >> 6), fr = lane & 15, fq = lane >> 4;
    LAS bf16* Qs = (LAS bf16*)lds; LAS bf16* Ks = (LAS bf16*)(lds + 17408); LAS bf16* KDT = (LAS bf16*)(lds + 34816); LAS bf16* VT = (LAS bf16*)(lds + 53248);
    LAS bf16* ATT = (LAS bf16*)(lds + 71680); LAS float* EL = (LAS float*)(lds + 80896);
    bf16* const U = (bf16*)(WSP + WS_U); const bf16* const KDg = (const bf16*)(WSP + WS_KD); const float* const ELg = (const float*)(WSP + WS_EL);
    f32x4 S[8];
#pragma unroll
    for (int kt = 0; kt < 8; ++kt)
#pragma unroll
        for (int e = 0; e < 4; ++e) S[kt][e] = S0 ? S0[(size_t)(16 * kt + 4 * fq + e) * 256 + 16 * w + fr] : 0.f;
    u32x4 pq[2][2], pk[2][2], pd[2][2], pv[2][2]; f32x4 pe[2] = {{0.f, 0.f, 0.f, 0.f}, {0.f, 0.f, 0.f, 0.f}};
#define GLA_LOADC(ci_, u_) do { const int r0_ = row_base + (ci_) * 64, nv_ = ((ci_) == nch - 1) ? nv_last : 64; const size_t it_ = (size_t)(cidx0 + (ci_)) * 4 + h; \
        _Pragma("unroll") for (int p = 0; p < 2; ++p) { const int idx = tid + 512 * p, t = idx >> 4, seg = idx & 15, tv = idx & 63, sv = idx >> 6; \
            const u32x4 z4 = {0u, 0u, 0u, 0u}; pq[u_][p] = z4; pk[u_][p] = z4; pv[u_][p] = z4; \
            if (t < nv_) { const bf16* up = U + (size_t)(r0_ + t) * NINP + h * 128 + 8 * seg; pq[u_][p] = *(const u32x4*)(up + Q0); pk[u_][p] = *(const u32x4*)(up + K0); } \
            pd[u_][p] = *(const u32x4*)(KDg + it_ * 8192 + idx * 8); \
            if (tv < nv_) pv[u_][p] = *(const u32x4*)(U + (size_t)(r0_ + tv) * NINP + V0 + h * 256 + vh * 128 + 8 * sv); } \
        if (tid < 32) pe[u_] = *(const f32x4*)(ELg + it_ * 128 + 4 * tid); } while (0)
    GLA_LOADC(0, 0);
    if (nch > 1) GLA_LOADC(1, 1);
    for (int c2 = 0; c2 < nch; c2 += 2) {
#pragma unroll
      for (int u = 0; u < 2; ++u) { const int ci = c2 + u; if (ci < nch) {
        const int r0 = row_base + ci * 64, nv = (ci == nch - 1) ? nv_last : 64;
#pragma unroll
        for (int p = 0; p < 2; ++p) { const int idx = tid + 512 * p, t = idx >> 4, seg = idx & 15, tv = idx & 63, sv = idx >> 6;
            *(LAS u32x4*)(Qs + t * 136 + 8 * seg) = pq[u][p]; *(LAS u32x4*)(Ks + t * 136 + 8 * seg) = pk[u][p];
            *(LAS u32x4*)(KDT + (idx >> 3) * 72 + (idx & 7) * 8) = pd[u][p];
            LAS bf16* vp = VT + (8 * sv) * 72 + tv; const u32x4 vv = pv[u][p];
            vp[0] = (bf16)(vv.x & 0xffffu); vp[72] = (bf16)(vv.x >> 16); vp[144] = (bf16)(vv.y & 0xffffu); vp[216] = (bf16)(vv.y >> 16);
            vp[288] = (bf16)(vv.z & 0xffffu); vp[360] = (bf16)(vv.z >> 16); vp[432] = (bf16)(vv.w & 0xffffu); vp[504] = (bf16)(vv.w >> 16); }
        if (tid < 32) *(LAS f32x4*)(EL + 4 * tid) = pe[u];
        __syncthreads();
        if (ci + 2 < nch) GLA_LOADC(ci + 2, u);
        { const int it = w >> 1;
#pragma unroll
          for (int jj = 0; jj < 2; ++jj) { const int jt = (w & 1) * 2 + jj; f32x4 a4 = {0.f, 0.f, 0.f, 0.f};
#pragma unroll
            for (int ks = 0; ks < 4; ++ks) { const bf16x8 a = *(const LAS bf16x8*)(Ks + (16 * jt + fr) * 136 + 32 * ks + 8 * fq), b = *(const LAS bf16x8*)(Qs + (16 * it + fr) * 136 + 32 * ks + 8 * fq);
                a4 = MFMA16(a, b, a4); }
            const int i = 16 * it + fr;
#pragma unroll
            for (int e = 0; e < 4; ++e) if (16 * jt + 4 * fq + e > i) a4[e] = 0.f;
            u32x2 o2; o2.x = cvtpk(a4[0], a4[1]); o2.y = cvtpk(a4[2], a4[3]);
            *(LAS u32x2*)(ATT + i * 72 + 16 * jt + 4 * fq) = o2; } }
        __syncthreads();
        bf16x8 vb[2], Sp[4];
#pragma unroll
        for (int js = 0; js < 2; ++js) vb[js] = *(const LAS bf16x8*)(VT + (16 * w + fr) * 72 + 32 * js + 8 * fq);
#pragma unroll
        for (int ks = 0; ks < 4; ++ks) { u32x4 pk4; const f32x4 s0 = S[2 * ks], s1 = S[2 * ks + 1];
            pk4.x = cvtpk(s0[0], s0[1]); pk4.y = cvtpk(s0[2], s0[3]); pk4.z = cvtpk(s1[0], s1[1]); pk4.w = cvtpk(s1[2], s1[3]); Sp[ks] = __builtin_bit_cast(bf16x8, pk4); }
        f32x4 o[4];
#pragma unroll
        for (int it = 0; it < 4; ++it) { f32x4 oo = {0.f, 0.f, 0.f, 0.f};
#pragma unroll
            for (int js = 0; js < 2; ++js) if (2 * js <= it) { const bf16x8 aa = *(const LAS bf16x8*)(ATT + (16 * it + fr) * 72 + 32 * js + 8 * fq); oo = MFMA16(aa, vb[js], oo); }
#pragma unroll
            for (int ks = 0; ks < 4; ++ks) { const u32x2 lo = *(const LAS u32x2*)(Qs + (16 * it + fr) * 136 + 32 * ks + 4 * fq), hi = *(const LAS u32x2*)(Qs + (16 * it + fr) * 136 + 32 * ks + 16 + 4 * fq);
                u32x4 q4; q4.x = lo.x; q4.y = lo.y; q4.z = hi.x; q4.w = hi.y; oo = MFMA16(__builtin_bit_cast(bf16x8, q4), Sp[ks], oo); }
            o[it] = oo; }
#pragma unroll
        for (int kt = 0; kt < 8; ++kt) { const f32x4 el = *(const LAS f32x4*)(EL + 16 * kt + 4 * fq); S[kt] *= el; }
#pragma unroll
        for (int js = 0; js < 2; ++js)
#pragma unroll
            for (int kt = 0; kt < 8; ++kt) { const bf16x8 a = *(const LAS bf16x8*)(KDT + (16 * kt + fr) * 72 + 32 * js + 8 * fq); S[kt] = MFMA16(a, vb[js], S[kt]); }
#pragma unroll
        for (int it = 0; it < 4; ++it)
#pragma unroll
            for (int e = 0; e < 4; ++e) { const int row = 16 * it + 4 * fq + e;
                if (row < nv && (!dry || o[it][e] == 1.2345e30f)) U[(size_t)(r0 + row) * NINP + V0 + h * 256 + vh * 128 + 16 * w + fr] = f2bf1(o[it][e]); }
        __syncthreads();
      } }
    }
#undef GLA_LOADC
#pragma unroll
    for (int kt = 0; kt < 8; ++kt)
#pragma unroll
        for (int e = 0; e < 4; ++e) if (!dry || S[kt][e] == 1.2345e30f) ST[(size_t)(16 * kt + 4 * fq + e) * 256 + 16 * w + fr] = S[kt][e];
}
__device__ __forceinline__ void gla_fin_row(bf16* U, const float* gnorm, int row, int lane, int dry = 0) {
    const u32x4* op = (const u32x4*)(U + (size_t)row * NINP + V0 + 16 * lane); u32x4* rp = (u32x4*)(U + (size_t)row * NINP + R0 + 16 * lane);
    const u32x4 o0 = op[0], o1 = op[1], r0 = rp[0], r1 = rp[1];
    float ov[16] = {bflo(o0.x), bfhi(o0.x), bflo(o0.y), bfhi(o0.y), bflo(o0.z), bfhi(o0.z), bflo(o0.w), bfhi(o0.w), bflo(o1.x), bfhi(o1.x), bflo(o1.y), bfhi(o1.y), bflo(o1.z), bfhi(o1.z), bflo(o1.w), bfhi(o1.w)};
    const float rv[16] = {bflo(r0.x), bfhi(r0.x), bflo(r0.y), bfhi(r0.y), bflo(r0.z), bfhi(r0.z), bflo(r0.w), bfhi(r0.w), bflo(r1.x), bfhi(r1.x), bflo(r1.y), bfhi(r1.y), bflo(r1.z), bfhi(r1.z), bflo(r1.w), bfhi(r1.w)};
    float ss = 0.f;
#pragma unroll
    for (int i = 0; i < 16; ++i) ss += ov[i] * ov[i];
    ss += bperm(lane ^ 1, ss); ss += bperm(lane ^ 2, ss); ss += bperm(lane ^ 4, ss); ss += bperm(lane ^ 8, ss);
    const float rstd = 1.0f / sqrtf(ss * (1.0f / 256.0f) + EPS);
    const f32x4* gp = (const f32x4*)(gnorm + 16 * lane);
#pragma unroll
    for (int j = 0; j < 4; ++j) { const f32x4 g = gp[j];
#pragma unroll
        for (int e = 0; e < 4; ++e) ov[4 * j + e] = ov[4 * j + e] * rstd * g[e] * rv[4 * j + e]; }
    u32x4 w0, w1; w0.x = cvtpk(ov[0], ov[1]); w0.y = cvtpk(ov[2], ov[3]); w0.z = cvtpk(ov[4], ov[5]); w0.w = cvtpk(ov[6], ov[7]);
    w1.x = cvtpk(ov[8], ov[9]); w1.y = cvtpk(ov[10], ov[11]); w1.z = cvtpk(ov[12], ov[13]); w1.w = cvtpk(ov[14], ov[15]);
    if (!dry || w0.x == 0x12345u) { rp[0] = w0; rp[1] = w1; }
}

__device__ __forceinline__ void small_gemm(LAS unsigned char* lds, const bf16* A, int lda, const bf16* Bt, int ldb, int K, f32x4 (&acc)[2]) {
    int tid_ = threadIdx.x; asm volatile("" : "+v"(tid_));
    const int tid = tid_, lane = tid & 63, w = __builtin_amdgcn_readfirstlane(tid >> 6), fr = lane & 15, fq = lane >> 4, wr = w & 3, wc = w >> 2;
    const int r = tid >> 3, seg = tid & 7, ns = K >> 7;
    const bf16* ap = A + (size_t)r * lda + 8 * seg; const bf16* bp = Bt + (size_t)r * ldb + 8 * seg;
    u32x4 pa[3][2], pb[3][2];
#pragma unroll
    for (int u = 0; u < 3; ++u) if (u < ns) {
#pragma unroll
        for (int hh = 0; hh < 2; ++hh) { pa[u][hh] = *(const u32x4*)(ap + u * 128 + 64 * hh); pb[u][hh] = *(const u32x4*)(bp + u * 128 + 64 * hh); } }
    for (int s0 = 0; s0 < ns; s0 += 3) {
#pragma unroll
        for (int u = 0; u < 3; ++u) { const int st = s0 + u; if (st < ns) {
            LAS bf16* As = (LAS bf16*)(lds + u * 34816); LAS bf16* Bs = (LAS bf16*)(lds + u * 34816 + 17408);
#pragma unroll
            for (int hh = 0; hh < 2; ++hh) { *(LAS u32x4*)(As + r * 136 + 64 * hh + 8 * seg) = pa[u][hh]; *(LAS u32x4*)(Bs + r * 136 + 64 * hh + 8 * seg) = pb[u][hh]; }
            __syncthreads();
            if (st + 3 < ns) {
#pragma unroll
                for (int hh = 0; hh < 2; ++hh) { pa[u][hh] = *(const u32x4*)(ap + (st + 3) * 128 + 64 * hh); pb[u][hh] = *(const u32x4*)(bp + (st + 3) * 128 + 64 * hh); } }
#pragma unroll
            for (int kk = 0; kk < 4; ++kk) { const bf16x8 a = *(const LAS bf16x8*)(As + (16 * wr + fr) * 136 + 32 * kk + 8 * fq);
#pragma unroll
                for (int n = 0; n < 2; ++n) { const bf16x8 b = *(const LAS bf16x8*)(Bs + (32 * wc + 16 * n + fr) * 136 + 32 * kk + 8 * fq); acc[n] = MFMA16(a, b, acc[n]); } }
        } }
    }
    __syncthreads();
}

#define XB_TMO      128
#define XB_XCNT(j)  (256  + 64 * (j))
#define XB_XSUB(j)  (1280 + 64 * (j))
#define XB_XGEN(j)  (2304 + 64 * (j))
#define XB_TOP      3328
#define XB_TOPGEN   3392
#define XCD_BAR_WORDS 3456
#define XB_SPIN_CAP (1u << 18)

__device__ __forceinline__ unsigned xb_ld(unsigned* p)              { return __hip_atomic_load(p, __ATOMIC_RELAXED, __HIP_MEMORY_SCOPE_AGENT); }
__device__ __forceinline__ unsigned xb_add(unsigned* p, unsigned v) { return __hip_atomic_fetch_add(p, v, __ATOMIC_RELAXED, __HIP_MEMORY_SCOPE_AGENT); }
__device__ __forceinline__ unsigned xb_xcc_id() { return (unsigned)__builtin_amdgcn_s_getreg((3 << 11) | 20) & 0xFu; }
#define XB_SPIN(cond, bar) do { unsigned _sp = 0; while (cond) { __builtin_amdgcn_s_sleep(1); \
    if ((++_sp & 255u) == 0u) { if (xb_ld(&(bar)[XB_TMO])) break; if (_sp > XB_SPIN_CAP) { atomicAdd(&(bar)[XB_TMO], 1u); break; } } } } while (0)

struct XcdBarrier {
    unsigned* bar; unsigned x;
    volatile LAS unsigned* st;
};

__device__ __forceinline__ XcdBarrier xcd_barrier_post(unsigned* bar, volatile LAS unsigned* st) {
    XcdBarrier b; b.bar = bar; b.x = xb_xcc_id(); b.st = st;
    if (threadIdx.x == 0) (void)xb_add(&bar[XB_XCNT(b.x)], 1u);
    return b;
}
__device__ __forceinline__ void xcd_barrier_complete(unsigned* bar, unsigned x, unsigned& nloc, unsigned& nx) {
    const unsigned G = gridDim.x * gridDim.y * gridDim.z;
    unsigned sum, cnt, mine, sp = 0u;
    for (;;) {
        sum = 0u; cnt = 0u; mine = 0u;
#pragma unroll
        for (unsigned j = 0; j < 16; ++j) { const unsigned c = xb_ld(&bar[XB_XCNT(j)]); sum += c; cnt += (c > 0u) ? 1u : 0u; mine = (j == x) ? c : mine; }
        if (sum == G) break;
        __builtin_amdgcn_s_sleep(1);
        if ((++sp & 255u) == 0u) { if (xb_ld(&bar[XB_TMO])) break; if (sp > XB_SPIN_CAP) { atomicAdd(&bar[XB_TMO], 1u); break; } }
    }
    nloc = mine > 0u ? mine : 1u; nx = cnt > 0u ? cnt : 1u;
}

__device__ __forceinline__ void xcd_barrier(const XcdBarrier& b) {
    asm volatile("s_waitcnt vmcnt(0)" ::: "memory");
    __syncthreads();
    if (threadIdx.x == 0) {
        unsigned* bar = b.bar;
        __builtin_amdgcn_s_waitcnt(0);
        unsigned nloc = b.st[0], nx = b.st[1];
        if (nloc == 0u) { xcd_barrier_complete(bar, b.x, nloc, nx); b.st[0] = nloc; b.st[1] = nx; }
        const unsigned old = xb_add(&bar[XB_XSUB(b.x)], 1u);
        const unsigned gen = old / nloc;
        if (old + 1u == (gen + 1u) * nloc) {
            __builtin_amdgcn_fence(__ATOMIC_RELEASE, "agent");
            asm volatile("s_waitcnt vmcnt(0)" ::: "memory");
            const unsigned og = xb_add(&bar[XB_TOP], 1u);
            const unsigned tg = og / nx;
            if (og + 1u == (tg + 1u) * nx) xb_add(&bar[XB_TOPGEN], 1u);
            else XB_SPIN(xb_ld(&bar[XB_TOPGEN]) == tg, bar);
            __builtin_amdgcn_fence(__ATOMIC_ACQUIRE, "agent");
            xb_add(&bar[XB_XGEN(b.x)], 1u);
            asm volatile("s_waitcnt vmcnt(0)" ::: "memory");
        } else {
            XB_SPIN(xb_ld(&bar[XB_XGEN(b.x)]) == gen, bar);
            __builtin_amdgcn_fence(__ATOMIC_ACQUIRE, "agent");
            asm volatile("s_waitcnt vmcnt(0)" ::: "memory");
        }
    }
    __syncthreads();
}

constexpr int N_PHASES = 23;
__global__ void __launch_bounds__(NTHR, 2) fwd(Args args) {
    extern __shared__ __attribute__((aligned(16))) unsigned char lds_raw[];
    LAS unsigned char* lds = (LAS unsigned char*)lds_raw;
    cg::grid_group grid = cg::this_grid();
    { volatile LAS unsigned* st0 = (volatile LAS unsigned*)(lds + 131072 + 64); if (threadIdx.x < 2) st0[threadIdx.x] = 0u; __syncthreads(); }
    const XcdBarrier xbar = xcd_barrier_post((unsigned*)(args.ws + WS_BAR), (volatile LAS unsigned*)(lds + 131072 + 64));
    const int G = gridDim.x, bx = blockIdx.x;
#define PHASE_LOCALS int t_ = threadIdx.x; asm volatile("" : "+v"(t_)); const int tid = t_, lane = tid & 63, wave = __builtin_amdgcn_readfirstlane(tid >> 6), gw = bx * NWAVES + wave, NGW = G * NWAVES; (void)tid; (void)lane; (void)gw; (void)NGW;
#define ws WSP
#define X (OUTP + O_Y)
#define HN ((bf16*)(WSP + WS_HN))
#define U ((bf16*)(WSP + WS_U))
#define FF ((bf16*)(WSP + WS_U))
#define PB ((float*)(WSP + WS_P))
#define MOD ((float*)(WSP + WS_MOD))
#define CS ((bf16*)(WSP + WS_CS))
    const int lo = args.ph_lo, hi = args.ph_hi;
#ifndef PROBE_P0
#define PROBE_P0 0
#endif
#ifndef PROBE_SYNC
#define PROBE_SYNC 0
#endif
#ifndef PROBE_RES
#define PROBE_RES 0
#endif
#ifndef PROBE_PREP
#define PROBE_PREP 0
#endif
#ifndef PROBE_REC
#define PROBE_REC 0
#endif
#ifndef PROBE_FIN
#define PROBE_FIN 0
#endif
#ifndef REP
#define REP 1
#endif
#ifndef SCM
#define SCM 15
#endif
#ifndef DBG_MASK
#define DBG_MASK 0x7ffff
#endif
#define PHON(k) ((DBG_MASK >> ((k) < 10 ? (k) : (k) - 8)) & 1)
#define IN(k) (lo <= (k) && (k) < hi)
#define SEAM(k) do { if (lo <= (k) && (k) + 1 < hi) { if ((k) == 0) grid.sync(); else xcd_barrier(xbar); } } while (0)

    for (int rp0_ = 0; rp0_ < 1 + (PROBE_P0 ? (hi > 22) : 0); ++rp0_) if (IN(0)) {
        PHASE_LOCALS
        LAS float* scr = (LAS float*)(lds + wave * 16384);
        constexpr int I_ADA = 16 * 192;
        for (int it = gw; it < 2 * I_ADA; it += NGW) { const int l = it / I_ADA, r = it % I_ADA;
            transpose_item(inp(9) + (size_t)l * D * NMOD, D, NMOD, (bf16*)(ws + WS_ADA + l * SZ_ADA), D, 0, 192, 0, scr, r, lane); }
        bf16* WG = (bf16*)(ws + WS_WG);
        for (int idx = bx * NTHR + tid; idx < 2 * 10 * 256 * 128; idx += G * NTHR) {
            const int l = idx / 327680, r = idx % 327680, n = r >> 15, vv = (r >> 7) & 255, wi = r & 127;
            const float* src = (vv < 128 ? inp(14) : inp(16)) + ((size_t)(l * 10 + n) * 128 + wi) * 128 + (vv & 127);
            WG[idx] = f2bf1(*src);
        }
        for (int idx = bx * NTHR + tid; idx < 256 * D; idx += G * NTHR) {
            const int row = idx >> 10, col = idx & 1023; float v = 0.f;
            if (row < 8) v = inp(2)[row * D + col]; else if (row < NB) v = inp(3)[(row - 8) * D + col];
            CS[idx] = f2bf1(v * fsigmoid(v));
        }
    }
    SEAM(0);
    for (int rp1_ = 0; rp1_ < 1 + (PROBE_P0 ? (hi > 22) : 0); ++rp1_) if (IN(1)) {
        if (bx < 48) { const int l = bx / 24;
            pg8::Gemm g{CS, (const bf16*)(ws + WS_ADA + l * SZ_ADA), 256, NMOD, D, D, D}; pg8::StaticOrder S; S.init(256, NMOD, G, bx % 24);
            pg8::EpiMod E{MOD + (size_t)l * NB * NMOD, inp(10) + (size_t)l * NMOD};
            pg8::gemm_phase<pg8::EpiMod, pg8::StaticOrder, true, true>(lds, g, S, E);
        } else {
            PHASE_LOCALS
            LAS float* scr = (LAS float*)(lds + wave * 16384);
            const int gw2 = (bx - 48) * NWAVES + wave, NGW2 = (G - 48) * NWAVES;
            constexpr int I_WIN = 16 * 248, I_PA = 20 * 32, I_PB = 16 * 32, I_WO = 16 * 32, I_W1 = 16 * 176, I_W2 = 44 * 32;
            constexpr int I_L = I_WIN + I_PA + I_PB + I_WO + I_W1 + I_W2;
            for (int it = gw2; it < 2 * I_L; it += NGW2) {
                const int l = it / I_L; int r = it % I_L;
                if (r < I_WIN) { transpose_item(inp(11) + (size_t)l * D * 7696, D, 7696, (bf16*)(ws + WS_WIN + l * SZ_WIN), D, 0, 248, 1, scr, r, lane); continue; } r -= I_WIN;
                if (r < I_PA) { transpose_item(inp(22) + (size_t)l * DR * D, DR, D, (bf16*)(ws + WS_WPJ + l * SZ_WPJ), DR + DVT, 0, 32, 0, scr, r, lane); continue; } r -= I_PA;
                if (r < I_PB) { transpose_item(inp(23) + (size_t)l * DVT * D, DVT, D, (bf16*)(ws + WS_WPJ + l * SZ_WPJ), DR + DVT, DR, 32, 0, scr, r, lane); continue; } r -= I_PB;
                if (r < I_WO) { transpose_item(inp(24) + (size_t)l * D * D, D, D, (bf16*)(ws + WS_WOUT + l * SZ_WOUT), D, 0, 32, 0, scr, r, lane); continue; } r -= I_WO;
                if (r < I_W1) { transpose_item(inp(25) + (size_t)l * D * 2 * DFF, D, 2 * DFF, (bf16*)(ws + WS_W1 + l * SZ_W1), D, 0, 176, 2, scr, r, lane); continue; } r -= I_W1;
                transpose_item(inp(26) + (size_t)l * DFF * D, DFF, D, (bf16*)(ws + WS_W2 + l * SZ_W2), DFF, 0, 32, 0, scr, r, lane);
            }
        }
    }
    SEAM(1);
    for (int l = 0; l < 2; ++l) {
        const int pb = 2 + 10 * l;
#define modl (MOD + (size_t)l * NB * NMOD)
        if (IN(pb)) {
            PHASE_LOCALS
            for (int row = gw; row < M; row += NGW) {
                const float* xr = l == 0 ? (row < MP ? inp(0) + (size_t)row * D : inp(1) + (size_t)(row - MP) * D) : X + (size_t)row * D;
                const float* mb = modl + (size_t)row_batch(row) * NMOD;
                norm_row(xr, inp(7) + l * D, mb + 1024, mb, HN + (size_t)row * D, nullptr, lane);
            }
        }
        SEAM(pb);
        if (IN(pb + 1)) {
            pg8::Gemm g{HN, (const bf16*)(ws + WS_WIN + l * SZ_WIN), M, NINP, D, D, D}; pg8::StaticOrder S; S.init(M, NINP, G, bx);
            pg8::EpiWin E{U};
            pg8::gemm_phase<pg8::EpiWin, pg8::StaticOrder, true, true>(lds, g, S, E);
        }
        SEAM(pb + 1);
        if (IN(pb + 2)) {
            const int nrep = 1 + (PROBE_PREP ? (hi > 22) : 0);
            for (int rp_ = 0; rp_ < nrep; ++rp_) { const int dry = rp_ < nrep - 1;
            for (int item = bx; item < 1536; item += G) gla_prep(lds, l, item, dry); }
        }
        SEAM(pb + 2);
        if (IN(pb + 3)) {
            ScanP P; P.l = l;
            float* const o_gla_p = OUTP + O_GLAP + (size_t)l * 8 * 4 * 32768; float* const o_gla_s = OUTP + O_GLAS + (size_t)l * 128 * 4 * 32768;
            if (bx < 64) { const int nrep = 1 + (PROBE_REC == 2 ? (hi > 22) : 0); for (int rp_ = 0; rp_ < nrep; ++rp_) { const int b = bx >> 3, h = (bx >> 1) & 3, vh = bx & 1; gla_rec(lds, l, h, vh, b * SEQ, SEQ / 64, 64, b * 32, nullptr, o_gla_p + (size_t)(b * 4 + h) * 32768 + vh * 128, rp_ < nrep - 1); } }
            else if (bx < 224) { lru_half_item(lds, l, bx - 64); }
            { unsigned* qc = (unsigned*)(WSP + WS_BAR) + 8192 + 64 * l; volatile LAS unsigned* qs = (volatile LAS unsigned*)(lds + 131072 + 128);
              for (;;) {
                __syncthreads();
                if (threadIdx.x == 0) *qs = atomicAdd(qc, 1u);
                __syncthreads();
                const int j = (int)*qs;
                if (j >= 1104) break;
                if (j < 80) lru_item<true>(lds, P, j);
                else { const int jj = j - 80, b = jj >> 3, h = (jj >> 1) & 3, vh = jj & 1;
                    gla_rec(lds, l, h, vh, MP + b * 4, 1, 4, 256 + b, inp(6) + (size_t)l * 128 * 4 * 32768 + (size_t)(b * 4 + h) * 32768 + vh * 128, o_gla_s + (size_t)(b * 4 + h) * 32768 + vh * 128); }
              } }
        }
        SEAM(pb + 3);
        if (IN(pb + 4)) {
            PHASE_LOCALS
            const int nrep = 1 + (PROBE_FIN ? (hi > 22) : 0);
            for (int rp_ = 0; rp_ < nrep; ++rp_) { const int dry = rp_ < nrep - 1;
            for (int row = gw; row < M; row += NGW) gla_fin_row(U, inp(21) + (size_t)l * DVT, row, lane, dry); }
        }
        SEAM(pb + 4);
        if (IN(pb + 5)) {
            const bf16* wpj = (const bf16*)(ws + WS_WPJ + l * SZ_WPJ);
            { pg8::Gemm g{U + G0, wpj, MP, D, DR, NINP, DR + DVT}; pg8::StaticOrder S; S.init(MP, D, G, bx); pg8::EpiProj E{U, PB, HN, 0};
              pg8::gemm_phase<pg8::EpiProj, pg8::StaticOrder, true, true>(lds, g, S, E); }
            { pg8::Gemm g{U + R0, wpj + DR, MP, D, DVT, NINP, DR + DVT}; pg8::StaticOrder S; S.init(MP, D, G, bx); pg8::EpiProj E{U, PB, HN, 1};
              pg8::gemm_phase<pg8::EpiProj, pg8::StaticOrder, true, true>(lds, g, S, E); }
            if (bx >= G - 128) {
                const int j = G - 1 - bx, rt = j >> 4, ct = j & 15; const int rowt = MP + 64 * rt, colt = 64 * ct;
                f32x4 aa[2] = {{0.f, 0.f, 0.f, 0.f}, {0.f, 0.f, 0.f, 0.f}}, ab[2] = {{0.f, 0.f, 0.f, 0.f}, {0.f, 0.f, 0.f, 0.f}};
                small_gemm(lds, U + (size_t)rowt * NINP + G0, NINP, wpj + (size_t)colt * (DR + DVT), DR + DVT, DR, aa);
                small_gemm(lds, U + (size_t)rowt * NINP + R0, NINP, wpj + (size_t)colt * (DR + DVT) + DR, DR + DVT, DVT, ab);
                int t_ = threadIdx.x; asm volatile("" : "+v"(t_)); const int lane = t_ & 63, w = t_ >> 6, fr = lane & 15, fq = lane >> 4;
#pragma unroll
                for (int n = 0; n < 2; ++n)
#pragma unroll
                    for (int e = 0; e < 4; ++e) { const int row = rowt + 16 * (w & 3) + 4 * fq + e, col = colt + 32 * (w >> 2) + 16 * n + fr; const bf16* up = U + (size_t)row * NINP + col;
                        HN[(size_t)row * D + col] = f2bf1(bf2f(up[GA0]) * aa[n][e] + bf2f(up[GB0]) * ab[n][e]); }
            }
        }
        SEAM(pb + 5);
        if (IN(pb + 6)) {
            pg8::Gemm g{HN, (const bf16*)(ws + WS_WOUT + l * SZ_WOUT), MP, D, D, D, D}; pg8::StaticOrder S; S.init(MP, D, G, bx);
            const int nrep = 1 + (PROBE_RES ? (hi > 22) : 0);
            for (int rp_ = 0; rp_ < nrep; ++rp_) {
            pg8::EpiRes E{l == 0 ? inp(0) : X, l == 0 ? inp(1) : X + (size_t)MP * D, X, modl + 2048, rp_ < nrep - 1};
            pg8::gemm_phase<pg8::EpiRes, pg8::StaticOrder, true, true>(lds, g, S, E); }
            if (bx >= G - 128) { const int j = G - 1 - bx, rt = j >> 4, ct = j & 15; const int rowt = MP + 64 * rt, colt = 64 * ct;
                f32x4 aa[2] = {{0.f, 0.f, 0.f, 0.f}, {0.f, 0.f, 0.f, 0.f}};
                small_gemm(lds, HN + (size_t)rowt * D, D, (const bf16*)(ws + WS_WOUT + l * SZ_WOUT) + (size_t)colt * D, D, D, aa);
                int t_ = threadIdx.x; asm volatile("" : "+v"(t_)); const int lane = t_ & 63, w = t_ >> 6, fr = lane & 15, fq = lane >> 4;
                const float* bs = l == 0 ? inp(1) : X + (size_t)MP * D;
#pragma unroll
                for (int n = 0; n < 2; ++n)
#pragma unroll
                    for (int e = 0; e < 4; ++e) { const int row = rowt + 16 * (w & 3) + 4 * fq + e, col = colt + 32 * (w >> 2) + 16 * n + fr;
                        X[(size_t)row * D + col] = bs[(size_t)(row - MP) * D + col] + (modl + 2048)[(size_t)row_batch(row) * NMOD + col] * aa[n][e]; }
            }
        }
        SEAM(pb + 6);
        if (IN(pb + 7)) {
            PHASE_LOCALS
            for (int row = gw; row < M; row += NGW) {
                const float* mb = modl + (size_t)row_batch(row) * NMOD;
                norm_row(X + (size_t)row * D, inp(8) + l * D, mb + 4096, mb + 3072, HN + (size_t)row * D, nullptr, lane);
            }
        }
        SEAM(pb + 7);
        if (IN(pb + 8)) {
            pg8::Gemm g{HN, (const bf16*)(ws + WS_W1 + l * SZ_W1), M, 2 * DFF, D, D, D}; pg8::StaticOrder S; S.init(M, 2 * DFF, G, bx);
            pg8::EpiSwiglu E{FF};
            pg8::gemm_phase<pg8::EpiSwiglu, pg8::StaticOrder, true, true>(lds, g, S, E);
        }
        SEAM(pb + 8);
        if (IN(pb + 9)) {
            pg8::Gemm g{FF, (const bf16*)(ws + WS_W2 + l * SZ_W2), MP, D, DFF, DFF, DFF}; pg8::StaticOrder S; S.init(MP, D, G, bx);
            const int nrep = 1 + (PROBE_RES ? (hi > 22) : 0);
            for (int rp_ = 0; rp_ < nrep; ++rp_) {
            pg8::EpiRes E{X, X + (size_t)MP * D, X, modl + 5120, rp_ < nrep - 1};
            pg8::gemm_phase<pg8::EpiRes, pg8::StaticOrder, true, true>(lds, g, S, E); }
            if (bx >= G - 128) { const int j = G - 1 - bx, rt = j >> 4, ct = j & 15; const int rowt = MP + 64 * rt, colt = 64 * ct;
                f32x4 aa[2] = {{0.f, 0.f, 0.f, 0.f}, {0.f, 0.f, 0.f, 0.f}};
                small_gemm(lds, FF + (size_t)rowt * DFF, DFF, (const bf16*)(ws + WS_W2 + l * SZ_W2) + (size_t)colt * DFF, DFF, DFF, aa);
                int t_ = threadIdx.x; asm volatile("" : "+v"(t_)); const int lane = t_ & 63, w = t_ >> 6, fr = lane & 15, fq = lane >> 4;
#pragma unroll
                for (int n = 0; n < 2; ++n)
#pragma unroll
                    for (int e = 0; e < 4; ++e) { const int row = rowt + 16 * (w & 3) + 4 * fq + e, col = colt + 32 * (w >> 2) + 16 * n + fr;
                        float* xp_ = X + (size_t)row * D + col; *xp_ = *xp_ + (modl + 5120)[(size_t)row_batch(row) * NMOD + col] * aa[n][e]; }
            }
        }
        SEAM(pb + 9);
    }
    if (IN(22)) {
        PHASE_LOCALS
        for (int row = gw; row < M; row += NGW) norm_row(X + (size_t)row * D, inp(27), nullptr, nullptr, nullptr, X + (size_t)row * D, lane);
    }
#undef IN
#undef SEAM
#undef ws
#undef X
#undef HN
#undef U
#undef FF
#undef PB
#undef MOD
#undef CS
#undef modl
}

#ifndef MK_SPLIT
#define MK_SPLIT 0
#endif
extern "C" void kernel_launch(void* const* d_in, const int* in_sizes, int n_in, void* d_out, int out_size, void* d_ws, size_t ws_size, hipStream_t stream) {
    static int grid = 0;
    if (grid == 0) {
        if (n_in != 28 || (size_t)out_size != O_END || ws_size < WS_END) { fprintf(stderr, "kernel_launch: unexpected shapes (n_in %d, out %d, ws %zu, need %zu); nothing launched\n", n_in, out_size, ws_size, (size_t)WS_END); grid = -1; return; }
        int dev = 0, cus = 0, per_cu = 0;
        (void)hipGetDevice(&dev); (void)hipDeviceGetAttribute(&cus, hipDeviceAttributeMultiprocessorCount, dev);
        if (hipFuncSetAttribute((const void*)fwd, hipFuncAttributeMaxDynamicSharedMemorySize, LDS_BYTES) != hipSuccess) { fprintf(stderr, "kernel_launch: hipFuncSetAttribute failed\n"); grid = -1; return; }
        if (hipOccupancyMaxActiveBlocksPerMultiprocessor(&per_cu, (const void*)fwd, NTHR, LDS_BYTES) != hipSuccess || per_cu < 1) { fprintf(stderr, "kernel_launch: occupancy query says %d\n", per_cu); per_cu = 1; }
        (void)hipGetLastError();
        grid = 256;
        if (cus * per_cu < 256) { fprintf(stderr, "kernel_launch: device holds only %d x %d workgroups; this kernel needs 256 co-resident\n", cus, per_cu); grid = -1; return; }
    }
    if (grid < 0) return;
    if (hipMemsetAsync((char*)d_ws + WS_BAR, 0, 65536, stream) != hipSuccess) { fprintf(stderr, "kernel_launch: memset of barrier words failed\n"); return; }
    Args a{};
    for (int i = 0; i < 28; ++i) a.in[i] = (const float*)d_in[i];
    a.out = (float*)d_out; a.ws = (unsigned char*)d_ws;
#if MK_SPLIT
    for (int p = 0; p < N_PHASES; ++p) { a.ph_lo = p; a.ph_hi = p + 1; void* kargs[] = {&a};
        hipError_t e = hipLaunchCooperativeKernel((const void*)fwd, dim3(grid), dim3(NTHR), kargs, LDS_BYTES, stream);
        if (e != hipSuccess) { fprintf(stderr, "kernel_launch: launch failed: %s\n", hipGetErrorString(e)); break; } }
#else
    a.ph_lo = 0; a.ph_hi = N_PHASES; void* kargs[] = {&a};
    hipError_t e = hipLaunchCooperativeKernel((const void*)fwd, dim3(grid), dim3(NTHR), kargs, LDS_BYTES, stream);
    if (e != hipSuccess) fprintf(stderr, "kernel_launch: cooperative launch failed: %s (grid %d)\n", hipGetErrorString(e), grid);
#endif
}
```

```cpp
#include <hip/hip_runtime.h>
#include <hip/hip_cooperative_groups.h>
#include <cstdio>
#include <cstdint>
namespace cg = cooperative_groups;

constexpr int D = 1024, MP = 16384, MS = 512, M = MP + MS, NB = 136, SEQ = 2048;
constexpr int DR = 1280, DKT = 512, DVT = 1024, DFF = 2816, NINP = 7936, NMOD = 6144;
constexpr int X0 = 0, G0 = 1280, Q0 = 2560, K0 = 3072, V0 = 3584, R0 = 4608, GA0 = 5632, GB0 = 6656, LR0 = 7680;
constexpr float EPS = 1e-6f;

namespace pg8 {
#define PG8_LAS __attribute__((address_space(3)))
typedef unsigned short bf16_t;
typedef short bf16x8 __attribute__((ext_vector_type(8)));
typedef float f32x4 __attribute__((ext_vector_type(4)));
typedef unsigned u32x4 __attribute__((ext_vector_type(4)));
constexpr int BM = 256, BK = 64, HALF = 128, HTB = HALF * BK * 2  , STAGE_BYTES = 8 * HTB, NXCD = 8, WGM = 8;

__host__ __device__ __forceinline__ int lds_byte(int r, int c) { const int st = (r >> 4) * 2 + (c >> 5), rr = r & 15, cc = c & 31, ob = rr * 64 + cc * 2; return st * 1024 + (ob ^ (((ob >> 9) & 1) << 5)); }
__host__ __device__ __forceinline__ void stage_rc(int b, int& R, int& C) { const int st = b / 1024, sb = b % 1024, swz = sb ^ (((sb >> 9) & 1) << 5); R = (st >> 1) * 16 + swz / 64; C = (st & 1) * 32 + (swz % 64) / 2; }
__host__ __device__ __forceinline__ int perm32(int rho) { const int n = rho >> 4, i = rho & 15; return 8 * (i >> 2) + 4 * n + (i & 3); }

struct Unit { int pm, pn; };
struct Gemm { const bf16_t* A; const bf16_t* Bt; int M, N, K, lda, ldb; };

struct StaticOrder {
    int nM, nN, nwg, G, c;
    __host__ __device__ void init(int M, int N, int G_, int c_) { nM = M / BM; nN = N / BM; nwg = nM * nN; G = G_; c = c_; }
    __host__ __device__ bool next(int i, Unit& u) const {
        const long L = (long)i * G + c; if (L >= nwg) return false;
        int wgid = (int)L; { const int q = nwg / NXCD, r = nwg % NXCD, xcd = wgid % NXCD, off = wgid / NXCD; wgid = (xcd < r ? xcd * (q + 1) : r * (q + 1) + (xcd - r) * q) + off; }
        const int nig = WGM * nN, gid = wgid / nig, fm = gid * WGM, gsz = (nM - fm) < WGM ? (nM - fm) : WGM;
        u.pm = fm + ((wgid % nig) % gsz); u.pn = (wgid % nig) / gsz; return true;
    }
    __device__ __forceinline__ void a_ready(const Unit&) const {}
    __device__ __forceinline__ void done(const Unit&) const {}
};


typedef __bf16 bf16x2_t __attribute__((ext_vector_type(2)));
typedef float f32x2_t __attribute__((ext_vector_type(2)));
typedef unsigned u32x2 __attribute__((ext_vector_type(2)));
__device__ __forceinline__ unsigned cvtpk(float lo, float hi) { f32x2_t v = {lo, hi}; bf16x2_t b = __builtin_convertvector(v, bf16x2_t); return __builtin_bit_cast(unsigned, b); }
__device__ __forceinline__ float bflo(unsigned w) { return __uint_as_float(w << 16); }
__device__ __forceinline__ float bfhi(unsigned w) { return __uint_as_float(w & 0xffff0000u); }
__device__ __forceinline__ float bf2f(bf16_t h) { return __uint_as_float(((unsigned)h) << 16); }
__device__ __forceinline__ float fsigmoid(float z) { return __builtin_amdgcn_rcpf(1.0f + __builtin_amdgcn_exp2f(-1.4426950408889634f * z)); }
__device__ __forceinline__ float fexp(float z) { return __builtin_amdgcn_exp2f(1.4426950408889634f * z); }
__device__ __forceinline__ float act_apply(float x, int mode) {
    if (mode == 1) { const float z = 1.5957691216057308f * (x + 0.044715f * x * x * x); return x * fsigmoid(z); }
    if (mode == 2) return x * 0.08838834764831845f;
    if (mode == 3) return x * fsigmoid(x);
    if (mode == 4) return fsigmoid(x);
    return x;
}
__device__ __forceinline__ int row_batch(int row) { return row < MP ? (row >> 11) : 8 + ((row - MP) >> 2); }

struct EpiWin {
    static constexpr bool PERM = true, AFTER_DRAIN = false;
    bf16_t* U;
    __device__ __forceinline__ void operator()(const f32x4 (&acc)[2][2][4][2], const Unit& u, int wr, int wc, int fr, int fq) const {
        const int row0 = u.pm * BM + wr * 64 + fr, colt = u.pn * BM;
        int mode = 0;
        if (colt >= G0 && colt < Q0) mode = 1; else if (colt >= Q0 && colt < K0) mode = 2; else if (colt >= R0 && colt < GA0) mode = 3; else if (colt >= GA0 && colt < LR0) mode = 4;
        const int col0 = colt + wc * 32 + 8 * fq;
#pragma unroll
        for (int ai = 0; ai < 2; ++ai)
#pragma unroll
            for (int m = 0; m < 4; ++m) { bf16_t* rowp = U + (size_t)(row0 + ai * HALF + m * 16) * NINP + col0;
#pragma unroll
                for (int bj = 0; bj < 2; ++bj) { f32x4 v0 = acc[ai][bj][m][0], v1 = acc[ai][bj][m][1];
#pragma unroll
                    for (int e = 0; e < 4; ++e) { v0[e] = act_apply(v0[e], mode); v1[e] = act_apply(v1[e], mode); }
                    u32x4 w; w.x = cvtpk(v0[0], v0[1]); w.y = cvtpk(v0[2], v0[3]); w.z = cvtpk(v1[0], v1[1]); w.w = cvtpk(v1[2], v1[3]);
                    *(u32x4*)(rowp + bj * HALF) = w; }
                __builtin_amdgcn_sched_barrier(0); }
    }
};
struct EpiProj {
    static constexpr bool PERM = true, AFTER_DRAIN = false;
    const bf16_t* U; float* P; bf16_t* Mo; int second;
    __device__ __forceinline__ void operator()(const f32x4 (&acc)[2][2][4][2], const Unit& u, int wr, int wc, int fr, int fq) const {
        const int row0 = u.pm * BM + wr * 64 + fr, col0 = u.pn * BM + wc * 32 + 8 * fq; const int goff = second ? GB0 : GA0;
        u32x4 gwb[2][2]; f32x4 ppb[2][2][2];
#define PRJ_LOAD(it_, s_) do { const int row_ = row0 + ((it_) >> 2) * HALF + ((it_) & 3) * 16; \
            _Pragma("unroll") for (int bj = 0; bj < 2; ++bj) { const int col_ = col0 + bj * HALF; gwb[s_][bj] = *(const u32x4*)(U + (size_t)row_ * NINP + goff + col_); \
                if (second) { const float* pp_ = P + (size_t)row_ * D + col_; ppb[s_][bj][0] = *(const f32x4*)pp_; ppb[s_][bj][1] = *(const f32x4*)(pp_ + 4); } } } while (0)
        PRJ_LOAD(0, 0);
#pragma unroll
        for (int it = 0; it < 8; ++it) { const int ai = it >> 2, m = it & 3, s = it & 1; const int row = row0 + ai * HALF + m * 16;
            if (it + 1 < 8) PRJ_LOAD(it + 1, (it + 1) & 1);
#pragma unroll
            for (int bj = 0; bj < 2; ++bj) { const int col = col0 + bj * HALF; const u32x4 gw = gwb[s][bj];
                f32x4 g0 = {bflo(gw.x), bfhi(gw.x), bflo(gw.y), bfhi(gw.y)}, g1 = {bflo(gw.z), bfhi(gw.z), bflo(gw.w), bfhi(gw.w)};
                f32x4 v0 = acc[ai][bj][m][0] * g0, v1 = acc[ai][bj][m][1] * g1;
                float* pp = P + (size_t)row * D + col;
                if (!second) { *(f32x4*)pp = v0; *(f32x4*)(pp + 4) = v1; }
                else { v0 += ppb[s][bj][0]; v1 += ppb[s][bj][1];
                    u32x4 w; w.x = cvtpk(v0[0], v0[1]); w.y = cvtpk(v0[2], v0[3]); w.z = cvtpk(v1[0], v1[1]); w.w = cvtpk(v1[2], v1[3]);
                    *(u32x4*)(Mo + (size_t)row * D + col) = w; } }
            __builtin_amdgcn_sched_barrier(0); }
#undef PRJ_LOAD
    }
};
struct EpiRes {
    static constexpr bool PERM = false, AFTER_DRAIN = false;
    const float* base_p; const float* base_s; float* out; const float* gate; int dry;
    __device__ __forceinline__ void operator()(const f32x4 (&acc)[2][2][4][2], const Unit& u, int wr, int wc, int fr, int fq) const {
        const int row0 = u.pm * BM + wr * 64 + fr, col0 = u.pn * BM + wc * 32 + 4 * fq;
        f32x4 bb[2][4], gg[2][4];
#define RES_LOAD(it_, s_) do { const int row_ = row0 + ((it_) >> 2) * HALF + ((it_) & 3) * 16; const float* bp_ = row_ < MP ? base_p + (size_t)row_ * D : base_s + (size_t)(row_ - MP) * D; \
            const float* gp_ = gate + (size_t)row_batch(row_) * NMOD; \
            _Pragma("unroll") for (int q = 0; q < 4; ++q) { const int col_ = col0 + (q >> 1) * HALF + (q & 1) * 16; bb[s_][q] = *(const f32x4*)(bp_ + col_); gg[s_][q] = *(const f32x4*)(gp_ + col_); } } while (0)
        RES_LOAD(0, 0);
#pragma unroll
        for (int it = 0; it < 8; ++it) { const int ai = it >> 2, m = it & 3, s = it & 1;
            if (it + 1 < 8) RES_LOAD(it + 1, (it + 1) & 1);
            float* op = out + (size_t)(row0 + ai * HALF + m * 16) * D;
#pragma unroll
            for (int q = 0; q < 4; ++q) { const int bj = q >> 1, n = q & 1, col = col0 + bj * HALF + n * 16;
                const f32x4 rr = bb[s][q] + gg[s][q] * acc[ai][bj][m][n]; if (!dry || rr.x == 1.2345e30f) *(f32x4*)(op + col) = rr; }
            __builtin_amdgcn_sched_barrier(0); }
#undef RES_LOAD
    }
};
struct EpiSwiglu {
    static constexpr bool PERM = true, AFTER_DRAIN = false;
    bf16_t* O;
    __device__ __forceinline__ void operator()(const f32x4 (&acc)[2][2][4][2], const Unit& u, int wr, int wc, int fr, int fq) const {
        const int row0 = u.pm * BM + wr * 64 + fr, col0 = u.pn * HALF + wc * 32 + 8 * fq;
#pragma unroll
        for (int ai = 0; ai < 2; ++ai)
#pragma unroll
            for (int m = 0; m < 4; ++m) { f32x4 v0, v1;
#pragma unroll
                for (int e = 0; e < 4; ++e) { const float a0 = acc[ai][0][m][0][e], a1 = acc[ai][0][m][1][e]; v0[e] = a0 * fsigmoid(a0) * acc[ai][1][m][0][e]; v1[e] = a1 * fsigmoid(a1) * acc[ai][1][m][1][e]; }
                u32x4 w; w.x = cvtpk(v0[0], v0[1]); w.y = cvtpk(v0[2], v0[3]); w.z = cvtpk(v1[0], v1[1]); w.w = cvtpk(v1[2], v1[3]);
                *(u32x4*)(O + (size_t)(row0 + ai * HALF + m * 16) * DFF + col0) = w;
                __builtin_amdgcn_sched_barrier(0); }
    }
};
struct EpiMod {
    static constexpr bool PERM = false, AFTER_DRAIN = false;
    float* out; const float* bias;
    __device__ __forceinline__ void operator()(const f32x4 (&acc)[2][2][4][2], const Unit& u, int wr, int wc, int fr, int fq) const {
        const int row0 = u.pm * BM + wr * 64 + fr, col0 = u.pn * BM + wc * 32 + 4 * fq;
#pragma unroll
        for (int ai = 0; ai < 2; ++ai)
#pragma unroll
            for (int m = 0; m < 4; ++m) { const int row = row0 + ai * HALF + m * 16; if (row < NB) {
#pragma unroll
                for (int bj = 0; bj < 2; ++bj)
#pragma unroll
                    for (int n = 0; n < 2; ++n) { const int col = col0 + bj * HALF + n * 16;
                        *(f32x4*)(out + (size_t)row * NMOD + col) = acc[ai][bj][m][n] + *(const f32x4*)(bias + col); } } }
    }
};

template <class Epi, class Sched, bool ALIGN_EPI = false, bool SP2 = false>
__device__ __forceinline__ void gemm_phase(PG8_LAS unsigned char* lds, const Gemm g, const Sched& S, const Epi& E) {
    int tid_ = threadIdx.x; asm volatile("" : "+v"(tid_));
    const int tid = tid_, wid = __builtin_amdgcn_readfirstlane(tid >> 6), lane = tid & 63, wr = wid >> 2, wc = wid & 3, fr = lane & 15, fq = lane >> 4;
    const int K = g.K, nt = K / BK;
    unsigned voffA[2], voffB[2];
#pragma unroll
    for (int i = 0; i < 2; ++i) { int R, C; stage_rc(tid * 16 + i * 8192, R, C); const int Rb = Epi::PERM ? ((R & ~31) + perm32(R & 31)) : R;
        voffA[i] = (unsigned)(R * g.lda + C) * 2u; voffB[i] = (unsigned)(Rb * g.ldb + C) * 2u; }
    const size_t kstep = (size_t)(BK * 2);
    const size_t hstepA = (size_t)HALF * g.lda * 2, hstepB = (size_t)HALF * g.ldb * 2;
    const size_t tstepA = 2 * hstepA, tstepB = 2 * hstepB;
    const unsigned ldsw = (unsigned)wid * 1024u;
    const int aoff = lds_byte(wr * 64 + fr, fq * 8), boff = lds_byte(wc * 32 + fr, fq * 8);
#define PG8_SA(b, h) (((b) * 2 + (h)) * HTB)
#define PG8_SB(b, h) ((4 + (b) * 2 + (h)) * HTB)
#define PG8_STAGE(bufoff, gbase, voff) do { _Pragma("unroll") for (int _i = 0; _i < 2; ++_i) \
        __builtin_amdgcn_global_load_lds((const unsigned*)((const char*)(gbase) + (voff)[_i]), (PG8_LAS unsigned*)(lds + (bufoff) + ldsw + _i * 8192), 16, 0, 0); } while (0)
#define PG8_LDA(dst, b, h) do { _Pragma("unroll") for (int m = 0; m < 4; ++m) _Pragma("unroll") for (int k = 0; k < 2; ++k) dst[m][k] = *(const PG8_LAS bf16x8*)(lds + PG8_SA(b, h) + aoff + m * 2048 + k * 1024); } while (0)
#define PG8_LDB(dst, b, h) do { _Pragma("unroll") for (int n = 0; n < 2; ++n) _Pragma("unroll") for (int k = 0; k < 2; ++k) dst[n][k] = *(const PG8_LAS bf16x8*)(lds + PG8_SB(b, h) + boff + n * 2048 + k * 1024); } while (0)
#define PG8_MMA(ai, bj, At, Bt) do { __builtin_amdgcn_s_setprio(1); _Pragma("unroll") for (int m = 0; m < 4; ++m) _Pragma("unroll") for (int n = 0; n < 2; ++n) _Pragma("unroll") for (int k = 0; k < 2; ++k) \
        acc[ai][bj][m][n] = __builtin_amdgcn_mfma_f32_16x16x32_bf16(Bt[n][k], At[m][k], acc[ai][bj][m][n], 0, 0, 0); __builtin_amdgcn_s_setprio(0); } while (0)
#define PG8_WAIT_V(n) asm volatile("s_waitcnt vmcnt(" #n ")" ::: "memory")
#define PG8_WAIT_L(n) asm volatile("s_waitcnt lgkmcnt(" #n ")" ::: "memory")
#define PG8_BAR __builtin_amdgcn_s_barrier()
#define PG8_SCHED __builtin_amdgcn_sched_barrier(0)
    Unit cur, nxt; int ui = 0;
    if (!S.next(0, cur)) return;
    f32x4 acc[2][2][4][2];
#pragma unroll
    for (int a = 0; a < 2; ++a)
#pragma unroll
        for (int b = 0; b < 2; ++b)
#pragma unroll
            for (int m = 0; m < 4; ++m)
#pragma unroll
                for (int n = 0; n < 2; ++n) acc[a][b][m][n] = (f32x4){0.f, 0.f, 0.f, 0.f};
    bf16x8 At[4][2], B0[2][2], B1[2][2];
    const char* cA = (const char*)g.A + (size_t)cur.pm * tstepA; const char* cB = (const char*)g.Bt + (size_t)cur.pn * tstepB;
    S.a_ready(cur);
    if constexpr (SP2) {
        PG8_STAGE(PG8_SB(0, 0), cB, voffB); PG8_STAGE(PG8_SB(0, 1), cB + hstepB, voffB); PG8_STAGE(PG8_SA(0, 0), cA, voffA); PG8_STAGE(PG8_SA(0, 1), cA + hstepA, voffA);
        if (wr == 1) PG8_BAR;
        PG8_WAIT_V(2); PG8_BAR;
        PG8_STAGE(PG8_SB(1, 0), cB + kstep, voffB); PG8_STAGE(PG8_SA(1, 0), cA + kstep, voffA); PG8_STAGE(PG8_SB(1, 1), cB + hstepB + kstep, voffB);
        PG8_WAIT_V(6); PG8_BAR;
    } else {
        PG8_STAGE(PG8_SB(0, 0), cB, voffB); PG8_STAGE(PG8_SA(0, 0), cA, voffA); PG8_STAGE(PG8_SB(0, 1), cB + hstepB, voffB); PG8_STAGE(PG8_SA(0, 1), cA + hstepA, voffA);
        if (wr == 1) PG8_BAR;
        PG8_WAIT_V(4); PG8_BAR;
        PG8_STAGE(PG8_SB(1, 0), cB + kstep, voffB); PG8_STAGE(PG8_SA(1, 0), cA + kstep, voffA); PG8_STAGE(PG8_SB(1, 1), cB + hstepB + kstep, voffB);
        PG8_WAIT_V(6); PG8_BAR;
    }
    for (;;) {
        const bool has_next = S.next(ui + 1, nxt);
        const char* nA = has_next ? (const char*)g.A + (size_t)nxt.pm * tstepA : cA; const char* nB = has_next ? (const char*)g.Bt + (size_t)nxt.pn * tstepB : cB;
        for (int t = 0; t < nt; t += 2) {
            const bool last = (t == nt - 2);
            const char* a1 = cA + (size_t)(t + 1) * kstep;
            const char* a2 = last ? nA : cA + (size_t)(t + 2) * kstep; const char* b2 = last ? nB : cB + (size_t)(t + 2) * kstep;
            const char* a3 = a2 + kstep; const char* b3 = b2 + kstep;
            if (last && has_next) S.a_ready(nxt);
            if constexpr (SP2) {
            PG8_LDB(B0, 0, 0); PG8_LDB(B1, 0, 1); PG8_SCHED; PG8_LDA(At, 0, 0); PG8_STAGE(PG8_SA(1, 1), a1 + hstepA, voffA);
            PG8_WAIT_V(8); PG8_WAIT_L(0); PG8_BAR; PG8_MMA(0, 0, At, B0); PG8_MMA(0, 1, At, B1); PG8_BAR; PG8_SCHED;
            PG8_LDA(At, 0, 1); PG8_STAGE(PG8_SB(0, 0), b2, voffB); PG8_STAGE(PG8_SB(0, 1), b2 + hstepB, voffB); PG8_STAGE(PG8_SA(0, 0), a2, voffA);
            PG8_WAIT_V(8); PG8_WAIT_L(0); PG8_BAR; PG8_MMA(1, 0, At, B0); PG8_MMA(1, 1, At, B1); PG8_BAR; PG8_SCHED;
            PG8_LDB(B0, 1, 0); PG8_LDB(B1, 1, 1); PG8_SCHED; PG8_LDA(At, 1, 0); PG8_STAGE(PG8_SA(0, 1), a2 + hstepA, voffA);
            PG8_WAIT_V(8); PG8_WAIT_L(0); PG8_BAR; PG8_MMA(0, 0, At, B0); PG8_MMA(0, 1, At, B1); PG8_BAR; PG8_SCHED;
            PG8_LDA(At, 1, 1); PG8_STAGE(PG8_SB(1, 0), b3, voffB); PG8_STAGE(PG8_SB(1, 1), b3 + hstepB, voffB); PG8_STAGE(PG8_SA(1, 0), a3, voffA);
            PG8_WAIT_V(8); PG8_WAIT_L(0); PG8_BAR; PG8_MMA(1, 0, At, B0); PG8_MMA(1, 1, At, B1); PG8_BAR; PG8_SCHED;
            } else {
            PG8_LDB(B0, 0, 0); PG8_SCHED; PG8_LDA(At, 0, 0); PG8_STAGE(PG8_SA(1, 1), a1 + hstepA, voffA);
            PG8_WAIT_L(8); PG8_BAR; PG8_WAIT_L(0); PG8_MMA(0, 0, At, B0); PG8_BAR; PG8_SCHED;
            PG8_LDB(B1, 0, 1); PG8_STAGE(PG8_SB(0, 0), b2, voffB);
            PG8_BAR; PG8_WAIT_L(0); PG8_MMA(0, 1, At, B1); PG8_BAR;
            PG8_LDA(At, 0, 1); PG8_STAGE(PG8_SA(0, 0), a2, voffA);
            PG8_BAR; PG8_WAIT_L(0); PG8_MMA(1, 0, At, B0); PG8_BAR; PG8_SCHED;
            PG8_STAGE(PG8_SB(0, 1), b2 + hstepB, voffB);
            PG8_WAIT_V(6); PG8_BAR; PG8_MMA(1, 1, At, B1); PG8_BAR;
            PG8_LDB(B0, 1, 0); PG8_SCHED; PG8_LDA(At, 1, 0); PG8_STAGE(PG8_SA(0, 1), a2 + hstepA, voffA);
            PG8_WAIT_L(8); PG8_BAR; PG8_WAIT_L(0); PG8_MMA(0, 0, At, B0); PG8_BAR; PG8_SCHED;
            PG8_LDB(B1, 1, 1); PG8_STAGE(PG8_SB(1, 0), b3, voffB);
            PG8_BAR; PG8_WAIT_L(0); PG8_MMA(0, 1, At, B1); PG8_BAR;
            PG8_LDA(At, 1, 1); PG8_STAGE(PG8_SA(1, 0), a3, voffA);
            PG8_BAR; PG8_WAIT_L(0); PG8_MMA(1, 0, At, B0); PG8_BAR; PG8_SCHED;
            PG8_STAGE(PG8_SB(1, 1), b3 + hstepB, voffB);
            PG8_WAIT_V(6); PG8_BAR; PG8_MMA(1, 1, At, B1); PG8_BAR;
            }
        }
        if constexpr (ALIGN_EPI) { if (wr == 0) PG8_BAR; }
        if constexpr (!Epi::AFTER_DRAIN) { E(acc, cur, wr, wc, fr, fq); S.done(cur); }
        if (!has_next) break;
#pragma unroll
        for (int a = 0; a < 2; ++a)
#pragma unroll
            for (int b = 0; b < 2; ++b)
#pragma unroll
                for (int m = 0; m < 4; ++m)
#pragma unroll
                    for (int n = 0; n < 2; ++n) acc[a][b][m][n] = (f32x4){0.f, 0.f, 0.f, 0.f};
        cur = nxt; cA = nA; cB = nB; ++ui;
        if constexpr (ALIGN_EPI) { if (wr == 1) PG8_BAR; }
    }
    PG8_WAIT_V(0);
    if constexpr (!ALIGN_EPI) { if (wr == 0) PG8_BAR; }
    PG8_BAR;
    if constexpr (Epi::AFTER_DRAIN) { E.fused(acc, cur, wr, wc, fr, fq, lds, wid, lane); S.done(cur); }
#undef PG8_SA
#undef PG8_SB
#undef PG8_STAGE
#undef PG8_LDA
#undef PG8_LDB
#undef PG8_MMA
#undef PG8_WAIT_V
#undef PG8_WAIT_L
#undef PG8_BAR
#undef PG8_SCHED
}
}

#define LAS __attribute__((address_space(3)))
typedef unsigned short bf16;
typedef float f32x4 __attribute__((ext_vector_type(4)));
typedef short bf16x8 __attribute__((ext_vector_type(8)));
typedef short bf16x4 __attribute__((ext_vector_type(4)));
typedef unsigned u32x4 __attribute__((ext_vector_type(4)));
typedef unsigned u32x2 __attribute__((ext_vector_type(2)));
using pg8::cvtpk; using pg8::bflo; using pg8::bfhi; using pg8::bf2f; using pg8::fsigmoid; using pg8::fexp; using pg8::row_batch;
constexpr int NWAVES = 8, NTHR = 512, LDS_BYTES = 147456;
constexpr size_t MiB = 1u << 20;
constexpr size_t WS_BAR = 0;
constexpr size_t WS_WIN = 1 * MiB;
constexpr size_t SZ_WIN = (size_t)NINP * D * 2;
constexpr size_t WS_WPJ = WS_WIN + 2 * SZ_WIN;
constexpr size_t SZ_WPJ = (size_t)D * (DR + DVT) * 2;
constexpr size_t WS_WOUT = WS_WPJ + 2 * SZ_WPJ;
constexpr size_t SZ_WOUT = (size_t)D * D * 2;
constexpr size_t WS_W1 = WS_WOUT + 2 * SZ_WOUT;
constexpr size_t SZ_W1 = (size_t)2 * DFF * D * 2;
constexpr size_t WS_W2 = WS_W1 + 2 * SZ_W1;
constexpr size_t SZ_W2 = (size_t)D * DFF * 2;
constexpr size_t WS_ADA = WS_W2 + 2 * SZ_W2;
constexpr size_t SZ_ADA = (size_t)NMOD * D * 2;
constexpr size_t WS_WG = WS_ADA + 2 * SZ_ADA;
constexpr size_t SZ_WG = (size_t)10 * 256 * 128 * 2;
constexpr size_t WS_CS = WS_WG + 2 * SZ_WG;
constexpr size_t WS_MOD = WS_CS + (size_t)256 * D * 2;
constexpr size_t SZ_MOD = (size_t)NB * NMOD * 4;
constexpr size_t WS_HN = ((WS_MOD + 2 * SZ_MOD + MiB - 1) / MiB) * MiB;
constexpr size_t WS_U = WS_HN + (size_t)M * D * 2;
constexpr size_t WS_P = WS_U + (size_t)M * NINP * 2;
constexpr size_t WS_END = WS_P + (size_t)M * D * 4;
constexpr size_t WS_KD = WS_P;
constexpr size_t WS_EL = WS_P + 32 * MiB;
static_assert(WS_KD + (size_t)1536 * 16384 <= WS_EL && WS_EL + (size_t)1536 * 512 <= WS_END, "KD/EL overlay P");

struct Args {
    const float* in[28]; float* out; unsigned char* ws; int ph_lo, ph_hi;
};
constexpr size_t O_Y = 0, O_CONVP = (size_t)M * D, O_LRUP = O_CONVP + 2 * 8 * 3 * DR, O_GLAP = O_LRUP + 2 * 8 * DR, O_CONVS = O_GLAP + (size_t)2 * 8 * 4 * 128 * 256,
                 O_LRUS = O_CONVS + (size_t)2 * 128 * 3 * DR, O_GLAS = O_LRUS + (size_t)2 * 128 * DR, O_END = O_GLAS + (size_t)2 * 128 * 4 * 128 * 256;

__device__ __forceinline__ float bperm(int srclane, float v) { return __int_as_float(__builtin_amdgcn_ds_bpermute(srclane << 2, __float_as_int(v))); }
__device__ __forceinline__ float wave_sum(float v, int lane) {
#pragma unroll
    for (int o = 1; o < 64; o <<= 1) v += bperm(lane ^ o, v);
    return v;
}
__device__ __forceinline__ int src_col(int np, int mapmode) {
    if (mapmode == 1) { if (np < GA0) return np; if (np < LR0) return np + 16; if (np < LR0 + 16) return np - LR0 + 5632; return -1; }
    if (mapmode == 2) { const int pn = np >> 8, bj = (np >> 7) & 1, j = np & 127; return bj * DFF + pn * 128 + j; }
    return np;
}
__device__ __forceinline__ void transpose_item(const float* W, int K, int N, bf16* WT, int ldt, int koff, int nblk, int mapmode, LAS float* scr, int item, int lane) {
    const int kb = item / nblk, nb = item % nblk, k0 = 64 * kb, n0 = 32 * nb;
    const int sc = src_col(n0 + (lane & 31), mapmode);
    float v[32];
#pragma unroll
    for (int i = 0; i < 32; ++i) { const int kk = 2 * i + (lane >> 5); v[i] = sc >= 0 ? W[(size_t)(k0 + kk) * N + sc] : 0.f; }
#pragma unroll
    for (int i = 0; i < 32; ++i) { const int kk = 2 * i + (lane >> 5); scr[kk * 33 + (lane & 31)] = v[i]; }
    asm volatile("s_waitcnt lgkmcnt(0)" ::: "memory");
    const int c = lane & 7;
#pragma unroll
    for (int j = 0; j < 4; ++j) { const int n = (lane >> 3) + 8 * j; const LAS float* s = scr + (8 * c) * 33 + n;
        u32x4 o; o.x = cvtpk(s[0 * 33], s[1 * 33]); o.y = cvtpk(s[2 * 33], s[3 * 33]); o.z = cvtpk(s[4 * 33], s[5 * 33]); o.w = cvtpk(s[6 * 33], s[7 * 33]);
        *(u32x4*)(WT + (size_t)(n0 + n) * ldt + koff + k0 + 8 * c) = o; }
    asm volatile("s_waitcnt lgkmcnt(0)" ::: "memory");
}
__device__ __forceinline__ void norm_row(const float* xrow, const float* g, const float* sc, const float* sh, bf16* orow, float* orow_f, int lane) {
    const f32x4* xr = (const f32x4*)xrow + lane; f32x4 v[4]; float s = 0.f;
#pragma unroll
    for (int j = 0; j < 4; ++j) { v[j] = xr[64 * j]; s += (v[j].x * v[j].x + v[j].y * v[j].y) + (v[j].z * v[j].z + v[j].w * v[j].w); }
    const float rstd = 1.0f / sqrtf(wave_sum(s, lane) * (1.0f / D) + EPS);
#pragma unroll
    for (int j = 0; j < 4; ++j) { const int col = 4 * lane + 256 * j; const f32x4 gg = *(const f32x4*)(g + col);
        f32x4 o = v[j] * rstd * gg;
        if (orow_f) { *(f32x4*)(orow_f + col) = o; }
        else { const f32x4 a = *(const f32x4*)(sc + col), b = *(const f32x4*)(sh + col); o = o * (a + 1.0f) + b;
            u32x2 w; w.x = cvtpk(o.x, o.y); w.y = cvtpk(o.z, o.w); *(u32x2*)(orow + col) = w; } }
}

struct ScanP { int l; };
typedef const float* fptr_t;
__device__ __forceinline__ fptr_t inp(int i) {
    const __attribute__((address_space(4))) unsigned char* kp = (const __attribute__((address_space(4))) unsigned char*)__builtin_amdgcn_kernarg_segment_ptr();
    asm volatile("" : "+s"(kp));
    return *(const __attribute__((address_space(4))) fptr_t*)(kp + 8 * i);
}
#define WSP ((unsigned char*)inp(29))
#define OUTP ((float*)inp(28))
__device__ __forceinline__ bf16 f2bf1(float x) { return (bf16)(cvtpk(x, 0.f) & 0xffffu); }
#define MFMA16(a, b, c) __builtin_amdgcn_mfma_f32_16x16x32_bf16((a), (b), (c), 0, 0, 0)

template <bool SAMPLE>
__device__ __forceinline__ void lru_item(LAS unsigned char* lds, const ScanP& P, int item, int dry = 0) {
    int tid_ = threadIdx.x; asm volatile("" : "+v"(tid_));
    const int tid = tid_, lane = tid & 63, w = __builtin_amdgcn_readfirstlane(tid >> 6), fr = lane & 15, fq = lane >> 4;
    const int n = item % 10, bb = item / 10;
    const int row0 = SAMPLE ? MP + bb * 64 : bb * SEQ;
    const int nch = SAMPLE ? 1 : SEQ / 64;
    LAS bf16* XC = (LAS bf16*)lds;
    const int l = P.l; bf16* const U = (bf16*)(WSP + WS_U);
    const bf16* wg = (const bf16*)(WSP + WS_WG + l * SZ_WG) + (size_t)n * 256 * 128;
    bf16x8 Bw[2][4];
#pragma unroll
    for (int nt = 0; nt < 2; ++nt)
#pragma unroll
        for (int ks = 0; ks < 4; ++ks) Bw[nt][ks] = *(const bf16x8*)(wg + (size_t)(nt * 128 + 16 * w + fr) * 128 + 32 * ks + 8 * fq);
    const int ch = n * 128 + 16 * w + fr;
    const float ba = (inp(15) + (size_t)l * DR)[ch], bx = (inp(17) + (size_t)l * DR)[ch], lam = (inp(18) + (size_t)l * DR)[ch];
    const float cl = -8.0f * log1pf(expf(-lam));
    const int cg = tid & 15, tt = tid >> 4, cch = n * 128 + 8 * cg;
    float cw[4][8], cb[8];
#pragma unroll
    for (int i = 0; i < 4; ++i)
#pragma unroll
        for (int j = 0; j < 8; ++j) cw[i][j] = (inp(12) + (size_t)l * 4 * DR)[i * DR + cch + j];
#pragma unroll
    for (int j = 0; j < 8; ++j) cb[j] = (inp(13) + (size_t)l * DR)[cch + j];
    const float* const st_conv = SAMPLE ? inp(4) + (size_t)l * 128 * 3 * DR : nullptr; const float* const st_lru = SAMPLE ? inp(5) + (size_t)l * 128 * DR : nullptr;
    float* const o_lru_s = OUTP + O_LRUS + (size_t)l * 128 * DR;
    float hc = 0.f;
    u32x4 uq[2][4];
#define LRU_LOADC(c_) do { _Pragma("unroll") for (int p = 0; p < 2; ++p) _Pragma("unroll") for (int d = 0; d < 4; ++d) { const int tl_ = tt + 32 * p; const u32x4 z4 = {0u, 0u, 0u, 0u}; uq[p][d] = z4; \
        if ((c_) * 64 + tl_ - d >= 0) uq[p][d] = *(const u32x4*)(U + (size_t)(row0 + (c_) * 64 + tl_ - d) * NINP + X0 + cch); } } while (0)
    if (!SAMPLE) LRU_LOADC(0);
    for (int c = 0; c < nch; ++c) {
        const int r0 = row0 + c * 64;
#pragma unroll
        for (int p = 0; p < 2; ++p) {
            const int tl = tt + 32 * p; float xc[8];
#pragma unroll
            for (int j = 0; j < 8; ++j) xc[j] = cb[j];
#pragma unroll
            for (int d = 0; d < 4; ++d) {
                float uv[8];
                bool from_u, zero = false;
                if (!SAMPLE) { from_u = (c * 64 + tl - d) >= 0; zero = !from_u; } else { from_u = ((tl & 3) - d) >= 0; }
                if (!SAMPLE) { const u32x4 q = uq[p][d];
                    uv[0] = bflo(q.x); uv[1] = bfhi(q.x); uv[2] = bflo(q.y); uv[3] = bfhi(q.y); uv[4] = bflo(q.z); uv[5] = bfhi(q.z); uv[6] = bflo(q.w); uv[7] = bfhi(q.w); }
                else if (from_u) { const u32x4 q = *(const u32x4*)(U + (size_t)(r0 + tl - d) * NINP + X0 + cch);
                    uv[0] = bflo(q.x); uv[1] = bfhi(q.x); uv[2] = bflo(q.y); uv[3] = bfhi(q.y); uv[4] = bflo(q.z); uv[5] = bfhi(q.z); uv[6] = bflo(q.w); uv[7] = bfhi(q.w); }
                else if (zero) {
#pragma unroll
                    for (int j = 0; j < 8; ++j) uv[j] = 0.f; }
                else { const int b = bb * 16 + (tl >> 2); const float* sp = st_conv + ((size_t)b * 3 + (3 + (tl & 3) - d)) * DR + cch;
                    const f32x4 s0 = *(const f32x4*)sp, s1 = *(const f32x4*)(sp + 4);
                    uv[0] = s0.x; uv[1] = s0.y; uv[2] = s0.z; uv[3] = s0.w; uv[4] = s1.x; uv[5] = s1.y; uv[6] = s1.z; uv[7] = s1.w; }
#pragma unroll
                for (int j = 0; j < 8; ++j) xc[j] += cw[3 - d][j] * uv[j];
            }
            u32x4 o; o.x = cvtpk(xc[0], xc[1]); o.y = cvtpk(xc[2], xc[3]); o.z = cvtpk(xc[4], xc[5]); o.w = cvtpk(xc[6], xc[7]);
            *(LAS u32x4*)(XC + tl * 136 + 8 * cg) = o;
        }
        __syncthreads();
        if (!SAMPLE && c + 1 < nch) LRU_LOADC(c + 1);
        bf16 gv[4][4];
#pragma unroll
        for (int mt = 0; mt < 4; ++mt)
#pragma unroll
            for (int e = 0; e < 4; ++e) gv[mt][e] = U[(size_t)(r0 + 16 * mt + 4 * fq + e) * NINP + G0 + ch];
        f32x4 acc[4][2];
#pragma unroll
        for (int mt = 0; mt < 4; ++mt) { acc[mt][0] = (f32x4){0.f, 0.f, 0.f, 0.f}; acc[mt][1] = (f32x4){0.f, 0.f, 0.f, 0.f};
#pragma unroll
            for (int ks = 0; ks < 4; ++ks) { const bf16x8 a = *(const LAS bf16x8*)(XC + (16 * mt + fr) * 136 + 32 * ks + 8 * fq);
                acc[mt][0] = MFMA16(a, Bw[0][ks], acc[mt][0]); acc[mt][1] = MFMA16(a, Bw[1][ks], acc[mt][1]); } }
#pragma unroll
        for (int mt = 0; mt < 4; ++mt) {
            float Pe[4], Qe[4];
#pragma unroll
            for (int e = 0; e < 4; ++e) { const int tl = 16 * mt + 4 * fq + e;
                const float r = fsigmoid(acc[mt][0][e] + ba), ii = fsigmoid(acc[mt][1][e] + bx), la = cl * r, a = fexp(la), x2 = 2.0f * la;
                const float om = (x2 > -0.1f) ? -x2 * (1.0f + x2 * (0.5f + x2 * (0.16666667f + x2 * 0.041666668f))) : 1.0f - a * a;
                const float xcv = bf2f(XC[tl * 136 + 16 * w + fr]), bv = __builtin_amdgcn_sqrtf(om) * ii * xcv;
                if (e == 0) { Pe[0] = a; Qe[0] = bv; } else { Pe[e] = a * Pe[e - 1]; Qe[e] = a * Qe[e - 1] + bv; } }
            float hin;
            if (!SAMPLE) {
                float Pi = Pe[3], Qi = Qe[3];
                { const float Pp = bperm(lane - 16, Pi), Qp = bperm(lane - 16, Qi); if (fq >= 1) { Qi = Pi * Qp + Qi; Pi = Pi * Pp; } }
                { const float Pp = bperm(lane - 32, Pi), Qp = bperm(lane - 32, Qi); if (fq >= 2) { Qi = Pi * Qp + Qi; Pi = Pi * Pp; } }
                float Px = bperm(lane - 16, Pi), Qx = bperm(lane - 16, Qi); if (fq == 0) { Px = 1.f; Qx = 0.f; }
                hin = Px * hc + Qx;
            } else { hin = st_lru[(size_t)(bb * 16 + 4 * mt + fq) * DR + ch]; }
            float hv[4];
#pragma unroll
            for (int e = 0; e < 4; ++e) hv[e] = Pe[e] * hin + Qe[e];
            if (!SAMPLE) hc = bperm(48 + fr, hv[3]); else if (!dry) o_lru_s[(size_t)(bb * 16 + 4 * mt + fq) * DR + ch] = hv[3];
#pragma unroll
            for (int e = 0; e < 4; ++e) if (!dry || hv[e] == 1.2345e30f) U[(size_t)(r0 + 16 * mt + 4 * fq + e) * NINP + G0 + ch] = f2bf1(hv[e] * bf2f(gv[mt][e]));
        }
        __syncthreads();
    }
#undef LRU_LOADC
    if (dry) return;
    if (!SAMPLE) {
        if (fq == 0) (OUTP + O_LRUP + (size_t)l * 8 * DR)[(size_t)bb * DR + ch] = hc;
        if (tid < 384) { const int j = tid >> 7, cc = tid & 127; (OUTP + O_CONVP + (size_t)l * 8 * 3 * DR)[((size_t)bb * 3 + j) * DR + n * 128 + cc] = bf2f(U[(size_t)(row0 + SEQ - 3 + j) * NINP + X0 + n * 128 + cc]); }
    } else {
        for (int idx = tid; idx < 6144; idx += NTHR) { const int s = idx / 384, rem = idx % 384, j = rem >> 7, cc = rem & 127;
            (OUTP + O_CONVS + (size_t)l * 128 * 3 * DR)[((size_t)(bb * 16 + s) * 3 + j) * DR + n * 128 + cc] = bf2f(U[(size_t)(row0 + 4 * s + 1 + j) * NINP + X0 + n * 128 + cc]); }
    }
}

__device__ __forceinline__ void lru_half_item(LAS unsigned char* lds, int l, int item) {
    int tid_ = threadIdx.x; asm volatile("" : "+v"(tid_));
    const int tid = tid_, lane = tid & 63, w = __builtin_amdgcn_readfirstlane(tid >> 6), fr = lane & 15, fq = lane >> 4, ct = w & 3, rh = w >> 2;
    const int hf = item & 1, n = (item >> 1) % 10, bb = (item >> 1) / 10;
    const int row0 = bb * SEQ; constexpr int nch = SEQ / 64;
    LAS bf16* XC = (LAS bf16*)lds; LAS float* HX = (LAS float*)(lds + 17408); LAS float* HC = (LAS float*)(lds + 17664);
    bf16* const U = (bf16*)(WSP + WS_U);
    const bf16* wg = (const bf16*)(WSP + WS_WG + l * SZ_WG) + (size_t)n * 256 * 128;
    bf16x8 Bw[2][4];
#pragma unroll
    for (int nt = 0; nt < 2; ++nt)
#pragma unroll
        for (int ks = 0; ks < 4; ++ks) Bw[nt][ks] = *(const bf16x8*)(wg + (size_t)(nt * 128 + hf * 64 + 16 * ct + fr) * 128 + 32 * ks + 8 * fq);
    const int chl = hf * 64 + 16 * ct + fr, ch = n * 128 + chl;
    const float ba = (inp(15) + (size_t)l * DR)[ch], bx = (inp(17) + (size_t)l * DR)[ch], lam = (inp(18) + (size_t)l * DR)[ch];
    const float cl = -8.0f * log1pf(expf(-lam));
    const int cg = tid & 15, tt = tid >> 4, cch = n * 128 + 8 * cg;
    float cw[4][8], cb[8];
#pragma unroll
    for (int i = 0; i < 4; ++i)
#pragma unroll
        for (int j = 0; j < 8; ++j) cw[i][j] = (inp(12) + (size_t)l * 4 * DR)[i * DR + cch + j];
#pragma unroll
    for (int j = 0; j < 8; ++j) cb[j] = (inp(13) + (size_t)l * DR)[cch + j];
    if (tid < 64) HC[tid] = 0.f;
    float hlast = 0.f;
    u32x4 uq[2][4];
#define LRU_LOADC(c_) do { _Pragma("unroll") for (int p = 0; p < 2; ++p) _Pragma("unroll") for (int d = 0; d < 4; ++d) { const int tl_ = tt + 32 * p; const u32x4 z4 = {0u, 0u, 0u, 0u}; uq[p][d] = z4; \
        if ((c_) * 64 + tl_ - d >= 0) uq[p][d] = *(const u32x4*)(U + (size_t)(row0 + (c_) * 64 + tl_ - d) * NINP + X0 + cch); } } while (0)
    LRU_LOADC(0);
    for (int c = 0; c < nch; ++c) {
        const int r0 = row0 + c * 64;
#pragma unroll
        for (int p = 0; p < 2; ++p) {
            const int tl = tt + 32 * p; float xc[8];
#pragma unroll
            for (int j = 0; j < 8; ++j) xc[j] = cb[j];
#pragma unroll
            for (int d = 0; d < 4; ++d) { const u32x4 q = uq[p][d];
                const float uv[8] = {bflo(q.x), bfhi(q.x), bflo(q.y), bfhi(q.y), bflo(q.z), bfhi(q.z), bflo(q.w), bfhi(q.w)};
#pragma unroll
                for (int j = 0; j < 8; ++j) xc[j] += cw[3 - d][j] * uv[j]; }
            u32x4 o; o.x = cvtpk(xc[0], xc[1]); o.y = cvtpk(xc[2], xc[3]); o.z = cvtpk(xc[4], xc[5]); o.w = cvtpk(xc[6], xc[7]);
            *(LAS u32x4*)(XC + tl * 136 + 8 * cg) = o;
        }
        __syncthreads();
        if (c + 1 < nch) LRU_LOADC(c + 1);
        bf16 gv[2][4];
#pragma unroll
        for (int mi = 0; mi < 2; ++mi)
#pragma unroll
            for (int e = 0; e < 4; ++e) gv[mi][e] = U[(size_t)(r0 + 32 * rh + 16 * mi + 4 * fq + e) * NINP + G0 + ch];
        f32x4 acc[2][2];
#pragma unroll
        for (int mi = 0; mi < 2; ++mi) { acc[mi][0] = (f32x4){0.f, 0.f, 0.f, 0.f}; acc[mi][1] = (f32x4){0.f, 0.f, 0.f, 0.f};
#pragma unroll
            for (int ks = 0; ks < 4; ++ks) { const bf16x8 a = *(const LAS bf16x8*)(XC + (32 * rh + 16 * mi + fr) * 136 + 32 * ks + 8 * fq);
                acc[mi][0] = MFMA16(a, Bw[0][ks], acc[mi][0]); acc[mi][1] = MFMA16(a, Bw[1][ks], acc[mi][1]); } }
        float Pe[2][4], Qe[2][4], Px[2], Qx[2], PT[2], QT[2];
#pragma unroll
        for (int mi = 0; mi < 2; ++mi) {
#pragma unroll
            for (int e = 0; e < 4; ++e) { const int tl = 32 * rh + 16 * mi + 4 * fq + e;
                const float r = fsigmoid(acc[mi][0][e] + ba), ii = fsigmoid(acc[mi][1][e] + bx), la = cl * r, a = fexp(la), x2 = 2.0f * la;
                const float om = (x2 > -0.1f) ? -x2 * (1.0f + x2 * (0.5f + x2 * (0.16666667f + x2 * 0.041666668f))) : 1.0f - a * a;
                const float xcv = bf2f(XC[tl * 136 + chl]), bv = __builtin_amdgcn_sqrtf(om) * ii * xcv;
                if (e == 0) { Pe[mi][0] = a; Qe[mi][0] = bv; } else { Pe[mi][e] = a * Pe[mi][e - 1]; Qe[mi][e] = a * Qe[mi][e - 1] + bv; } }
            float Pi = Pe[mi][3], Qi = Qe[mi][3];
            { const float Pp = bperm(lane - 16, Pi), Qp = bperm(lane - 16, Qi); if (fq >= 1) { Qi = Pi * Qp + Qi; Pi = Pi * Pp; } }
            { const float Pp = bperm(lane - 32, Pi), Qp = bperm(lane - 32, Qi); if (fq >= 2) { Qi = Pi * Qp + Qi; Pi = Pi * Pp; } }
            float px = bperm(lane - 16, Pi), qx = bperm(lane - 16, Qi); if (fq == 0) { px = 1.f; qx = 0.f; }
            Px[mi] = px; Qx[mi] = qx;
            PT[mi] = bperm(48 + fr, Pi); QT[mi] = bperm(48 + fr, Qi);
        }
        const float P32 = PT[1] * PT[0], Q32 = PT[1] * QT[0] + QT[1];
        float hs = 0.f;
        if (rh == 0) { hs = HC[16 * ct + fr]; if (fq == 0) HX[16 * ct + fr] = P32 * hs + Q32; }
        __syncthreads();
        if (rh == 1) { hs = HX[16 * ct + fr]; hlast = P32 * hs + Q32; if (fq == 0) HC[16 * ct + fr] = hlast; }
        const float hs1 = PT[0] * hs + QT[0];
#pragma unroll
        for (int mi = 0; mi < 2; ++mi) { const float hin = Px[mi] * (mi == 0 ? hs : hs1) + Qx[mi];
#pragma unroll
            for (int e = 0; e < 4; ++e) U[(size_t)(r0 + 32 * rh + 16 * mi + 4 * fq + e) * NINP + G0 + ch] = f2bf1((Pe[mi][e] * hin + Qe[mi][e]) * bf2f(gv[mi][e])); }
    }
#undef LRU_LOADC
    if (rh == 1 && fq == 0) (OUTP + O_LRUP + (size_t)l * 8 * DR)[(size_t)bb * DR + ch] = hlast;
    if (tid < 192) { const int j = tid >> 6, cc = hf * 64 + (tid & 63); (OUTP + O_CONVP + (size_t)l * 8 * 3 * DR)[((size_t)bb * 3 + j) * DR + n * 128 + cc] = bf2f(U[(size_t)(row0 + SEQ - 3 + j) * NINP + X0 + n * 128 + cc]); }
    __syncthreads();
}

__device__ __forceinline__ void gla_prep(LAS unsigned char* lds, int l, int item, int dry = 0) {
    int tid_ = threadIdx.x; asm volatile("" : "+v"(tid_));
    const int tid = tid_;
    LAS float* LRS = (LAS float*)lds; LAS float* TOT = (LAS float*)(lds + 4096);
    const int cidx = item >> 2, h = item & 3;
    const int r0 = cidx < 256 ? (cidx >> 5) * SEQ + (cidx & 31) * 64 : MP + 4 * (cidx - 256), nv = cidx < 256 ? 64 : 4;
    const int c = tid & 127, tg = tid >> 7;
    bf16* const U = (bf16*)(WSP + WS_U);
    float wa2c[16];
#pragma unroll
    for (int r = 0; r < 16; ++r) wa2c[r] = (inp(19) + (size_t)l * 16 * DKT)[r * DKT + h * 128 + c];
    const float gba = (inp(20) + (size_t)l * DKT)[h * 128 + c];
    if (tid < 128) { const int t = tid >> 1, hf = tid & 1; u32x4 a = {0u, 0u, 0u, 0u};
        if (t < nv) a = *(const u32x4*)(U + (size_t)(r0 + t) * NINP + LR0 + 8 * hf);
        const f32x4 l0 = {bflo(a.x), bfhi(a.x), bflo(a.y), bfhi(a.y)}, l1 = {bflo(a.z), bfhi(a.z), bflo(a.w), bfhi(a.w)};
        *(LAS f32x4*)(LRS + t * 16 + 8 * hf) = l0; *(LAS f32x4*)(LRS + t * 16 + 8 * hf + 4) = l1; }
    float qv[16], kv[16];
#pragma unroll
    for (int i = 0; i < 16; ++i) { const int t = 16 * tg + i; qv[i] = 0.f; kv[i] = 0.f;
        if (t < nv) { const bf16* up = U + (size_t)(r0 + t) * NINP + h * 128 + c; qv[i] = bf2f(up[Q0]); kv[i] = bf2f(up[K0]); } }
    __syncthreads();
    float bc[16]; float run = 0.f;
#pragma unroll
    for (int i = 0; i < 16; ++i) { const int t = 16 * tg + i; float g = 0.f;
        if (t < nv) { const LAS f32x4* lp = (const LAS f32x4*)(LRS + t * 16); const f32x4 a = lp[0], b = lp[1], cc = lp[2], d = lp[3];
            float pre = gba;
            pre += wa2c[0] * a.x + wa2c[1] * a.y + wa2c[2] * a.z + wa2c[3] * a.w + wa2c[4] * b.x + wa2c[5] * b.y + wa2c[6] * b.z + wa2c[7] * b.w;
            pre += wa2c[8] * cc.x + wa2c[9] * cc.y + wa2c[10] * cc.z + wa2c[11] * cc.w + wa2c[12] * d.x + wa2c[13] * d.y + wa2c[14] * d.z + wa2c[15] * d.w;
            g = (fminf(pre, 0.f) - __logf(1.0f + fexp(-fabsf(pre)))) * 0.0625f; }
        run += g; bc[i] = run; }
    TOT[tg * 128 + c] = run;
    __syncthreads();
    float off = 0.f, blast = 0.f;
#pragma unroll
    for (int j = 0; j < 4; ++j) { const float v = TOT[j * 128 + c]; blast += v; if (j < tg) off += v; }
    float kdv[16];
#pragma unroll
    for (int i = 0; i < 16; ++i) { const int t = 16 * tg + i; const float bci = bc[i] + off;
        if (t < nv && !dry) { bf16* up = U + (size_t)(r0 + t) * NINP + h * 128 + c; up[Q0] = f2bf1(qv[i] * fexp(bci)); up[K0] = f2bf1(kv[i] * fexp(-bci)); }
        kdv[i] = kv[i] * fexp(blast - bci); }
    { u32x4 k0, k1; k0.x = cvtpk(kdv[0], kdv[1]); k0.y = cvtpk(kdv[2], kdv[3]); k0.z = cvtpk(kdv[4], kdv[5]); k0.w = cvtpk(kdv[6], kdv[7]);
      k1.x = cvtpk(kdv[8], kdv[9]); k1.y = cvtpk(kdv[10], kdv[11]); k1.z = cvtpk(kdv[12], kdv[13]); k1.w = cvtpk(kdv[14], kdv[15]);
      bf16* kd = (bf16*)(WSP + WS_KD) + (size_t)item * 8192 + c * 64 + 16 * tg; if (!dry || k0.x == 0x12345u) { *(u32x4*)kd = k0; *(u32x4*)(kd + 8) = k1; } }
    if (tg == 0 && !dry) ((float*)(WSP + WS_EL))[(size_t)item * 128 + c] = fexp(blast);
    __syncthreads();
}

__device__ __forceinline__ void gla_rec(LAS unsigned char* lds, int l, int h, int vh, int row_base, int nch, int nv_last, int cidx0, const float* S0, float* ST, int dry = 0) {
    int tid_ = threadIdx.x; asm volatile("" : "+v"(tid_));
    const int tid = tid_, lane = tid & 63, w = __builtin_amdgcn_readfirstlane(tid >> 6), fr = lane & 15, fq = lane >> 4;
    LAS bf16* Qs = (LAS bf16*)lds; LAS bf16* Ks = (LAS bf16*)(lds + 17408); LAS bf16* KDT = (LAS bf16*)(lds + 34816); LAS bf16* VT = (LAS bf16*)(lds + 53248);
    LAS bf16* ATT = (LAS bf16*)(lds + 71680); LAS float* EL = (LAS float*)(lds + 80896);
    bf16* const U = (bf16*)(WSP + WS_U); const bf16* const KDg = (const bf16*)(WSP + WS_KD); const float* const ELg = (const float*)(WSP + WS_EL);
    f32x4 S[8];
#pragma unroll
    for (int kt = 0; kt < 8; ++kt)
#pragma unroll
        for (int e = 0; e < 4; ++e) S[kt][e] = S0 ? S0[(size_t)(16 * kt + 4 * fq + e) * 256 + 16 * w + fr] : 0.f;
    u32x4 pq[2][2], pk[2][2], pd[2][2], pv[2][2]; f32x4 pe[2] = {{0.f, 0.f, 0.f, 0.f}, {0.f, 0.f, 0.f, 0.f}};
#define GLA_LOADC(ci_, u_) do { const int r0_ = row_base + (ci_) * 64, nv_ = ((ci_) == nch - 1) ? nv_last : 64; const size_t it_ = (size_t)(cidx0 + (ci_)) * 4 + h; \
        _Pragma("unroll") for (int p = 0; p < 2; ++p) { const int idx = tid + 512 * p, t = idx >> 4, seg = idx & 15, tv = idx & 63, sv = idx >> 6; \
            const u32x4 z4 = {0u, 0u, 0u, 0u}; pq[u_][p] = z4; pk[u_][p] = z4; pv[u_][p] = z4; \
            if (t < nv_) { const bf16* up = U + (size_t)(r0_ + t) * NINP + h * 128 + 8 * seg; pq[u_][p] = *(const u32x4*)(up + Q0); pk[u_][p] = *(const u32x4*)(up + K0); } \
            pd[u_][p] = *(const u32x4*)(KDg + it_ * 8192 + idx * 8); \
            if (tv < nv_) pv[u_][p] = *(const u32x4*)(U + (size_t)(r0_ + tv) * NINP + V0 + h * 256 + vh * 128 + 8 * sv); } \
        if (tid < 32) pe[u_] = *(const f32x4*)(ELg + it_ * 128 + 4 * tid); } while (0)
    GLA_LOADC(0, 0);
    if (nch > 1) GLA_LOADC(1, 1);
    for (int c2 = 0; c2 < nch; c2 += 2) {
#pragma unroll
      for (int u = 0; u < 2; ++u) { const int ci = c2 + u; if (ci < nch) {
        const int r0 = row_base + ci * 64, nv = (ci == nch - 1) ? nv_last : 64;
#pragma unroll
        for (int p = 0; p < 2; ++p) { const int idx = tid + 512 * p, t = idx >> 4, seg = idx & 15, tv = idx & 63, sv = idx >> 6;
            *(LAS u32x4*)(Qs + t * 136 + 8 * seg) = pq[u][p]; *(LAS u32x4*)(Ks + t * 136 + 8 * seg) = pk[u][p];
            *(LAS u32x4*)(KDT + (idx >> 3) * 72 + (idx & 7) * 8) = pd[u][p];
            LAS bf16* vp = VT + (8 * sv) * 72 + tv; const u32x4 vv = pv[u][p];
            vp[0] = (bf16)(vv.x & 0xffffu); vp[72] = (bf16)(vv.x >> 16); vp[144] = (bf16)(vv.y & 0xffffu); vp[216] = (bf16)(vv.y >> 16);
            vp[288] = (bf16)(vv.z & 0xffffu); vp[360] = (bf16)(vv.z >> 16); vp[432] = (bf16)(vv.w & 0xffffu); vp[504] = (bf16)(vv.w >> 16); }
        if (tid < 32) *(LAS f32x4*)(EL + 4 * tid) = pe[u];
        __syncthreads();
        if (ci + 2 < nch) GLA_LOADC(ci + 2, u);
        { const int it = w >> 1;
#pragma unroll
          for (int jj = 0; jj < 2; ++jj) { const int jt = (w & 1) * 2 + jj; f32x4 a4 = {0.f, 0.f, 0.f, 0.f};
#pragma unroll
            for (int ks = 0; ks < 4; ++ks) { const bf16x8 a = *(const LAS bf16x8*)(Ks + (16 * jt + fr) * 136 + 32 * ks + 8 * fq), b = *(const LAS bf16x8*)(Qs + (16 * it + fr) * 136 + 32 * ks + 8 * fq);
                a4 = MFMA16(a, b, a4); }
            const int i = 16 * it + fr;
#pragma unroll
            for (int e = 0; e < 4; ++e) if (16 * jt + 4 * fq + e > i) a4[e] = 0.f;
            u32x2 o2; o2.x = cvtpk(a4[0], a4[1]); o2.y = cvtpk(a4[2], a4[3]);
            *(LAS u32x2*)(ATT + i * 72 + 16 * jt + 4 * fq) = o2; } }
        __syncthreads();
        bf16x8 vb[2], Sp[4];
#pragma unroll
        for (int js = 0; js < 2; ++js) vb[js] = *(const LAS bf16x8*)(VT + (16 * w + fr) * 72 + 32 * js + 8 * fq);
#pragma unroll
        for (int ks = 0; ks < 4; ++ks) { u32x4 pk4; const f32x4 s0 = S[2 * ks], s1 = S[2 * ks + 1];
            pk4.x = cvtpk(s0[0], s0[1]); pk4.y = cvtpk(s0[2], s0[3]); pk4.z = cvtpk(s1[0], s1[1]); pk4.w = cvtpk(s1[2], s1[3]); Sp[ks] = __builtin_bit_cast(bf16x8, pk4); }
        f32x4 o[4];
#pragma unroll
        for (int it = 0; it < 4; ++it) { f32x4 oo = {0.f, 0.f, 0.f, 0.f};
#pragma unroll
            for (int js = 0; js < 2; ++js) if (2 * js <= it) { const bf16x8 aa = *(const LAS bf16x8*)(ATT + (16 * it + fr) * 72 + 32 * js + 8 * fq); oo = MFMA16(aa, vb[js], oo); }
#pragma unroll
            for (int ks = 0; ks < 4; ++ks) { const u32x2 lo = *(const LAS u32x2*)(Qs + (16 * it + fr) * 136 + 32 * ks + 4 * fq), hi = *(const LAS u32x2*)(Qs + (16 * it + fr) * 136 + 32 * ks + 16 + 4 * fq);
                u32x4 q4; q4.x = lo.x; q4.y = lo.y; q4.z = hi.x; q4.w = hi.y; oo = MFMA16(__builtin_bit_cast(bf16x8, q4), Sp[ks], oo); }
            o[it] = oo; }
#pragma unroll
        for (int kt = 0; kt < 8; ++kt) { const f32x4 el = *(const LAS f32x4*)(EL + 16 * kt + 4 * fq); S[kt] *= el; }
#pragma unroll
        for (int js = 0; js < 2; ++js)
#pragma unroll
            for (int kt = 0; kt < 8; ++kt) { const bf16x8 a = *(const LAS bf16x8*)(KDT + (16 * kt + fr) * 72 + 32 * js + 8 * fq); S[kt] = MFMA16(a, vb[js], S[kt]); }
#pragma unroll
        for (int it = 0; it < 4; ++it)
#pragma unroll
            for (int e = 0; e < 4; ++e) { const int row = 16 * it + 4 * fq + e;
                if (row < nv && (!dry || o[it][e] == 1.2345e30f)) U[(size_t)(r0 + row) * NINP + V0 + h * 256 + vh * 128 + 16 * w + fr] = f2bf1(o[it][e]); }
        __syncthreads();
      } }
    }
#undef GLA_LOADC
#pragma unroll
    for (int kt = 0; kt < 8; ++kt)
#pragma unroll
        for (int e = 0; e < 4; ++e) if (!dry || S[kt][e] == 1.2345e30f) ST[(size_t)(16 * kt + 4 * fq + e) * 256 + 16 * w + fr] = S[kt][e];
}
__device__ __forceinline__ void gla_fin_row(bf16* U, const float* gnorm, int row, int lane, int dry = 0) {
    const u32x4* op = (const u32x4*)(U + (size_t)row * NINP + V0 + 16 * lane); u32x4* rp = (u32x4*)(U + (size_t)row * NINP + R0 + 16 * lane);
    const u32x4 o0 = op[0], o1 = op[1], r0 = rp[0], r1 = rp[1];
    float ov[16] = {bflo(o0.x), bfhi(o0.x), bflo(o0.y), bfhi(o0.y), bflo(o0.z), bfhi(o0.z), bflo(o0.w), bfhi(o0.w), bflo(o1.x), bfhi(o1.x), bflo(o1.y), bfhi(o1.y), bflo(o1.z), bfhi(o1.z), bflo(o1.w), bfhi(o1.w)};
    const float rv[16] = {bflo(r0.x), bfhi(r0.x), bflo(r0.y), bfhi(r0.y), bflo(r0.z), bfhi(r0.z), bflo(r0.w), bfhi(r0.w), bflo(r1.x), bfhi(r1.x), bflo(r1.y), bfhi(r1.y), bflo(r1.z), bfhi(r1.z), bflo(r1.w), bfhi(r1.w)};
    float ss = 0.f;
#pragma unroll
    for (int i = 0; i < 16; ++i) ss += ov[i] * ov[i];
    ss += bperm(lane ^ 1, ss); ss += bperm(lane ^ 2, ss); ss += bperm(lane ^ 4, ss); ss += bperm(lane ^ 8, ss);
    const float rstd = 1.0f / sqrtf(ss * (1.0f / 256.0f) + EPS);
    const f32x4* gp = (const f32x4*)(gnorm + 16 * lane);
#pragma unroll
    for (int j = 0; j < 4; ++j) { const f32x4 g = gp[j];
#pragma unroll
        for (int e = 0; e < 4; ++e) ov[4 * j + e] = ov[4 * j + e] * rstd * g[e] * rv[4 * j + e]; }
    u32x4 w0, w1; w0.x = cvtpk(ov[0], ov[1]); w0.y = cvtpk(ov[2], ov[3]); w0.z = cvtpk(ov[4], ov[5]); w0.w = cvtpk(ov[6], ov[7]);
    w1.x = cvtpk(ov[8], ov[9]); w1.y = cvtpk(ov[10], ov[11]); w1.z = cvtpk(ov[12], ov[13]); w1.w = cvtpk(ov[14], ov[15]);
    if (!dry || w0.x == 0x12345u) { rp[0] = w0; rp[1] = w1; }
}

__device__ __forceinline__ void small_gemm(LAS unsigned char* lds, const bf16* A, int lda, const bf16* Bt, int ldb, int K, f32x4 (&acc)[2]) {
    int tid_ = threadIdx.x; asm volatile("" : "+v"(tid_));
    const int tid = tid_, lane = tid & 63, w = __builtin_amdgcn_readfirstlane(tid >> 6), fr = lane & 15, fq = lane >> 4, wr = w & 3, wc = w >> 2;
    const int r = tid >> 3, seg = tid & 7, ns = K >> 7;
    const bf16* ap = A + (size_t)r * lda + 8 * seg; const bf16* bp = Bt + (size_t)r * ldb + 8 * seg;
    u32x4 pa[3][2], pb[3][2];
#pragma unroll
    for (int u = 0; u < 3; ++u) if (u < ns) {
#pragma unroll
        for (int hh = 0; hh < 2; ++hh) { pa[u][hh] = *(const u32x4*)(ap + u * 128 + 64 * hh); pb[u][hh] = *(const u32x4*)(bp + u * 128 + 64 * hh); } }
    for (int s0 = 0; s0 < ns; s0 += 3) {
#pragma unroll
        for (int u = 0; u < 3; ++u) { const int st = s0 + u; if (st < ns) {
            LAS bf16* As = (LAS bf16*)(lds + u * 34816); LAS bf16* Bs = (LAS bf16*)(lds + u * 34816 + 17408);
#pragma unroll
            for (int hh = 0; hh < 2; ++hh) { *(LAS u32x4*)(As + r * 136 + 64 * hh + 8 * seg) = pa[u][hh]; *(LAS u32x4*)(Bs + r * 136 + 64 * hh + 8 * seg) = pb[u][hh]; }
            __syncthreads();
            if (st + 3 < ns) {
#pragma unroll
                for (int hh = 0; hh < 2; ++hh) { pa[u][hh] = *(const u32x4*)(ap + (st + 3) * 128 + 64 * hh); pb[u][hh] = *(const u32x4*)(bp + (st + 3) * 128 + 64 * hh); } }
#pragma unroll
            for (int kk = 0; kk < 4; ++kk) { const bf16x8 a = *(const LAS bf16x8*)(As + (16 * wr + fr) * 136 + 32 * kk + 8 * fq);
#pragma unroll
                for (int n = 0; n < 2; ++n) { const bf16x8 b = *(const LAS bf16x8*)(Bs + (32 * wc + 16 * n + fr) * 136 + 32 * kk + 8 * fq); acc[n] = MFMA16(a, b, acc[n]); } }
        } }
    }
    __syncthreads();
}

#define XB_TMO      128
#define XB_XCNT(j)  (256  + 64 * (j))
#define XB_XSUB(j)  (1280 + 64 * (j))
#define XB_XGEN(j)  (2304 + 64 * (j))
#define XB_TOP      3328
#define XB_TOPGEN   3392
#define XCD_BAR_WORDS 3456
#define XB_SPIN_CAP (1u << 18)

__device__ __forceinline__ unsigned xb_ld(unsigned* p)              { return __hip_atomic_load(p, __ATOMIC_RELAXED, __HIP_MEMORY_SCOPE_AGENT); }
__device__ __forceinline__ unsigned xb_add(unsigned* p, unsigned v) { return __hip_atomic_fetch_add(p, v, __ATOMIC_RELAXED, __HIP_MEMORY_SCOPE_AGENT); }
__device__ __forceinline__ unsigned xb_xcc_id() { return (unsigned)__builtin_amdgcn_s_getreg((3 << 11) | 20) & 0xFu; }
#define XB_SPIN(cond, bar) do { unsigned _sp = 0; while (cond) { __builtin_amdgcn_s_sleep(1); \
    if ((++_sp & 255u) == 0u) { if (xb_ld(&(bar)[XB_TMO])) break; if (_sp > XB_SPIN_CAP) { atomicAdd(&(bar)[XB_TMO], 1u); break; } } } } while (0)

struct XcdBarrier {
    unsigned* bar; unsigned x;
    volatile LAS unsigned* st;
};

__device__ __forceinline__ XcdBarrier xcd_barrier_post(unsigned* bar, volatile LAS unsigned* st) {
    XcdBarrier b; b.bar = bar; b.x = xb_xcc_id(); b.st = st;
    if (threadIdx.x == 0) (void)xb_add(&bar[XB_XCNT(b.x)], 1u);
    return b;
}
__device__ __forceinline__ void xcd_barrier_complete(unsigned* bar, unsigned x, unsigned& nloc, unsigned& nx) {
    const unsigned G = gridDim.x * gridDim.y * gridDim.z;
    unsigned sum, cnt, mine, sp = 0u;
    for (;;) {
        sum = 0u; cnt = 0u; mine = 0u;
#pragma unroll
        for (unsigned j = 0; j < 16; ++j) { const unsigned c = xb_ld(&bar[XB_XCNT(j)]); sum += c; cnt += (c > 0u) ? 1u : 0u; mine = (j == x) ? c : mine; }
        if (sum == G) break;
        __builtin_amdgcn_s_sleep(1);
        if ((++sp & 255u) == 0u) { if (xb_ld(&bar[XB_TMO])) break; if (sp > XB_SPIN_CAP) { atomicAdd(&bar[XB_TMO], 1u); break; } }
    }
    nloc = mine > 0u ? mine : 1u; nx = cnt > 0u ? cnt : 1u;
}

__device__ __forceinline__ void xcd_barrier(const XcdBarrier& b) {
    asm volatile("s_waitcnt vmcnt(0)" ::: "memory");
    __syncthreads();
    if (threadIdx.x == 0) {
        unsigned* bar = b.bar;
        __builtin_amdgcn_s_waitcnt(0);
        unsigned nloc = b.st[0], nx = b.st[1];
        if (nloc == 0u) { xcd_barrier_complete(bar, b.x, nloc, nx); b.st[0] = nloc; b.st[1] = nx; }
        const unsigned old = xb_add(&bar[XB_XSUB(b.x)], 1u);
        const unsigned gen = old / nloc;
        if (old + 1u == (gen + 1u) * nloc) {
            __builtin_amdgcn_fence(__ATOMIC_RELEASE, "agent");
            asm volatile("s_waitcnt vmcnt(0)" ::: "memory");
            const unsigned og = xb_add(&bar[XB_TOP], 1u);
            const unsigned tg = og / nx;
            if (og + 1u == (tg + 1u) * nx) xb_add(&bar[XB_TOPGEN], 1u);
            else XB_SPIN(xb_ld(&bar[XB_TOPGEN]) == tg, bar);
            __builtin_amdgcn_fence(__ATOMIC_ACQUIRE, "agent");
            xb_add(&bar[XB_XGEN(b.x)], 1u);
            asm volatile("s_waitcnt vmcnt(0)" ::: "memory");
        } else {
            XB_SPIN(xb_ld(&bar[XB_XGEN(b.x)]) == gen, bar);
            __builtin_amdgcn_fence(__ATOMIC_ACQUIRE, "agent");
            asm volatile("s_waitcnt vmcnt(0)" ::: "memory");
        }
    }
    __syncthreads();
}

constexpr int N_PHASES = 23;
__global__ void __launch_bounds__(NTHR, 2) fwd(Args args) {
    extern __shared__ __attribute__((aligned(16))) unsigned char lds_raw[];
    LAS unsigned char* lds = (LAS unsigned char*)lds_raw;
    cg::grid_group grid = cg::this_grid();
    { volatile LAS unsigned* st0 = (volatile LAS unsigned*)(lds + 131072 + 64); if (threadIdx.x < 2) st0[threadIdx.x] = 0u; __syncthreads(); }
    const XcdBarrier xbar = xcd_barrier_post((unsigned*)(args.ws + WS_BAR), (volatile LAS unsigned*)(lds + 131072 + 64));
    const int G = gridDim.x, bx = blockIdx.x;
#define PHASE_LOCALS int t_ = threadIdx.x; asm volatile("" : "+v"(t_)); const int tid = t_, lane = tid & 63, wave = __builtin_amdgcn_readfirstlane(tid >> 6), gw = bx * NWAVES + wave, NGW = G * NWAVES; (void)tid; (void)lane; (void)gw; (void)NGW;
#define ws WSP
#define X (OUTP + O_Y)
#define HN ((bf16*)(WSP + WS_HN))
#define U ((bf16*)(WSP + WS_U))
#define FF ((bf16*)(WSP + WS_U))
#define PB ((float*)(WSP + WS_P))
#define MOD ((float*)(WSP + WS_MOD))
#define CS ((bf16*)(WSP + WS_CS))
    const int lo = args.ph_lo, hi = args.ph_hi;
#ifndef PROBE_P0
#define PROBE_P0 0
#endif
#ifndef PROBE_SYNC
#define PROBE_SYNC 0
#endif
#ifndef PROBE_RES
#define PROBE_RES 0
#endif
#ifndef PROBE_PREP
#define PROBE_PREP 0
#endif
#ifndef PROBE_REC
#define PROBE_REC 0
#endif
#ifndef PROBE_FIN
#define PROBE_FIN 0
#endif
#ifndef REP
#define REP 1
#endif
#ifndef SCM
#define SCM 15
#endif
#ifndef DBG_MASK
#define DBG_MASK 0x7ffff
#endif
#define PHON(k) ((DBG_MASK >> ((k) < 10 ? (k) : (k) - 8)) & 1)
#define IN(k) (lo <= (k) && (k) < hi)
#define SEAM(k) do { if (lo <= (k) && (k) + 1 < hi) { if (lo == 0x7fffffff) grid.sync(); else xcd_barrier(xbar); } } while (0)

    for (int rp0_ = 0; rp0_ < 1 + (PROBE_P0 ? (hi > 22) : 0); ++rp0_) if (IN(0)) {
        PHASE_LOCALS
        LAS float* scr = (LAS float*)(lds + wave * 16384);
        constexpr int I_ADA = 16 * 192;
        for (int it = gw; it < 2 * I_ADA; it += NGW) { const int l = it / I_ADA, r = it % I_ADA;
            transpose_item(inp(9) + (size_t)l * D * NMOD, D, NMOD, (bf16*)(ws + WS_ADA + l * SZ_ADA), D, 0, 192, 0, scr, r, lane); }
        bf16* WG = (bf16*)(ws + WS_WG);
        for (int idx = bx * NTHR + tid; idx < 2 * 10 * 256 * 128; idx += G * NTHR) {
            const int l = idx / 327680, r = idx % 327680, n = r >> 15, vv = (r >> 7) & 255, wi = r & 127;
            const float* src = (vv < 128 ? inp(14) : inp(16)) + ((size_t)(l * 10 + n) * 128 + wi) * 128 + (vv & 127);
            WG[idx] = f2bf1(*src);
        }
        for (int idx = bx * NTHR + tid; idx < 256 * D; idx += G * NTHR) {
            const int row = idx >> 10, col = idx & 1023; float v = 0.f;
            if (row < 8) v = inp(2)[row * D + col]; else if (row < NB) v = inp(3)[(row - 8) * D + col];
            CS[idx] = f2bf1(v * fsigmoid(v));
        }
    }
    SEAM(0);
    for (int rp1_ = 0; rp1_ < 1 + (PROBE_P0 ? (hi > 22) : 0); ++rp1_) if (IN(1)) {
        if (bx < 48) { const int l = bx / 24;
            pg8::Gemm g{CS, (const bf16*)(ws + WS_ADA + l * SZ_ADA), 256, NMOD, D, D, D}; pg8::StaticOrder S; S.init(256, NMOD, G, bx % 24);
            pg8::EpiMod E{MOD + (size_t)l * NB * NMOD, inp(10) + (size_t)l * NMOD};
            pg8::gemm_phase<pg8::EpiMod, pg8::StaticOrder, true, true>(lds, g, S, E);
        } else {
            PHASE_LOCALS
            LAS float* scr = (LAS float*)(lds + wave * 16384);
            const int gw2 = (bx - 48) * NWAVES + wave, NGW2 = (G - 48) * NWAVES;
            constexpr int I_WIN = 16 * 248, I_PA = 20 * 32, I_PB = 16 * 32, I_WO = 16 * 32, I_W1 = 16 * 176, I_W2 = 44 * 32;
            constexpr int I_L = I_WIN + I_PA + I_PB + I_WO + I_W1 + I_W2;
            for (int it = gw2; it < 2 * I_L; it += NGW2) {
                const int l = it / I_L; int r = it % I_L;
                if (r < I_WIN) { transpose_item(inp(11) + (size_t)l * D * 7696, D, 7696, (bf16*)(ws + WS_WIN + l * SZ_WIN), D, 0, 248, 1, scr, r, lane); continue; } r -= I_WIN;
                if (r < I_PA) { transpose_item(inp(22) + (size_t)l * DR * D, DR, D, (bf16*)(ws + WS_WPJ + l * SZ_WPJ), DR + DVT, 0, 32, 0, scr, r, lane); continue; } r -= I_PA;
                if (r < I_PB) { transpose_item(inp(23) + (size_t)l * DVT * D, DVT, D, (bf16*)(ws + WS_WPJ + l * SZ_WPJ), DR + DVT, DR, 32, 0, scr, r, lane); continue; } r -= I_PB;
                if (r < I_WO) { transpose_item(inp(24) + (size_t)l * D * D, D, D, (bf16*)(ws + WS_WOUT + l * SZ_WOUT), D, 0, 32, 0, scr, r, lane); continue; } r -= I_WO;
                if (r < I_W1) { transpose_item(inp(25) + (size_t)l * D * 2 * DFF, D, 2 * DFF, (bf16*)(ws + WS_W1 + l * SZ_W1), D, 0, 176, 2, scr, r, lane); continue; } r -= I_W1;
                transpose_item(inp(26) + (size_t)l * DFF * D, DFF, D, (bf16*)(ws + WS_W2 + l * SZ_W2), DFF, 0, 32, 0, scr, r, lane);
            }
        }
    }
    SEAM(1);
    for (int l = 0; l < 2; ++l) {
        const int pb = 2 + 10 * l;
#define modl (MOD + (size_t)l * NB * NMOD)
        if (IN(pb)) {
            PHASE_LOCALS
            for (int row = gw; row < M; row += NGW) {
                const float* xr = l == 0 ? (row < MP ? inp(0) + (size_t)row * D : inp(1) + (size_t)(row - MP) * D) : X + (size_t)row * D;
                const float* mb = modl + (size_t)row_batch(row) * NMOD;
                norm_row(xr, inp(7) + l * D, mb + 1024, mb, HN + (size_t)row * D, nullptr, lane);
            }
        }
        SEAM(pb);
        if (IN(pb + 1)) {
            pg8::Gemm g{HN, (const bf16*)(ws + WS_WIN + l * SZ_WIN), M, NINP, D, D, D}; pg8::StaticOrder S; S.init(M, NINP, G, bx);
            pg8::EpiWin E{U};
            pg8::gemm_phase<pg8::EpiWin, pg8::StaticOrder, true, true>(lds, g, S, E);
        }
        SEAM(pb + 1);
        if (IN(pb + 2)) {
            const int nrep = 1 + (PROBE_PREP ? (hi > 22) : 0);
            for (int rp_ = 0; rp_ < nrep; ++rp_) { const int dry = rp_ < nrep - 1;
            for (int item = bx; item < 1536; item += G) gla_prep(lds, l, item, dry); }
        }
        SEAM(pb + 2);
        if (IN(pb + 3)) {
            ScanP P; P.l = l;
            float* const o_gla_p = OUTP + O_GLAP + (size_t)l * 8 * 4 * 32768; float* const o_gla_s = OUTP + O_GLAS + (size_t)l * 128 * 4 * 32768;
            if (bx < 64) { const int nrep = 1 + (PROBE_REC == 2 ? (hi > 22) : 0); for (int rp_ = 0; rp_ < nrep; ++rp_) { const int b = bx >> 3, h = (bx >> 1) & 3, vh = bx & 1; gla_rec(lds, l, h, vh, b * SEQ, SEQ / 64, 64, b * 32, nullptr, o_gla_p + (size_t)(b * 4 + h) * 32768 + vh * 128, rp_ < nrep - 1); } }
            else if (bx < 224) { lru_half_item(lds, l, bx - 64); }
            { unsigned* qc = (unsigned*)(WSP + WS_BAR) + 8192 + 64 * l; volatile LAS unsigned* qs = (volatile LAS unsigned*)(lds + 131072 + 128);
              for (;;) {
                __syncthreads();
                if (threadIdx.x == 0) *qs = atomicAdd(qc, 1u);
                __syncthreads();
                const int j = (int)*qs;
                if (j >= 1104) break;
                if (j < 80) lru_item<true>(lds, P, j);
                else { const int jj = j - 80, b = jj >> 3, h = (jj >> 1) & 3, vh = jj & 1;
                    gla_rec(lds, l, h, vh, MP + b * 4, 1, 4, 256 + b, inp(6) + (size_t)l * 128 * 4 * 32768 + (size_t)(b * 4 + h) * 32768 + vh * 128, o_gla_s + (size_t)(b * 4 + h) * 32768 + vh * 128); }
              } }
        }
        SEAM(pb + 3);
        if (IN(pb + 4)) {
            PHASE_LOCALS
            const int nrep = 1 + (PROBE_FIN ? (hi > 22) : 0);
            for (int rp_ = 0; rp_ < nrep; ++rp_) { const int dry = rp_ < nrep - 1;
            for (int row = gw; row < M; row += NGW) gla_fin_row(U, inp(21) + (size_t)l * DVT, row, lane, dry); }
        }
        SEAM(pb + 4);
        if (IN(pb + 5)) {
            const bf16* wpj = (const bf16*)(ws + WS_WPJ + l * SZ_WPJ);
            { pg8::Gemm g{U + G0, wpj, MP, D, DR, NINP, DR + DVT}; pg8::StaticOrder S; S.init(MP, D, G, bx); pg8::EpiProj E{U, PB, HN, 0};
              pg8::gemm_phase<pg8::EpiProj, pg8::StaticOrder, true, true>(lds, g, S, E); }
            { pg8::Gemm g{U + R0, wpj + DR, MP, D, DVT, NINP, DR + DVT}; pg8::StaticOrder S; S.init(MP, D, G, bx); pg8::EpiProj E{U, PB, HN, 1};
              pg8::gemm_phase<pg8::EpiProj, pg8::StaticOrder, true, true>(lds, g, S, E); }
            if (bx >= G - 128) {
                const int j = G - 1 - bx, rt = j >> 4, ct = j & 15; const int rowt = MP + 64 * rt, colt = 64 * ct;
                f32x4 aa[2] = {{0.f, 0.f, 0.f, 0.f}, {0.f, 0.f, 0.f, 0.f}}, ab[2] = {{0.f, 0.f, 0.f, 0.f}, {0.f, 0.f, 0.f, 0.f}};
                small_gemm(lds, U + (size_t)rowt * NINP + G0, NINP, wpj + (size_t)colt * (DR + DVT), DR + DVT, DR, aa);
                small_gemm(lds, U + (size_t)rowt * NINP + R0, NINP, wpj + (size_t)colt * (DR + DVT) + DR, DR + DVT, DVT, ab);
                int t_ = threadIdx.x; asm volatile("" : "+v"(t_)); const int lane = t_ & 63, w = t_ >> 6, fr = lane & 15, fq = lane >> 4;
#pragma unroll
                for (int n = 0; n < 2; ++n)
#pragma unroll
                    for (int e = 0; e < 4; ++e) { const int row = rowt + 16 * (w & 3) + 4 * fq + e, col = colt + 32 * (w >> 2) + 16 * n + fr; const bf16* up = U + (size_t)row * NINP + col;
                        HN[(size_t)row * D + col] = f2bf1(bf2f(up[GA0]) * aa[n][e] + bf2f(up[GB0]) * ab[n][e]); }
            }
        }
        SEAM(pb + 5);
        if (IN(pb + 6)) {
            pg8::Gemm g{HN, (const bf16*)(ws + WS_WOUT + l * SZ_WOUT), MP, D, D, D, D}; pg8::StaticOrder S; S.init(MP, D, G, bx);
            const int nrep = 1 + (PROBE_RES ? (hi > 22) : 0);
            for (int rp_ = 0; rp_ < nrep; ++rp_) {
            pg8::EpiRes E{l == 0 ? inp(0) : X, l == 0 ? inp(1) : X + (size_t)MP * D, X, modl + 2048, rp_ < nrep - 1};
            pg8::gemm_phase<pg8::EpiRes, pg8::StaticOrder, true, true>(lds, g, S, E); }
            if (bx >= G - 128) { const int j = G - 1 - bx, rt = j >> 4, ct = j & 15; const int rowt = MP + 64 * rt, colt = 64 * ct;
                f32x4 aa[2] = {{0.f, 0.f, 0.f, 0.f}, {0.f, 0.f, 0.f, 0.f}};
                small_gemm(lds, HN + (size_t)rowt * D, D, (const bf16*)(ws + WS_WOUT + l * SZ_WOUT) + (size_t)colt * D, D, D, aa);
                int t_ = threadIdx.x; asm volatile("" : "+v"(t_)); const int lane = t_ & 63, w = t_ >> 6, fr = lane & 15, fq = lane >> 4;
                const float* bs = l == 0 ? inp(1) : X + (size_t)MP * D;
#pragma unroll
                for (int n = 0; n < 2; ++n)
#pragma unroll
                    for (int e = 0; e < 4; ++e) { const int row = rowt + 16 * (w & 3) + 4 * fq + e, col = colt + 32 * (w >> 2) + 16 * n + fr;
                        X[(size_t)row * D + col] = bs[(size_t)(row - MP) * D + col] + (modl + 2048)[(size_t)row_batch(row) * NMOD + col] * aa[n][e]; }
            }
        }
        SEAM(pb + 6);
        if (IN(pb + 7)) {
            PHASE_LOCALS
            for (int row = gw; row < M; row += NGW) {
                const float* mb = modl + (size_t)row_batch(row) * NMOD;
                norm_row(X + (size_t)row * D, inp(8) + l * D, mb + 4096, mb + 3072, HN + (size_t)row * D, nullptr, lane);
            }
        }
        SEAM(pb + 7);
        if (IN(pb + 8)) {
            pg8::Gemm g{HN, (const bf16*)(ws + WS_W1 + l * SZ_W1), M, 2 * DFF, D, D, D}; pg8::StaticOrder S; S.init(M, 2 * DFF, G, bx);
            pg8::EpiSwiglu E{FF};
            pg8::gemm_phase<pg8::EpiSwiglu, pg8::StaticOrder, true, true>(lds, g, S, E);
        }
        SEAM(pb + 8);
        if (IN(pb + 9)) {
            pg8::Gemm g{FF, (const bf16*)(ws + WS_W2 + l * SZ_W2), MP, D, DFF, DFF, DFF}; pg8::StaticOrder S; S.init(MP, D, G, bx);
            const int nrep = 1 + (PROBE_RES ? (hi > 22) : 0);
            for (int rp_ = 0; rp_ < nrep; ++rp_) {
            pg8::EpiRes E{X, X + (size_t)MP * D, X, modl + 5120, rp_ < nrep - 1};
            pg8::gemm_phase<pg8::EpiRes, pg8::StaticOrder, true, true>(lds, g, S, E); }
            if (bx >= G - 128) { const int j = G - 1 - bx, rt = j >> 4, ct = j & 15; const int rowt = MP + 64 * rt, colt = 64 * ct;
                f32x4 aa[2] = {{0.f, 0.f, 0.f, 0.f}, {0.f, 0.f, 0.f, 0.f}};
                small_gemm(lds, FF + (size_t)rowt * DFF, DFF, (const bf16*)(ws + WS_W2 + l * SZ_W2) + (size_t)colt * DFF, DFF, DFF, aa);
                int t_ = threadIdx.x; asm volatile("" : "+v"(t_)); const int lane = t_ & 63, w = t_ >> 6, fr = lane & 15, fq = lane >> 4;
#pragma unroll
                for (int n = 0; n < 2; ++n)
#pragma unroll
                    for (int e = 0; e < 4; ++e) { const int row = rowt + 16 * (w & 3) + 4 * fq + e, col = colt + 32 * (w >> 2) + 16 * n + fr;
                        float* xp_ = X + (size_t)row * D + col; *xp_ = *xp_ + (modl + 5120)[(size_t)row_batch(row) * NMOD + col] * aa[n][e]; }
            }
        }
        SEAM(pb + 9);
    }
    if (IN(22)) {
        PHASE_LOCALS
        for (int row = gw; row < M; row += NGW) norm_row(X + (size_t)row * D, inp(27), nullptr, nullptr, nullptr, X + (size_t)row * D, lane);
    }
#undef IN
#undef SEAM
#undef ws
#undef X
#undef HN
#undef U
#undef FF
#undef PB
#undef MOD
#undef CS
#undef modl
}

#ifndef MK_SPLIT
#define MK_SPLIT 0
#endif
extern "C" void kernel_launch(void* const* d_in, const int* in_sizes, int n_in, void* d_out, int out_size, void* d_ws, size_t ws_size, hipStream_t stream) {
    static int grid = 0;
    if (grid == 0) {
        if (n_in != 28 || (size_t)out_size != O_END || ws_size < WS_END) { fprintf(stderr, "kernel_launch: unexpected shapes (n_in %d, out %d, ws %zu, need %zu); nothing launched\n", n_in, out_size, ws_size, (size_t)WS_END); grid = -1; return; }
        int dev = 0, cus = 0, per_cu = 0;
        (void)hipGetDevice(&dev); (void)hipDeviceGetAttribute(&cus, hipDeviceAttributeMultiprocessorCount, dev);
        if (hipFuncSetAttribute((const void*)fwd, hipFuncAttributeMaxDynamicSharedMemorySize, LDS_BYTES) != hipSuccess) { fprintf(stderr, "kernel_launch: hipFuncSetAttribute failed\n"); grid = -1; return; }
        if (hipOccupancyMaxActiveBlocksPerMultiprocessor(&per_cu, (const void*)fwd, NTHR, LDS_BYTES) != hipSuccess || per_cu < 1) { fprintf(stderr, "kernel_launch: occupancy query says %d\n", per_cu); per_cu = 1; }
        (void)hipGetLastError();
        grid = 256;
        if (cus * per_cu < 256) { fprintf(stderr, "kernel_launch: device holds only %d x %d workgroups; this kernel needs 256 co-resident\n", cus, per_cu); grid = -1; return; }
    }
    if (grid < 0) return;
    if (hipMemsetAsync((char*)d_ws + WS_BAR, 0, 65536, stream) != hipSuccess) { fprintf(stderr, "kernel_launch: memset of barrier words failed\n"); return; }
    Args a{};
    for (int i = 0; i < 28; ++i) a.in[i] = (const float*)d_in[i];
    a.out = (float*)d_out; a.ws = (unsigned char*)d_ws;
#if MK_SPLIT
    for (int p = 0; p < N_PHASES; ++p) { a.ph_lo = p; a.ph_hi = p + 1; void* kargs[] = {&a};
        hipError_t e = hipLaunchCooperativeKernel((const void*)fwd, dim3(grid), dim3(NTHR), kargs, LDS_BYTES, stream);
        if (e != hipSuccess) { fprintf(stderr, "kernel_launch: launch failed: %s\n", hipGetErrorString(e)); break; } }
#else
    a.ph_lo = 0; a.ph_hi = N_PHASES; void* kargs[] = {&a};
    hipError_t e = hipLaunchCooperativeKernel((const void*)fwd, dim3(grid), dim3(NTHR), kargs, LDS_BYTES, stream);
    if (e != hipSuccess) fprintf(stderr, "kernel_launch: cooperative launch failed: %s (grid %d)\n", hipGetErrorString(e), grid);
#endif
}
```

```cpp
#include <hip/hip_runtime.h>
#include <hip/hip_cooperative_groups.h>
#include <cstdio>
#include <cstdint>
namespace cg = cooperative_groups;

constexpr int D = 1024, MP = 16384, MS = 512, M = MP + MS, NB = 136, SEQ = 2048;
constexpr int DR = 1280, DKT = 512, DVT = 1024, DFF = 2816, NINP = 7936, NMOD = 6144;
constexpr int X0 = 0, G0 = 1280, Q0 = 2560, K0 = 3072, V0 = 3584, R0 = 4608, GA0 = 5632, GB0 = 6656, LR0 = 7680;
constexpr float EPS = 1e-6f;

namespace pg8 {
#define PG8_LAS __attribute__((address_space(3)))
typedef unsigned short bf16_t;
typedef short bf16x8 __attribute__((ext_vector_type(8)));
typedef float f32x4 __attribute__((ext_vector_type(4)));
typedef unsigned u32x4 __attribute__((ext_vector_type(4)));
constexpr int BM = 256, BK = 64, HALF = 128, HTB = HALF * BK * 2  , STAGE_BYTES = 8 * HTB, NXCD = 8, WGM = 8;

__host__ __device__ __forceinline__ int lds_byte(int r, int c) { const int st = (r >> 4) * 2 + (c >> 5), rr = r & 15, cc = c & 31, ob = rr * 64 + cc * 2; return st * 1024 + (ob ^ (((ob >> 9) & 1) << 5)); }
__host__ __device__ __forceinline__ void stage_rc(int b, int& R, int& C) { const int st = b / 1024, sb = b % 1024, swz = sb ^ (((sb >> 9) & 1) << 5); R = (st >> 1) * 16 + swz / 64; C = (st & 1) * 32 + (swz % 64) / 2; }
__host__ __device__ __forceinline__ int perm32(int rho) { const int n = rho >> 4, i = rho & 15; return 8 * (i >> 2) + 4 * n + (i & 3); }

struct Unit { int pm, pn; };
struct Gemm { const bf16_t* A; const bf16_t* Bt; int M, N, K, lda, ldb; };

struct StaticOrder {
    int nM, nN, nwg, G, c;
    __host__ __device__ void init(int M, int N, int G_, int c_) { nM = M / BM; nN = N / BM; nwg = nM * nN; G = G_; c = c_; }
    __host__ __device__ bool next(int i, Unit& u) const {
        const long L = (long)i * G + c; if (L >= nwg) return false;
        int wgid = (int)L; { const int q = nwg / NXCD, r = nwg % NXCD, xcd = wgid % NXCD, off = wgid / NXCD; wgid = (xcd < r ? xcd * (q + 1) : r * (q + 1) + (xcd - r) * q) + off; }
        const int nig = WGM * nN, gid = wgid / nig, fm = gid * WGM, gsz = (nM - fm) < WGM ? (nM - fm) : WGM;
        u.pm = fm + ((wgid % nig) % gsz); u.pn = (wgid % nig) / gsz; return true;
    }
    __device__ __forceinline__ void a_ready(const Unit&) const {}
    __device__ __forceinline__ void done(const Unit&) const {}
};


typedef __bf16 bf16x2_t __attribute__((ext_vector_type(2)));
typedef float f32x2_t __attribute__((ext_vector_type(2)));
typedef unsigned u32x2 __attribute__((ext_vector_type(2)));
__device__ __forceinline__ unsigned cvtpk(float lo, float hi) { f32x2_t v = {lo, hi}; bf16x2_t b = __builtin_convertvector(v, bf16x2_t); return __builtin_bit_cast(unsigned, b); }
__device__ __forceinline__ float bflo(unsigned w) { return __uint_as_float(w << 16); }
__device__ __forceinline__ float bfhi(unsigned w) { return __uint_as_float(w & 0xffff0000u); }
__device__ __forceinline__ float bf2f(bf16_t h) { return __uint_as_float(((unsigned)h) << 16); }
__device__ __forceinline__ float fsigmoid(float z) { return __builtin_amdgcn_rcpf(1.0f + __builtin_amdgcn_exp2f(-1.4426950408889634f * z)); }
__device__ __forceinline__ float fexp(float z) { return __builtin_amdgcn_exp2f(1.4426950408889634f * z); }
__device__ __forceinline__ float act_apply(float x, int mode) {
    if (mode == 1) { const float z = 1.5957691216057308f * (x + 0.044715f * x * x * x); return x * fsigmoid(z); }
    if (mode == 2) return x * 0.08838834764831845f;
    if (mode == 3) return x * fsigmoid(x);
    if (mode == 4) return fsigmoid(x);
    return x;
}
__device__ __forceinline__ int row_batch(int row) { return row < MP ? (row >> 11) : 8 + ((row - MP) >> 2); }

struct EpiWin {
    static constexpr bool PERM = true, AFTER_DRAIN = false;
    bf16_t* U;
    __device__ __forceinline__ void operator()(const f32x4 (&acc)[2][2][4][2], const Unit& u, int wr, int wc, int fr, int fq) const {
        const int row0 = u.pm * BM + wr * 64 + fr, colt = u.pn * BM;
        int mode = 0;
        if (colt >= G0 && colt < Q0) mode = 1; else if (colt >= Q0 && colt < K0) mode = 2; else if (colt >= R0 && colt < GA0) mode = 3; else if (colt >= GA0 && colt < LR0) mode = 4;
        const int col0 = colt + wc * 32 + 8 * fq;
#pragma unroll
        for (int ai = 0; ai < 2; ++ai)
#pragma unroll
            for (int m = 0; m < 4; ++m) { bf16_t* rowp = U + (size_t)(row0 + ai * HALF + m * 16) * NINP + col0;
#pragma unroll
                for (int bj = 0; bj < 2; ++bj) { f32x4 v0 = acc[ai][bj][m][0], v1 = acc[ai][bj][m][1];
#pragma unroll
                    for (int e = 0; e < 4; ++e) { v0[e] = act_apply(v0[e], mode); v1[e] = act_apply(v1[e], mode); }
                    u32x4 w; w.x = cvtpk(v0[0], v0[1]); w.y = cvtpk(v0[2], v0[3]); w.z = cvtpk(v1[0], v1[1]); w.w = cvtpk(v1[2], v1[3]);
                    *(u32x4*)(rowp + bj * HALF) = w; }
                __builtin_amdgcn_sched_barrier(0); }
    }
};
struct EpiProj {
    static constexpr bool PERM = true, AFTER_DRAIN = false;
    const bf16_t* U; float* P; bf16_t* Mo; int second;
    __device__ __forceinline__ void operator()(const f32x4 (&acc)[2][2][4][2], const Unit& u, int wr, int wc, int fr, int fq) const {
        const int row0 = u.pm * BM + wr * 64 + fr, col0 = u.pn * BM + wc * 32 + 8 * fq; const int goff = second ? GB0 : GA0;
        u32x4 gwb[2][2]; f32x4 ppb[2][2][2];
#define PRJ_LOAD(it_, s_) do { const int row_ = row0 + ((it_) >> 2) * HALF + ((it_) & 3) * 16; \
            _Pragma("unroll") for (int bj = 0; bj < 2; ++bj) { const int col_ = col0 + bj * HALF; gwb[s_][bj] = *(const u32x4*)(U + (size_t)row_ * NINP + goff + col_); \
                if (second) { const float* pp_ = P + (size_t)row_ * D + col_; ppb[s_][bj][0] = *(const f32x4*)pp_; ppb[s_][bj][1] = *(const f32x4*)(pp_ + 4); } } } while (0)
        PRJ_LOAD(0, 0);
#pragma unroll
        for (int it = 0; it < 8; ++it) { const int ai = it >> 2, m = it & 3, s = it & 1; const int row = row0 + ai * HALF + m * 16;
            if (it + 1 < 8) PRJ_LOAD(it + 1, (it + 1) & 1);
#pragma unroll
            for (int bj = 0; bj < 2; ++bj) { const int col = col0 + bj * HALF; const u32x4 gw = gwb[s][bj];
                f32x4 g0 = {bflo(gw.x), bfhi(gw.x), bflo(gw.y), bfhi(gw.y)}, g1 = {bflo(gw.z), bfhi(gw.z), bflo(gw.w), bfhi(gw.w)};
                f32x4 v0 = acc[ai][bj][m][0] * g0, v1 = acc[ai][bj][m][1] * g1;
                float* pp = P + (size_t)row * D + col;
                if (!second) { *(f32x4*)pp = v0; *(f32x4*)(pp + 4) = v1; }
                else { v0 += ppb[s][bj][0]; v1 += ppb[s][bj][1];
                    u32x4 w; w.x = cvtpk(v0[0], v0[1]); w.y = cvtpk(v0[2], v0[3]); w.z = cvtpk(v1[0], v1[1]); w.w = cvtpk(v1[2], v1[3]);
                    *(u32x4*)(Mo + (size_t)row * D + col) = w; } }
            __builtin_amdgcn_sched_barrier(0); }
#undef PRJ_LOAD
    }
};
struct EpiRes {
    static constexpr bool PERM = false, AFTER_DRAIN = false;
    const float* base_p; const float* base_s; float* out; const float* gate; int dry;
    __device__ __forceinline__ void operator()(const f32x4 (&acc)[2][2][4][2], const Unit& u, int wr, int wc, int fr, int fq) const {
        const int row0 = u.pm * BM + wr * 64 + fr, col0 = u.pn * BM + wc * 32 + 4 * fq;
        f32x4 bb[2][4], gg[2][4];
#define RES_LOAD(it_, s_) do { const int row_ = row0 + ((it_) >> 2) * HALF + ((it_) & 3) * 16; const float* bp_ = row_ < MP ? base_p + (size_t)row_ * D : base_s + (size_t)(row_ - MP) * D; \
            const float* gp_ = gate + (size_t)row_batch(row_) * NMOD; \
            _Pragma("unroll") for (int q = 0; q < 4; ++q) { const int col_ = col0 + (q >> 1) * HALF + (q & 1) * 16; bb[s_][q] = *(const f32x4*)(bp_ + col_); gg[s_][q] = *(const f32x4*)(gp_ + col_); } } while (0)
        RES_LOAD(0, 0);
#pragma unroll
        for (int it = 0; it < 8; ++it) { const int ai = it >> 2, m = it & 3, s = it & 1;
            if (it + 1 < 8) RES_LOAD(it + 1, (it + 1) & 1);
            float* op = out + (size_t)(row0 + ai * HALF + m * 16) * D;
#pragma unroll
            for (int q = 0; q < 4; ++q) { const int bj = q >> 1, n = q & 1, col = col0 + bj * HALF + n * 16;
                const f32x4 rr = bb[s][q] + gg[s][q] * acc[ai][bj][m][n]; if (!dry || rr.x == 1.2345e30f) *(f32x4*)(op + col) = rr; }
            __builtin_amdgcn_sched_barrier(0); }
#undef RES_LOAD
    }
};
struct EpiSwiglu {
    static constexpr bool PERM = true, AFTER_DRAIN = false;
    bf16_t* O;
    __device__ __forceinline__ void operator()(const f32x4 (&acc)[2][2][4][2], const Unit& u, int wr, int wc, int fr, int fq) const {
        const int row0 = u.pm * BM + wr * 64 + fr, col0 = u.pn * HALF + wc * 32 + 8 * fq;
#pragma unroll
        for (int ai = 0; ai < 2; ++ai)
#pragma unroll
            for (int m = 0; m < 4; ++m) { f32x4 v0, v1;
#pragma unroll
                for (int e = 0; e < 4; ++e) { const float a0 = acc[ai][0][m][0][e], a1 = acc[ai][0][m][1][e]; v0[e] = a0 * fsigmoid(a0) * acc[ai][1][m][0][e]; v1[e] = a1 * fsigmoid(a1) * acc[ai][1][m][1][e]; }
                u32x4 w; w.x = cvtpk(v0[0], v0[1]); w.y = cvtpk(v0[2], v0[3]); w.z = cvtpk(v1[0], v1[1]); w.w = cvtpk(v1[2], v1[3]);
                *(u32x4*)(O + (size_t)(row0 + ai * HALF + m * 16) * DFF + col0) = w;
                __builtin_amdgcn_sched_barrier(0); }
    }
};
struct EpiMod {
    static constexpr bool PERM = false, AFTER_DRAIN = false;
    float* out; const float* bias;
    __device__ __forceinline__ void operator()(const f32x4 (&acc)[2][2][4][2], const Unit& u, int wr, int wc, int fr, int fq) const {
        const int row0 = u.pm * BM + wr * 64 + fr, col0 = u.pn * BM + wc * 32 + 4 * fq;
#pragma unroll
        for (int ai = 0; ai < 2; ++ai)
#pragma unroll
            for (int m = 0; m < 4; ++m) { const int row = row0 + ai * HALF + m * 16; if (row < NB) {
#pragma unroll
                for (int bj = 0; bj < 2; ++bj)
#pragma unroll
                    for (int n = 0; n < 2; ++n) { const int col = col0 + bj * HALF + n * 16;
                        *(f32x4*)(out + (size_t)row * NMOD + col) = acc[ai][bj][m][n] + *(const f32x4*)(bias + col); } } }
    }
};

template <class Epi, class Sched, bool ALIGN_EPI = false, bool SP2 = false>
__device__ __forceinline__ void gemm_phase(PG8_LAS unsigned char* lds, const Gemm g, const Sched& S, const Epi& E) {
    int tid_ = threadIdx.x; asm volatile("" : "+v"(tid_));
    const int tid = tid_, wid = __builtin_amdgcn_readfirstlane(tid >> 6), lane = tid & 63, wr = wid >> 2, wc = wid & 3, fr = lane & 15, fq = lane >> 4;
    const int K = g.K, nt = K / BK;
    unsigned voffA[2], voffB[2];
#pragma unroll
    for (int i = 0; i < 2; ++i) { int R, C; stage_rc(tid * 16 + i * 8192, R, C); const int Rb = Epi::PERM ? ((R & ~31) + perm32(R & 31)) : R;
        voffA[i] = (unsigned)(R * g.lda + C) * 2u; voffB[i] = (unsigned)(Rb * g.ldb + C) * 2u; }
    const size_t kstep = (size_t)(BK * 2);
    const size_t hstepA = (size_t)HALF * g.lda * 2, hstepB = (size_t)HALF * g.ldb * 2;
    const size_t tstepA = 2 * hstepA, tstepB = 2 * hstepB;
    const unsigned ldsw = (unsigned)wid * 1024u;
    const int aoff = lds_byte(wr * 64 + fr, fq * 8), boff = lds_byte(wc * 32 + fr, fq * 8);
#define PG8_SA(b, h) (((b) * 2 + (h)) * HTB)
#define PG8_SB(b, h) ((4 + (b) * 2 + (h)) * HTB)
#define PG8_STAGE(bufoff, gbase, voff) do { _Pragma("unroll") for (int _i = 0; _i < 2; ++_i) \
        __builtin_amdgcn_global_load_lds((const unsigned*)((const char*)(gbase) + (voff)[_i]), (PG8_LAS unsigned*)(lds + (bufoff) + ldsw + _i * 8192), 16, 0, 0); } while (0)
#define PG8_LDA(dst, b, h) do { _Pragma("unroll") for (int m = 0; m < 4; ++m) _Pragma("unroll") for (int k = 0; k < 2; ++k) dst[m][k] = *(const PG8_LAS bf16x8*)(lds + PG8_SA(b, h) + aoff + m * 2048 + k * 1024); } while (0)
#define PG8_LDB(dst, b, h) do { _Pragma("unroll") for (int n = 0; n < 2; ++n) _Pragma("unroll") for (int k = 0; k < 2; ++k) dst[n][k] = *(const PG8_LAS bf16x8*)(lds + PG8_SB(b, h) + boff + n * 2048 + k * 1024); } while (0)
#define PG8_MMA(ai, bj, At, Bt) do { __builtin_amdgcn_s_setprio(1); _Pragma("unroll") for (int m = 0; m < 4; ++m) _Pragma("unroll") for (int n = 0; n < 2; ++n) _Pragma("unroll") for (int k = 0; k < 2; ++k) \
        acc[ai][bj][m][n] = __builtin_amdgcn_mfma_f32_16x16x32_bf16(Bt[n][k], At[m][k], acc[ai][bj][m][n], 0, 0, 0); __builtin_amdgcn_s_setprio(0); } while (0)
#define PG8_WAIT_V(n) asm volatile("s_waitcnt vmcnt(" #n ")" ::: "memory")
#define PG8_WAIT_L(n) asm volatile("s_waitcnt lgkmcnt(" #n ")" ::: "memory")
#define PG8_BAR __builtin_amdgcn_s_barrier()
#define PG8_SCHED __builtin_amdgcn_sched_barrier(0)
    Unit cur, nxt; int ui = 0;
    if (!S.next(0, cur)) return;
    f32x4 acc[2][2][4][2];
#pragma unroll
    for (int a = 0; a < 2; ++a)
#pragma unroll
        for (int b = 0; b < 2; ++b)
#pragma unroll
            for (int m = 0; m < 4; ++m)
#pragma unroll
                for (int n = 0; n < 2; ++n) acc[a][b][m][n] = (f32x4){0.f, 0.f, 0.f, 0.f};
    bf16x8 At[4][2], B0[2][2], B1[2][2];
    const char* cA = (const char*)g.A + (size_t)cur.pm * tstepA; const char* cB = (const char*)g.Bt + (size_t)cur.pn * tstepB;
    S.a_ready(cur);
    if constexpr (SP2) {
        PG8_STAGE(PG8_SB(0, 0), cB, voffB); PG8_STAGE(PG8_SB(0, 1), cB + hstepB, voffB); PG8_STAGE(PG8_SA(0, 0), cA, voffA); PG8_STAGE(PG8_SA(0, 1), cA + hstepA, voffA);
        if (wr == 1) PG8_BAR;
        PG8_WAIT_V(2); PG8_BAR;
        PG8_STAGE(PG8_SB(1, 0), cB + kstep, voffB); PG8_STAGE(PG8_SA(1, 0), cA + kstep, voffA); PG8_STAGE(PG8_SB(1, 1), cB + hstepB + kstep, voffB);
        PG8_WAIT_V(6); PG8_BAR;
    } else {
        PG8_STAGE(PG8_SB(0, 0), cB, voffB); PG8_STAGE(PG8_SA(0, 0), cA, voffA); PG8_STAGE(PG8_SB(0, 1), cB + hstepB, voffB); PG8_STAGE(PG8_SA(0, 1), cA + hstepA, voffA);
        if (wr == 1) PG8_BAR;
        PG8_WAIT_V(4); PG8_BAR;
        PG8_STAGE(PG8_SB(1, 0), cB + kstep, voffB); PG8_STAGE(PG8_SA(1, 0), cA + kstep, voffA); PG8_STAGE(PG8_SB(1, 1), cB + hstepB + kstep, voffB);
        PG8_WAIT_V(6); PG8_BAR;
    }
    for (;;) {
        const bool has_next = S.next(ui + 1, nxt);
        const char* nA = has_next ? (const char*)g.A + (size_t)nxt.pm * tstepA : cA; const char* nB = has_next ? (const char*)g.Bt + (size_t)nxt.pn * tstepB : cB;
        for (int t = 0; t < nt; t += 2) {
            const bool last = (t == nt - 2);
            const char* a1 = cA + (size_t)(t + 1) * kstep;
            const char* a2 = last ? nA : cA + (size_t)(t + 2) * kstep; const char* b2 = last ? nB : cB + (size_t)(t + 2) * kstep;
            const char* a3 = a2 + kstep; const char* b3 = b2 + kstep;
            if (last && has_next) S.a_ready(nxt);
            if constexpr (SP2) {
            PG8_LDB(B0, 0, 0); PG8_LDB(B1, 0, 1); PG8_SCHED; PG8_LDA(At, 0, 0); PG8_STAGE(PG8_SA(1, 1), a1 + hstepA, voffA);
            PG8_WAIT_V(8); PG8_WAIT_L(0); PG8_BAR; PG8_MMA(0, 0, At, B0); PG8_MMA(0, 1, At, B1); PG8_BAR; PG8_SCHED;
            PG8_LDA(At, 0, 1); PG8_STAGE(PG8_SB(0, 0), b2, voffB); PG8_STAGE(PG8_SB(0, 1), b2 + hstepB, voffB); PG8_STAGE(PG8_SA(0, 0), a2, voffA);
            PG8_WAIT_V(8); PG8_WAIT_L(0); PG8_BAR; PG8_MMA(1, 0, At, B0); PG8_MMA(1, 1, At, B1); PG8_BAR; PG8_SCHED;
            PG8_LDB(B0, 1, 0); PG8_LDB(B1, 1, 1); PG8_SCHED; PG8_LDA(At, 1, 0); PG8_STAGE(PG8_SA(0, 1), a2 + hstepA, voffA);
            PG8_WAIT_V(8); PG8_WAIT_L(0); PG8_BAR; PG8_MMA(0, 0, At, B0); PG8_MMA(0, 1, At, B1); PG8_BAR; PG8_SCHED;
            PG8_LDA(At, 1, 1); PG8_STAGE(PG8_SB(1, 0), b3, voffB); PG8_STAGE(PG8_SB(1, 1), b3 + hstepB, voffB); PG8_STAGE(PG8_SA(1, 0), a3, voffA);
            PG8_WAIT_V(8); PG8_WAIT_L(0); PG8_BAR; PG8_MMA(1, 0, At, B0); PG8_MMA(1, 1, At, B1); PG8_BAR; PG8_SCHED;
            } else {
            PG8_LDB(B0, 0, 0); PG8_SCHED; PG8_LDA(At, 0, 0); PG8_STAGE(PG8_SA(1, 1), a1 + hstepA, voffA);
            PG8_WAIT_L(8); PG8_BAR; PG8_WAIT_L(0); PG8_MMA(0, 0, At, B0); PG8_BAR; PG8_SCHED;
            PG8_LDB(B1, 0, 1); PG8_STAGE(PG8_SB(0, 0), b2, voffB);
            PG8_BAR; PG8_WAIT_L(0); PG8_MMA(0, 1, At, B1); PG8_BAR;
            PG8_LDA(At, 0, 1); PG8_STAGE(PG8_SA(0, 0), a2, voffA);
            PG8_BAR; PG8_WAIT_L(0); PG8_MMA(1, 0, At, B0); PG8_BAR; PG8_SCHED;
            PG8_STAGE(PG8_SB(0, 1), b2 + hstepB, voffB);
            PG8_WAIT_V(6); PG8_BAR; PG8_MMA(1, 1, At, B1); PG8_BAR;
            PG8_LDB(B0, 1, 0); PG8_SCHED; PG8_LDA(At, 1, 0); PG8_STAGE(PG8_SA(0, 1), a2 + hstepA, voffA);
            PG8_WAIT_L(8); PG8_BAR; PG8_WAIT_L(0); PG8_MMA(0, 0, At, B0); PG8_BAR; PG8_SCHED;
            PG8_LDB(B1, 1, 1); PG8_STAGE(PG8_SB(1, 0), b3, voffB);
            PG8_BAR; PG8_WAIT_L(0); PG8_MMA(0, 1, At, B1); PG8_BAR;
            PG8_LDA(At, 1, 1); PG8_STAGE(PG8_SA(1, 0), a3, voffA);
            PG8_BAR; PG8_WAIT_L(0); PG8_MMA(1, 0, At, B0); PG8_BAR; PG8_SCHED;
            PG8_STAGE(PG8_SB(1, 1), b3 + hstepB, voffB);
            PG8_WAIT_V(6); PG8_BAR; PG8_MMA(1, 1, At, B1); PG8_BAR;
            }
        }
        if constexpr (ALIGN_EPI) { if (wr == 0) PG8_BAR; }
        if constexpr (!Epi::AFTER_DRAIN) { E(acc, cur, wr, wc, fr, fq); S.done(cur); }
        if (!has_next) break;
#pragma unroll
        for (int a = 0; a < 2; ++a)
#pragma unroll
            for (int b = 0; b < 2; ++b)
#pragma unroll
                for (int m = 0; m < 4; ++m)
#pragma unroll
                    for (int n = 0; n < 2; ++n) acc[a][b][m][n] = (f32x4){0.f, 0.f, 0.f, 0.f};
        cur = nxt; cA = nA; cB = nB; ++ui;
        if constexpr (ALIGN_EPI) { if (wr == 1) PG8_BAR; }
    }
    PG8_WAIT_V(0);
    if constexpr (!ALIGN_EPI) { if (wr == 0) PG8_BAR; }
    PG8_BAR;
    if constexpr (Epi::AFTER_DRAIN) { E.fused(acc, cur, wr, wc, fr, fq, lds, wid, lane); S.done(cur); }
#undef PG8_SA
#undef PG8_SB
#undef PG8_STAGE
#undef PG8_LDA
#undef PG8_LDB
#undef PG8_MMA
#undef PG8_WAIT_V
#undef PG8_WAIT_L
#undef PG8_BAR
#undef PG8_SCHED
}
}

#define LAS __attribute__((address_space(3)))
typedef unsigned short bf16;
typedef float f32x4 __attribute__((ext_vector_type(4)));
typedef short bf16x8 __attribute__((ext_vector_type(8)));
typedef short bf16x4 __attribute__((ext_vector_type(4)));
typedef unsigned u32x4 __attribute__((ext_vector_type(4)));
typedef unsigned u32x2 __attribute__((ext_vector_type(2)));
using pg8::cvtpk; using pg8::bflo; using pg8::bfhi; using pg8::bf2f; using pg8::fsigmoid; using pg8::fexp; using pg8::row_batch;
constexpr int NWAVES = 8, NTHR = 512, LDS_BYTES = 147456;
constexpr size_t MiB = 1u << 20;
constexpr size_t WS_BAR = 0;
constexpr size_t WS_WIN = 1 * MiB;
constexpr size_t SZ_WIN = (size_t)NINP * D * 2;
constexpr size_t WS_WPJ = WS_WIN + 2 * SZ_WIN;
constexpr size_t SZ_WPJ = (size_t)D * (DR + DVT) * 2;
constexpr size_t WS_WOUT = WS_WPJ + 2 * SZ_WPJ;
constexpr size_t SZ_WOUT = (size_t)D * D * 2;
constexpr size_t WS_W1 = WS_WOUT + 2 * SZ_WOUT;
constexpr size_t SZ_W1 = (size_t)2 * DFF * D * 2;
constexpr size_t WS_W2 = WS_W1 + 2 * SZ_W1;
constexpr size_t SZ_W2 = (size_t)D * DFF * 2;
constexpr size_t WS_ADA = WS_W2 + 2 * SZ_W2;
constexpr size_t SZ_ADA = (size_t)NMOD * D * 2;
constexpr size_t WS_WG = WS_ADA + 2 * SZ_ADA;
constexpr size_t SZ_WG = (size_t)10 * 256 * 128 * 2;
constexpr size_t WS_CS = WS_WG + 2 * SZ_WG;
constexpr size_t WS_MOD = WS_CS + (size_t)256 * D * 2;
constexpr size_t SZ_MOD = (size_t)NB * NMOD * 4;
constexpr size_t WS_HN = ((WS_MOD + 2 * SZ_MOD + MiB - 1) / MiB) * MiB;
constexpr size_t WS_U = WS_HN + (size_t)M * D * 2;
constexpr size_t WS_P = WS_U + (size_t)M * NINP * 2;
constexpr size_t WS_END = WS_P + (size_t)M * D * 4;
constexpr size_t WS_KD = WS_P;
constexpr size_t WS_EL = WS_P + 32 * MiB;
static_assert(WS_KD + (size_t)1536 * 16384 <= WS_EL && WS_EL + (size_t)1536 * 512 <= WS_END, "KD/EL overlay P");

struct Args {
    const float* in[28]; float* out; unsigned char* ws; int ph_lo, ph_hi;
};
constexpr size_t O_Y = 0, O_CONVP = (size_t)M * D, O_LRUP = O_CONVP + 2 * 8 * 3 * DR, O_GLAP = O_LRUP + 2 * 8 * DR, O_CONVS = O_GLAP + (size_t)2 * 8 * 4 * 128 * 256,
                 O_LRUS = O_CONVS + (size_t)2 * 128 * 3 * DR, O_GLAS = O_LRUS + (size_t)2 * 128 * DR, O_END = O_GLAS + (size_t)2 * 128 * 4 * 128 * 256;

__device__ __forceinline__ float bperm(int srclane, float v) { return __int_as_float(__builtin_amdgcn_ds_bpermute(srclane << 2, __float_as_int(v))); }
__device__ __forceinline__ float wave_sum(float v, int lane) {
#pragma unroll
    for (int o = 1; o < 64; o <<= 1) v += bperm(lane ^ o, v);
    return v;
}
__device__ __forceinline__ int src_col(int np, int mapmode) {
    if (mapmode == 1) { if (np < GA0) return np; if (np < LR0) return np + 16; if (np < LR0 + 16) return np - LR0 + 5632; return -1; }
    if (mapmode == 2) { const int pn = np >> 8, bj = (np >> 7) & 1, j = np & 127; return bj * DFF + pn * 128 + j; }
    return np;
}
__device__ __forceinline__ void transpose_item(const float* W, int K, int N, bf16* WT, int ldt, int koff, int nblk, int mapmode, LAS float* scr, int item, int lane) {
    const int kb = item / nblk, nb = item % nblk, k0 = 64 * kb, n0 = 32 * nb;
    const int sc = src_col(n0 + (lane & 31), mapmode);
    float v[32];
#pragma unroll
    for (int i = 0; i < 32; ++i) { const int kk = 2 * i + (lane >> 5); v[i] = sc >= 0 ? W[(size_t)(k0 + kk) * N + sc] : 0.f; }
#pragma unroll
    for (int i = 0; i < 32; ++i) { const int kk = 2 * i + (lane >> 5); scr[kk * 33 + (lane & 31)] = v[i]; }
    asm volatile("s_waitcnt lgkmcnt(0)" ::: "memory");
    const int c = lane & 7;
#pragma unroll
    for (int j = 0; j < 4; ++j) { const int n = (lane >> 3) + 8 * j; const LAS float* s = scr + (8 * c) * 33 + n;
        u32x4 o; o.x = cvtpk(s[0 * 33], s[1 * 33]); o.y = cvtpk(s[2 * 33], s[3 * 33]); o.z = cvtpk(s[4 * 33], s[5 * 33]); o.w = cvtpk(s[6 * 33], s[7 * 33]);
        *(u32x4*)(WT + (size_t)(n0 + n) * ldt + koff + k0 + 8 * c) = o; }
    asm volatile("s_waitcnt lgkmcnt(0)" ::: "memory");
}
__device__ __forceinline__ void norm_row(const float* xrow, const float* g, const float* sc, const float* sh, bf16* orow, float* orow_f, int lane) {
    const f32x4* xr = (const f32x4*)xrow + lane; f32x4 v[4]; float s = 0.f;
#pragma unroll
    for (int j = 0; j < 4; ++j) { v[j] = xr[64 * j]; s += (v[j].x * v[j].x + v[j].y * v[j].y) + (v[j].z * v[j].z + v[j].w * v[j].w); }
    const float rstd = 1.0f / sqrtf(wave_sum(s, lane) * (1.0f / D) + EPS);
#pragma unroll
    for (int j = 0; j < 4; ++j) { const int col = 4 * lane + 256 * j; const f32x4 gg = *(const f32x4*)(g + col);
        f32x4 o = v[j] * rstd * gg;
        if (orow_f) { *(f32x4*)(orow_f + col) = o; }
        else { const f32x4 a = *(const f32x4*)(sc + col), b = *(const f32x4*)(sh + col); o = o * (a + 1.0f) + b;
            u32x2 w; w.x = cvtpk(o.x, o.y); w.y = cvtpk(o.z, o.w); *(u32x2*)(orow + col) = w; } }
}

struct ScanP { int l; };
typedef const float* fptr_t;
__device__ __forceinline__ fptr_t inp(int i) {
    const __attribute__((address_space(4))) unsigned char* kp = (const __attribute__((address_space(4))) unsigned char*)__builtin_amdgcn_kernarg_segment_ptr();
    asm volatile("" : "+s"(kp));
    return *(const __attribute__((address_space(4))) fptr_t*)(kp + 8 * i);
}
#define WSP ((unsigned char*)inp(29))
#define OUTP ((float*)inp(28))
__device__ __forceinline__ bf16 f2bf1(float x) { return (bf16)(cvtpk(x, 0.f) & 0xffffu); }
#define MFMA16(a, b, c) __builtin_amdgcn_mfma_f32_16x16x32_bf16((a), (b), (c), 0, 0, 0)
#define LDS_BARRIER() do { asm volatile("s_waitcnt lgkmcnt(0)" ::: "memory"); __builtin_amdgcn_s_barrier(); asm volatile("" ::: "memory"); } while (0)

template <bool SAMPLE>
__device__ __forceinline__ void lru_item(LAS unsigned char* lds, const ScanP& P, int item, int dry = 0) {
    int tid_ = threadIdx.x; asm volatile("" : "+v"(tid_));
    const int tid = tid_, lane = tid & 63, w = __builtin_amdgcn_readfirstlane(tid >> 6), fr = lane & 15, fq = lane >> 4;
    const int n = item % 10, bb = item / 10;
    const int row0 = SAMPLE ? MP + bb * 64 : bb * SEQ;
    const int nch = SAMPLE ? 1 : SEQ / 64;
    LAS bf16* XC = (LAS bf16*)lds;
    const int l = P.l; bf16* const U = (bf16*)(WSP + WS_U);
    const bf16* wg = (const bf16*)(WSP + WS_WG + l * SZ_WG) + (size_t)n * 256 * 128;
    bf16x8 Bw[2][4];
#pragma unroll
    for (int nt = 0; nt < 2; ++nt)
#pragma unroll
        for (int ks = 0; ks < 4; ++ks) Bw[nt][ks] = *(const bf16x8*)(wg + (size_t)(nt * 128 + 16 * w + fr) * 128 + 32 * ks + 8 * fq);
    const int ch = n * 128 + 16 * w + fr;
    const float ba = (inp(15) + (size_t)l * DR)[ch], bx = (inp(17) + (size_t)l * DR)[ch], lam = (inp(18) + (size_t)l * DR)[ch];
    const float cl = -8.0f * log1pf(expf(-lam));
    const int cg = tid & 15, tt = tid >> 4, cch = n * 128 + 8 * cg;
    float cw[4][8], cb[8];
#pragma unroll
    for (int i = 0; i < 4; ++i)
#pragma unroll
        for (int j = 0; j < 8; ++j) cw[i][j] = (inp(12) + (size_t)l * 4 * DR)[i * DR + cch + j];
#pragma unroll
    for (int j = 0; j < 8; ++j) cb[j] = (inp(13) + (size_t)l * DR)[cch + j];
    const float* const st_conv = SAMPLE ? inp(4) + (size_t)l * 128 * 3 * DR : nullptr; const float* const st_lru = SAMPLE ? inp(5) + (size_t)l * 128 * DR : nullptr;
    float* const o_lru_s = OUTP + O_LRUS + (size_t)l * 128 * DR;
    float hc = 0.f;
    u32x4 uq[2][4];
#define LRU_LOADC(c_) do { _Pragma("unroll") for (int p = 0; p < 2; ++p) _Pragma("unroll") for (int d = 0; d < 4; ++d) { const int tl_ = tt + 32 * p; const u32x4 z4 = {0u, 0u, 0u, 0u}; uq[p][d] = z4; \
        if ((c_) * 64 + tl_ - d >= 0) uq[p][d] = *(const u32x4*)(U + (size_t)(row0 + (c_) * 64 + tl_ - d) * NINP + X0 + cch); } } while (0)
    if (!SAMPLE) LRU_LOADC(0);
    for (int c = 0; c < nch; ++c) {
        const int r0 = row0 + c * 64;
#pragma unroll
        for (int p = 0; p < 2; ++p) {
            const int tl = tt + 32 * p; float xc[8];
#pragma unroll
            for (int j = 0; j < 8; ++j) xc[j] = cb[j];
#pragma unroll
            for (int d = 0; d < 4; ++d) {
                float uv[8];
                bool from_u, zero = false;
                if (!SAMPLE) { from_u = (c * 64 + tl - d) >= 0; zero = !from_u; } else { from_u = ((tl & 3) - d) >= 0; }
                if (!SAMPLE) { const u32x4 q = uq[p][d];
                    uv[0] = bflo(q.x); uv[1] = bfhi(q.x); uv[2] = bflo(q.y); uv[3] = bfhi(q.y); uv[4] = bflo(q.z); uv[5] = bfhi(q.z); uv[6] = bflo(q.w); uv[7] = bfhi(q.w); }
                else if (from_u) { const u32x4 q = *(const u32x4*)(U + (size_t)(r0 + tl - d) * NINP + X0 + cch);
                    uv[0] = bflo(q.x); uv[1] = bfhi(q.x); uv[2] = bflo(q.y); uv[3] = bfhi(q.y); uv[4] = bflo(q.z); uv[5] = bfhi(q.z); uv[6] = bflo(q.w); uv[7] = bfhi(q.w); }
                else if (zero) {
#pragma unroll
                    for (int j = 0; j < 8; ++j) uv[j] = 0.f; }
                else { const int b = bb * 16 + (tl >> 2); const float* sp = st_conv + ((size_t)b * 3 + (3 + (tl & 3) - d)) * DR + cch;
                    const f32x4 s0 = *(const f32x4*)sp, s1 = *(const f32x4*)(sp + 4);
                    uv[0] = s0.x; uv[1] = s0.y; uv[2] = s0.z; uv[3] = s0.w; uv[4] = s1.x; uv[5] = s1.y; uv[6] = s1.z; uv[7] = s1.w; }
#pragma unroll
                for (int j = 0; j < 8; ++j) xc[j] += cw[3 - d][j] * uv[j];
            }
            u32x4 o; o.x = cvtpk(xc[0], xc[1]); o.y = cvtpk(xc[2], xc[3]); o.z = cvtpk(xc[4], xc[5]); o.w = cvtpk(xc[6], xc[7]);
            *(LAS u32x4*)(XC + tl * 136 + 8 * cg) = o;
        }
        LDS_BARRIER();
        if (!SAMPLE && c + 1 < nch) LRU_LOADC(c + 1);
        bf16 gv[4][4];
#pragma unroll
        for (int mt = 0; mt < 4; ++mt)
#pragma unroll
            for (int e = 0; e < 4; ++e) gv[mt][e] = U[(size_t)(r0 + 16 * mt + 4 * fq + e) * NINP + G0 + ch];
        f32x4 acc[4][2];
#pragma unroll
        for (int mt = 0; mt < 4; ++mt) { acc[mt][0] = (f32x4){0.f, 0.f, 0.f, 0.f}; acc[mt][1] = (f32x4){0.f, 0.f, 0.f, 0.f};
#pragma unroll
            for (int ks = 0; ks < 4; ++ks) { const bf16x8 a = *(const LAS bf16x8*)(XC + (16 * mt + fr) * 136 + 32 * ks + 8 * fq);
                acc[mt][0] = MFMA16(a, Bw[0][ks], acc[mt][0]); acc[mt][1] = MFMA16(a, Bw[1][ks], acc[mt][1]); } }
#pragma unroll
        for (int mt = 0; mt < 4; ++mt) {
            float Pe[4], Qe[4];
#pragma unroll
            for (int e = 0; e < 4; ++e) { const int tl = 16 * mt + 4 * fq + e;
                const float r = fsigmoid(acc[mt][0][e] + ba), ii = fsigmoid(acc[mt][1][e] + bx), la = cl * r, a = fexp(la), x2 = 2.0f * la;
                const float om = (x2 > -0.1f) ? -x2 * (1.0f + x2 * (0.5f + x2 * (0.16666667f + x2 * 0.041666668f))) : 1.0f - a * a;
                const float xcv = bf2f(XC[tl * 136 + 16 * w + fr]), bv = __builtin_amdgcn_sqrtf(om) * ii * xcv;
                if (e == 0) { Pe[0] = a; Qe[0] = bv; } else { Pe[e] = a * Pe[e - 1]; Qe[e] = a * Qe[e - 1] + bv; } }
            float hin;
            if (!SAMPLE) {
                float Pi = Pe[3], Qi = Qe[3];
                { const float Pp = bperm(lane - 16, Pi), Qp = bperm(lane - 16, Qi); if (fq >= 1) { Qi = Pi * Qp + Qi; Pi = Pi * Pp; } }
                { const float Pp = bperm(lane - 32, Pi), Qp = bperm(lane - 32, Qi); if (fq >= 2) { Qi = Pi * Qp + Qi; Pi = Pi * Pp; } }
                float Px = bperm(lane - 16, Pi), Qx = bperm(lane - 16, Qi); if (fq == 0) { Px = 1.f; Qx = 0.f; }
                hin = Px * hc + Qx;
            } else { hin = st_lru[(size_t)(bb * 16 + 4 * mt + fq) * DR + ch]; }
            float hv[4];
#pragma unroll
            for (int e = 0; e < 4; ++e) hv[e] = Pe[e] * hin + Qe[e];
            if (!SAMPLE) hc = bperm(48 + fr, hv[3]); else if (!dry) o_lru_s[(size_t)(bb * 16 + 4 * mt + fq) * DR + ch] = hv[3];
#pragma unroll
            for (int e = 0; e < 4; ++e) if (!dry || hv[e] == 1.2345e30f) U[(size_t)(r0 + 16 * mt + 4 * fq + e) * NINP + G0 + ch] = f2bf1(hv[e] * bf2f(gv[mt][e]));
        }
        LDS_BARRIER();
    }
#undef LRU_LOADC
    if (dry) return;
    if (!SAMPLE) {
        if (fq == 0) (OUTP + O_LRUP + (size_t)l * 8 * DR)[(size_t)bb * DR + ch] = hc;
        if (tid < 384) { const int j = tid >> 7, cc = tid & 127; (OUTP + O_CONVP + (size_t)l * 8 * 3 * DR)[((size_t)bb * 3 + j) * DR + n * 128 + cc] = bf2f(U[(size_t)(row0 + SEQ - 3 + j) * NINP + X0 + n * 128 + cc]); }
    } else {
        for (int idx = tid; idx < 6144; idx += NTHR) { const int s = idx / 384, rem = idx % 384, j = rem >> 7, cc = rem & 127;
            (OUTP + O_CONVS + (size_t)l * 128 * 3 * DR)[((size_t)(bb * 16 + s) * 3 + j) * DR + n * 128 + cc] = bf2f(U[(size_t)(row0 + 4 * s + 1 + j) * NINP + X0 + n * 128 + cc]); }
    }
}

__device__ __forceinline__ void lru_half_item(LAS unsigned char* lds, int l, int item) {
    int tid_ = threadIdx.x; asm volatile("" : "+v"(tid_));
    const int tid = tid_, lane = tid & 63, w = __builtin_amdgcn_readfirstlane(tid >> 6), fr = lane & 15, fq = lane >> 4, ct = w & 3, rh = w >> 2;
    const int hf = item & 1, n = (item >> 1) % 10, bb = (item >> 1) / 10;
    const int row0 = bb * SEQ; constexpr int nch = SEQ / 64;
    LAS bf16* XC = (LAS bf16*)lds; LAS float* HX = (LAS float*)(lds + 17408); LAS float* HC = (LAS float*)(lds + 17664);
    bf16* const U = (bf16*)(WSP + WS_U);
    const bf16* wg = (const bf16*)(WSP + WS_WG + l * SZ_WG) + (size_t)n * 256 * 128;
    bf16x8 Bw[2][4];
#pragma unroll
    for (int nt = 0; nt < 2; ++nt)
#pragma unroll
        for (int ks = 0; ks < 4; ++ks) Bw[nt][ks] = *(const bf16x8*)(wg + (size_t)(nt * 128 + hf * 64 + 16 * ct + fr) * 128 + 32 * ks + 8 * fq);
    const int chl = hf * 64 + 16 * ct + fr, ch = n * 128 + chl;
    const float ba = (inp(15) + (size_t)l * DR)[ch], bx = (inp(17) + (size_t)l * DR)[ch], lam = (inp(18) + (size_t)l * DR)[ch];
    const float cl = -8.0f * log1pf(expf(-lam));
    const int cg = tid & 15, tt = tid >> 4, cch = n * 128 + 8 * cg;
    float cw[4][8], cb[8];
#pragma unroll
    for (int i = 0; i < 4; ++i)
#pragma unroll
        for (int j = 0; j < 8; ++j) cw[i][j] = (inp(12) + (size_t)l * 4 * DR)[i * DR + cch + j];
#pragma unroll
    for (int j = 0; j < 8; ++j) cb[j] = (inp(13) + (size_t)l * DR)[cch + j];
    if (tid < 64) HC[tid] = 0.f;
    float hlast = 0.f;
    u32x4 uq[2][4];
#define LRU_LOADC(c_) do { _Pragma("unroll") for (int p = 0; p < 2; ++p) _Pragma("unroll") for (int d = 0; d < 4; ++d) { const int tl_ = tt + 32 * p; const u32x4 z4 = {0u, 0u, 0u, 0u}; uq[p][d] = z4; \
        if ((c_) * 64 + tl_ - d >= 0) uq[p][d] = *(const u32x4*)(U + (size_t)(row0 + (c_) * 64 + tl_ - d) * NINP + X0 + cch); } } while (0)
    LRU_LOADC(0);
    for (int c = 0; c < nch; ++c) {
        const int r0 = row0 + c * 64;
#pragma unroll
        for (int p = 0; p < 2; ++p) {
            const int tl = tt + 32 * p; float xc[8];
#pragma unroll
            for (int j = 0; j < 8; ++j) xc[j] = cb[j];
#pragma unroll
            for (int d = 0; d < 4; ++d) { const u32x4 q = uq[p][d];
                const float uv[8] = {bflo(q.x), bfhi(q.x), bflo(q.y), bfhi(q.y), bflo(q.z), bfhi(q.z), bflo(q.w), bfhi(q.w)};
#pragma unroll
                for (int j = 0; j < 8; ++j) xc[j] += cw[3 - d][j] * uv[j]; }
            u32x4 o; o.x = cvtpk(xc[0], xc[1]); o.y = cvtpk(xc[2], xc[3]); o.z = cvtpk(xc[4], xc[5]); o.w = cvtpk(xc[6], xc[7]);
            *(LAS u32x4*)(XC + tl * 136 + 8 * cg) = o;
        }
        LDS_BARRIER();
        if (c + 1 < nch) LRU_LOADC(c + 1);
        bf16 gv[2][4];
#pragma unroll
        for (int mi = 0; mi < 2; ++mi)
#pragma unroll
            for (int e = 0; e < 4; ++e) gv[mi][e] = U[(size_t)(r0 + 32 * rh + 16 * mi + 4 * fq + e) * NINP + G0 + ch];
        bf16x8 af[2][4]; float xcv[2][4];
#pragma unroll
        for (int mi = 0; mi < 2; ++mi)
#pragma unroll
            for (int ks = 0; ks < 4; ++ks) af[mi][ks] = *(const LAS bf16x8*)(XC + (32 * rh + 16 * mi + fr) * 136 + 32 * ks + 8 * fq);
#pragma unroll
        for (int mi = 0; mi < 2; ++mi)
#pragma unroll
            for (int e = 0; e < 4; ++e) xcv[mi][e] = bf2f(XC[(32 * rh + 16 * mi + 4 * fq + e) * 136 + chl]);
        __builtin_amdgcn_sched_barrier(0);
        f32x4 acc[2][2];
#pragma unroll
        for (int mi = 0; mi < 2; ++mi) { acc[mi][0] = (f32x4){0.f, 0.f, 0.f, 0.f}; acc[mi][1] = (f32x4){0.f, 0.f, 0.f, 0.f}; }
#pragma unroll
        for (int ks = 0; ks < 4; ++ks)
#pragma unroll
            for (int mi = 0; mi < 2; ++mi) { acc[mi][0] = MFMA16(af[mi][ks], Bw[0][ks], acc[mi][0]); acc[mi][1] = MFMA16(af[mi][ks], Bw[1][ks], acc[mi][1]); }
        float Pe[2][4], Qe[2][4], Px[2], Qx[2], PT[2], QT[2], Pi[2], Qi[2];
#pragma unroll
        for (int mi = 0; mi < 2; ++mi) {
#pragma unroll
            for (int e = 0; e < 4; ++e) {
                const float r = fsigmoid(acc[mi][0][e] + ba), ii = fsigmoid(acc[mi][1][e] + bx), la = cl * r, a = fexp(la), x2 = 2.0f * la;
                const float om = (x2 > -0.1f) ? -x2 * (1.0f + x2 * (0.5f + x2 * (0.16666667f + x2 * 0.041666668f))) : 1.0f - a * a;
                const float bv = __builtin_amdgcn_sqrtf(om) * ii * xcv[mi][e];
                if (e == 0) { Pe[mi][0] = a; Qe[mi][0] = bv; } else { Pe[mi][e] = a * Pe[mi][e - 1]; Qe[mi][e] = a * Qe[mi][e - 1] + bv; } }
            Pi[mi] = Pe[mi][3]; Qi[mi] = Qe[mi][3]; }
        { float Pp[2], Qp[2];
#pragma unroll
          for (int mi = 0; mi < 2; ++mi) { Pp[mi] = bperm(lane - 16, Pi[mi]); Qp[mi] = bperm(lane - 16, Qi[mi]); }
#pragma unroll
          for (int mi = 0; mi < 2; ++mi) if (fq >= 1) { Qi[mi] = Pi[mi] * Qp[mi] + Qi[mi]; Pi[mi] = Pi[mi] * Pp[mi]; }
#pragma unroll
          for (int mi = 0; mi < 2; ++mi) { Pp[mi] = bperm(lane - 32, Pi[mi]); Qp[mi] = bperm(lane - 32, Qi[mi]); }
#pragma unroll
          for (int mi = 0; mi < 2; ++mi) if (fq >= 2) { Qi[mi] = Pi[mi] * Qp[mi] + Qi[mi]; Pi[mi] = Pi[mi] * Pp[mi]; }
#pragma unroll
          for (int mi = 0; mi < 2; ++mi) { Px[mi] = bperm(lane - 16, Pi[mi]); Qx[mi] = bperm(lane - 16, Qi[mi]); PT[mi] = bperm(48 + fr, Pi[mi]); QT[mi] = bperm(48 + fr, Qi[mi]); }
#pragma unroll
          for (int mi = 0; mi < 2; ++mi) if (fq == 0) { Px[mi] = 1.f; Qx[mi] = 0.f; } }
        const float P32 = PT[1] * PT[0], Q32 = PT[1] * QT[0] + QT[1];
        float hs = 0.f;
        if (rh == 0) { hs = HC[16 * ct + fr]; if (fq == 0) HX[16 * ct + fr] = P32 * hs + Q32; }
        LDS_BARRIER();
        if (rh == 1) { hs = HX[16 * ct + fr]; hlast = P32 * hs + Q32; if (fq == 0) HC[16 * ct + fr] = hlast; }
        const float hs1 = PT[0] * hs + QT[0];
#pragma unroll
        for (int mi = 0; mi < 2; ++mi) { const float hin = Px[mi] * (mi == 0 ? hs : hs1) + Qx[mi];
#pragma unroll
            for (int e = 0; e < 4; ++e) U[(size_t)(r0 + 32 * rh + 16 * mi + 4 * fq + e) * NINP + G0 + ch] = f2bf1((Pe[mi][e] * hin + Qe[mi][e]) * bf2f(gv[mi][e])); }
    }
#undef LRU_LOADC
    if (rh == 1 && fq == 0) (OUTP + O_LRUP + (size_t)l * 8 * DR)[(size_t)bb * DR + ch] = hlast;
    if (tid < 192) { const int j = tid >> 6, cc = hf * 64 + (tid & 63); (OUTP + O_CONVP + (size_t)l * 8 * 3 * DR)[((size_t)bb * 3 + j) * DR + n * 128 + cc] = bf2f(U[(size_t)(row0 + SEQ - 3 + j) * NINP + X0 + n * 128 + cc]); }
    LDS_BARRIER();
}

__device__ __forceinline__ void gla_prep(LAS unsigned char* lds, int l, int item, int dry = 0) {
    int tid_ = threadIdx.x; asm volatile("" : "+v"(tid_));
    const int tid = tid_;
    LAS float* LRS = (LAS float*)lds; LAS float* TOT = (LAS float*)(lds + 4096);
    const int cidx = item >> 2, h = item & 3;
    const int r0 = cidx < 256 ? (cidx >> 5) * SEQ + (cidx & 31) * 64 : MP + 4 * (cidx - 256), nv = cidx < 256 ? 64 : 4;
    const int c = tid & 127, tg = tid >> 7;
    bf16* const U = (bf16*)(WSP + WS_U);
    float wa2c[16];
#pragma unroll
    for (int r = 0; r < 16; ++r) wa2c[r] = (inp(19) + (size_t)l * 16 * DKT)[r * DKT + h * 128 + c];
    const float gba = (inp(20) + (size_t)l * DKT)[h * 128 + c];
    if (tid < 128) { const int t = tid >> 1, hf = tid & 1; u32x4 a = {0u, 0u, 0u, 0u};
        if (t < nv) a = *(const u32x4*)(U + (size_t)(r0 + t) * NINP + LR0 + 8 * hf);
        const f32x4 l0 = {bflo(a.x), bfhi(a.x), bflo(a.y), bfhi(a.y)}, l1 = {bflo(a.z), bfhi(a.z), bflo(a.w), bfhi(a.w)};
        *(LAS f32x4*)(LRS + t * 16 + 8 * hf) = l0; *(LAS f32x4*)(LRS + t * 16 + 8 * hf + 4) = l1; }
    float qv[16], kv[16];
#pragma unroll
    for (int i = 0; i < 16; ++i) { const int t = 16 * tg + i; qv[i] = 0.f; kv[i] = 0.f;
        if (t < nv) { const bf16* up = U + (size_t)(r0 + t) * NINP + h * 128 + c; qv[i] = bf2f(up[Q0]); kv[i] = bf2f(up[K0]); } }
    LDS_BARRIER();
    float bc[16]; float run = 0.f;
#pragma unroll
    for (int i = 0; i < 16; ++i) { const int t = 16 * tg + i; float g = 0.f;
        if (t < nv) { const LAS f32x4* lp = (const LAS f32x4*)(LRS + t * 16); const f32x4 a = lp[0], b = lp[1], cc = lp[2], d = lp[3];
            float pre = gba;
            pre += wa2c[0] * a.x + wa2c[1] * a.y + wa2c[2] * a.z + wa2c[3] * a.w + wa2c[4] * b.x + wa2c[5] * b.y + wa2c[6] * b.z + wa2c[7] * b.w;
            pre += wa2c[8] * cc.x + wa2c[9] * cc.y + wa2c[10] * cc.z + wa2c[11] * cc.w + wa2c[12] * d.x + wa2c[13] * d.y + wa2c[14] * d.z + wa2c[15] * d.w;
            g = (fminf(pre, 0.f) - __logf(1.0f + fexp(-fabsf(pre)))) * 0.0625f; }
        run += g; bc[i] = run; }
    TOT[tg * 128 + c] = run;
    LDS_BARRIER();
    float off = 0.f, blast = 0.f;
#pragma unroll
    for (int j = 0; j < 4; ++j) { const float v = TOT[j * 128 + c]; blast += v; if (j < tg) off += v; }
    float kdv[16];
#pragma unroll
    for (int i = 0; i < 16; ++i) { const int t = 16 * tg + i; const float bci = bc[i] + off;
        if (t < nv && !dry) { bf16* up = U + (size_t)(r0 + t) * NINP + h * 128 + c; up[Q0] = f2bf1(qv[i] * fexp(bci)); up[K0] = f2bf1(kv[i] * fexp(-bci)); }
        kdv[i] = kv[i] * fexp(blast - bci); }
    { u32x4 k0, k1; k0.x = cvtpk(kdv[0], kdv[1]); k0.y = cvtpk(kdv[2], kdv[3]); k0.z = cvtpk(kdv[4], kdv[5]); k0.w = cvtpk(kdv[6], kdv[7]);
      k1.x = cvtpk(kdv[8], kdv[9]); k1.y = cvtpk(kdv[10], kdv[11]); k1.z = cvtpk(kdv[12], kdv[13]); k1.w = cvtpk(kdv[14], kdv[15]);
      bf16* kd = (bf16*)(WSP + WS_KD) + (size_t)item * 8192 + c * 64 + 16 * tg; if (!dry || k0.x == 0x12345u) { *(u32x4*)kd = k0; *(u32x4*)(kd + 8) = k1; } }
    if (tg == 0 && !dry) ((float*)(WSP + WS_EL))[(size_t)item * 128 + c] = fexp(blast);
    LDS_BARRIER();
}

__device__ __forceinline__ void gla_rec(LAS unsigned char* lds, int l, int h, int vh, int row_base, int nch, int nv_last, int cidx0, const float* S0, float* ST, int dry = 0) {
    int tid_ = threadIdx.x; asm volatile("" : "+v"(tid_));
    const int tid = tid_, lane = tid & 63, w = __builtin_amdgcn_readfirstlane(tid >> 6), fr = lane & 15, fq = lane >> 4;
    LAS bf16* Qs = (LAS bf16*)lds; LAS bf16* Ks = (LAS bf16*)(lds + 17408); LAS bf16* KDT = (LAS bf16*)(lds + 34816); LAS bf16* VT = (LAS bf16*)(lds + 53248);
    LAS bf16* ATT = (LAS bf16*)(lds + 71680); LAS float* EL = (LAS float*)(lds + 80896);
    bf16* const U = (bf16*)(WSP + WS_U); const bf16* const KDg = (const bf16*)(WSP + WS_KD); const float* const ELg = (const float*)(WSP + WS_EL);
    f32x4 S[8];
#pragma unroll
    for (int kt = 0; kt < 8; ++kt)
#pragma unroll
        for (int e = 0; e < 4; ++e) S[kt][e] = S0 ? S0[(size_t)(16 * kt + 4 * fq + e) * 256 + 16 * w + fr] : 0.f;
    u32x4 pq[2][2], pk[2][2], pd[2][2], pv[2][2]; f32x4 pe[2] = {{0.f, 0.f, 0.f, 0.f}, {0.f, 0.f, 0.f, 0.f}};
#define GLA_LOADC(ci_, u_) do { const int r0_ = row_base + (ci_) * 64, nv_ = ((ci_) == nch - 1) ? nv_last : 64; const size_t it_ = (size_t)(cidx0 + (ci_)) * 4 + h; \
        _Pragma("unroll") for (int p = 0; p < 2; ++p) { const int idx = tid + 512 * p, t = idx >> 4, seg = idx & 15, tv = idx & 63, sv = idx >> 6; \
            const u32x4 z4 = {0u, 0u, 0u, 0u}; pq[u_][p] = z4; pk[u_][p] = z4; pv[u_][p] = z4; \
            if (t < nv_) { const bf16* up = U + (size_t)(r0_ + t) * NINP + h * 128 + 8 * seg; pq[u_][p] = *(const u32x4*)(up + Q0); pk[u_][p] = *(const u32x4*)(up + K0); } \
            pd[u_][p] = *(const u32x4*)(KDg + it_ * 8192 + idx * 8); \
            if (tv < nv_) pv[u_][p] = *(const u32x4*)(U + (size_t)(r0_ + tv) * NINP + V0 + h * 256 + vh * 128 + 8 * sv); } \
        if (tid < 32) pe[u_] = *(const f32x4*)(ELg + it_ * 128 + 4 * tid); } while (0)
    GLA_LOADC(0, 0);
    for (int c2 = 0; c2 < nch; c2 += 2) {
#pragma unroll
      for (int u = 0; u < 2; ++u) { const int ci = c2 + u; if (ci < nch) {
        const int r0 = row_base + ci * 64, nv = (ci == nch - 1) ? nv_last : 64;
#pragma unroll
        for (int p = 0; p < 2; ++p) { const int idx = tid + 512 * p, t = idx >> 4, seg = idx & 15, tv = idx & 63, sv = idx >> 6;
            *(LAS u32x4*)(Qs + t * 136 + 8 * seg) = pq[0][p]; *(LAS u32x4*)(Ks + t * 136 + 8 * seg) = pk[0][p];
            *(LAS u32x4*)(KDT + (idx >> 3) * 72 + (idx & 7) * 8) = pd[0][p];
            LAS bf16* vp = VT + (8 * sv) * 72 + tv; const u32x4 vv = pv[0][p];
            vp[0] = (bf16)(vv.x & 0xffffu); vp[72] = (bf16)(vv.x >> 16); vp[144] = (bf16)(vv.y & 0xffffu); vp[216] = (bf16)(vv.y >> 16);
            vp[288] = (bf16)(vv.z & 0xffffu); vp[360] = (bf16)(vv.z >> 16); vp[432] = (bf16)(vv.w & 0xffffu); vp[504] = (bf16)(vv.w >> 16); }
        if (tid < 32) *(LAS f32x4*)(EL + 4 * tid) = pe[0];
        LDS_BARRIER();
        if (ci + 1 < nch) GLA_LOADC(ci + 1, 0);
#define SB() __builtin_amdgcn_sched_barrier(0)
        { const int it = w >> 1; bf16x8 qf[4], kf[2][4];
#pragma unroll
          for (int ks = 0; ks < 4; ++ks) { qf[ks] = *(const LAS bf16x8*)(Qs + (16 * it + fr) * 136 + 32 * ks + 8 * fq);
#pragma unroll
            for (int jj = 0; jj < 2; ++jj) kf[jj][ks] = *(const LAS bf16x8*)(Ks + (16 * ((w & 1) * 2 + jj) + fr) * 136 + 32 * ks + 8 * fq); }
          SB();
          f32x4 a4[2] = {{0.f, 0.f, 0.f, 0.f}, {0.f, 0.f, 0.f, 0.f}};
#pragma unroll
          for (int ks = 0; ks < 4; ++ks) { a4[0] = MFMA16(kf[0][ks], qf[ks], a4[0]); a4[1] = MFMA16(kf[1][ks], qf[ks], a4[1]); }
          const int i = 16 * it + fr;
#pragma unroll
          for (int jj = 0; jj < 2; ++jj) { const int jt = (w & 1) * 2 + jj;
#pragma unroll
            for (int e = 0; e < 4; ++e) if (16 * jt + 4 * fq + e > i) a4[jj][e] = 0.f;
            u32x2 o2; o2.x = cvtpk(a4[jj][0], a4[jj][1]); o2.y = cvtpk(a4[jj][2], a4[jj][3]);
            *(LAS u32x2*)(ATT + i * 72 + 16 * jt + 4 * fq) = o2; } }
        LDS_BARRIER();
        bf16x8 vb[2], Sp[4], aaA[2], qaA[2][4], aaB[2][2], qaB[2][4];
#define GLA_QA(dst_, it_, ks_) do { const u32x2 lo_ = *(const LAS u32x2*)(Qs + (16 * (it_) + fr) * 136 + 32 * (ks_) + 4 * fq), hi_ = *(const LAS u32x2*)(Qs + (16 * (it_) + fr) * 136 + 32 * (ks_) + 16 + 4 * fq); \
            u32x4 q4_; q4_.x = lo_.x; q4_.y = lo_.y; q4_.z = hi_.x; q4_.w = hi_.y; dst_ = __builtin_bit_cast(bf16x8, q4_); } while (0)
#pragma unroll
        for (int js = 0; js < 2; ++js) vb[js] = *(const LAS bf16x8*)(VT + (16 * w + fr) * 72 + 32 * js + 8 * fq);
#pragma unroll
        for (int ii = 0; ii < 2; ++ii) { aaA[ii] = *(const LAS bf16x8*)(ATT + (16 * ii + fr) * 72 + 8 * fq);
#pragma unroll
            for (int ks = 0; ks < 4; ++ks) GLA_QA(qaA[ii][ks], ii, ks); }
#pragma unroll
        for (int ks = 0; ks < 4; ++ks) { u32x4 pk4; const f32x4 s0 = S[2 * ks], s1 = S[2 * ks + 1];
            pk4.x = cvtpk(s0[0], s0[1]); pk4.y = cvtpk(s0[2], s0[3]); pk4.z = cvtpk(s1[0], s1[1]); pk4.w = cvtpk(s1[2], s1[3]); Sp[ks] = __builtin_bit_cast(bf16x8, pk4); }
        SB();
#pragma unroll
        for (int ii = 0; ii < 2; ++ii) {
#pragma unroll
            for (int js = 0; js < 2; ++js) aaB[ii][js] = *(const LAS bf16x8*)(ATT + (16 * (2 + ii) + fr) * 72 + 32 * js + 8 * fq);
#pragma unroll
            for (int ks = 0; ks < 4; ++ks) GLA_QA(qaB[ii][ks], 2 + ii, ks); }
        f32x4 o[4];
        { f32x4 o0 = {0.f, 0.f, 0.f, 0.f}, o1 = {0.f, 0.f, 0.f, 0.f};
          o0 = MFMA16(aaA[0], vb[0], o0); o1 = MFMA16(aaA[1], vb[0], o1);
#pragma unroll
          for (int ks = 0; ks < 4; ++ks) { o0 = MFMA16(qaA[0][ks], Sp[ks], o0); o1 = MFMA16(qaA[1][ks], Sp[ks], o1); }
          o[0] = o0; o[1] = o1; }
        SB();
        f32x4 elv[8];
#pragma unroll
        for (int kt = 0; kt < 8; ++kt) elv[kt] = *(const LAS f32x4*)(EL + 16 * kt + 4 * fq);
        { f32x4 o2 = {0.f, 0.f, 0.f, 0.f}, o3 = {0.f, 0.f, 0.f, 0.f};
#pragma unroll
          for (int js = 0; js < 2; ++js) { o2 = MFMA16(aaB[0][js], vb[js], o2); o3 = MFMA16(aaB[1][js], vb[js], o3); }
#pragma unroll
          for (int ks = 0; ks < 4; ++ks) { o2 = MFMA16(qaB[0][ks], Sp[ks], o2); o3 = MFMA16(qaB[1][ks], Sp[ks], o3); }
          o[2] = o2; o[3] = o3; }
        SB();
        bf16x8 kd0[8], kd1[8];
#pragma unroll
        for (int kt = 0; kt < 8; ++kt) kd0[kt] = *(const LAS bf16x8*)(KDT + (16 * kt + fr) * 72 + 8 * fq);
#pragma unroll
        for (int kt = 0; kt < 8; ++kt) kd1[kt] = *(const LAS bf16x8*)(KDT + (16 * kt + fr) * 72 + 32 + 8 * fq);
#pragma unroll
        for (int kt = 0; kt < 8; ++kt) S[kt] *= elv[kt];
        SB();
#pragma unroll
        for (int kt = 0; kt < 8; ++kt) S[kt] = MFMA16(kd0[kt], vb[0], S[kt]);
#pragma unroll
        for (int kt = 0; kt < 8; ++kt) S[kt] = MFMA16(kd1[kt], vb[1], S[kt]);
        SB();
#undef GLA_QA
#pragma unroll
        for (int it = 0; it < 4; ++it)
#pragma unroll
            for (int e = 0; e < 4; ++e) { const int row = 16 * it + 4 * fq + e;
                if (row < nv && (!dry || o[it][e] == 1.2345e30f)) U[(size_t)(r0 + row) * NINP + V0 + h * 256 + vh * 128 + 16 * w + fr] = f2bf1(o[it][e]); }
        LDS_BARRIER();
      } }
    }
#undef GLA_LOADC
#pragma unroll
    for (int kt = 0; kt < 8; ++kt)
#pragma unroll
        for (int e = 0; e < 4; ++e) if (!dry || S[kt][e] == 1.2345e30f) ST[(size_t)(16 * kt + 4 * fq + e) * 256 + 16 * w + fr] = S[kt][e];
}
__device__ __forceinline__ void gla_fin_row(bf16* U, const float* gnorm, int row, int lane, int dry = 0) {
    const u32x4* op = (const u32x4*)(U + (size_t)row * NINP + V0 + 16 * lane); u32x4* rp = (u32x4*)(U + (size_t)row * NINP + R0 + 16 * lane);
    const u32x4 o0 = op[0], o1 = op[1], r0 = rp[0], r1 = rp[1];
    float ov[16] = {bflo(o0.x), bfhi(o0.x), bflo(o0.y), bfhi(o0.y), bflo(o0.z), bfhi(o0.z), bflo(o0.w), bfhi(o0.w), bflo(o1.x), bfhi(o1.x), bflo(o1.y), bfhi(o1.y), bflo(o1.z), bfhi(o1.z), bflo(o1.w), bfhi(o1.w)};
    const float rv[16] = {bflo(r0.x), bfhi(r0.x), bflo(r0.y), bfhi(r0.y), bflo(r0.z), bfhi(r0.z), bflo(r0.w), bfhi(r0.w), bflo(r1.x), bfhi(r1.x), bflo(r1.y), bfhi(r1.y), bflo(r1.z), bfhi(r1.z), bflo(r1.w), bfhi(r1.w)};
    float ss = 0.f;
#pragma unroll
    for (int i = 0; i < 16; ++i) ss += ov[i] * ov[i];
    ss += bperm(lane ^ 1, ss); ss += bperm(lane ^ 2, ss); ss += bperm(lane ^ 4, ss); ss += bperm(lane ^ 8, ss);
    const float rstd = 1.0f / sqrtf(ss * (1.0f / 256.0f) + EPS);
    const f32x4* gp = (const f32x4*)(gnorm + 16 * lane);
#pragma unroll
    for (int j = 0; j < 4; ++j) { const f32x4 g = gp[j];
#pragma unroll
        for (int e = 0; e < 4; ++e) ov[4 * j + e] = ov[4 * j + e] * rstd * g[e] * rv[4 * j + e]; }
    u32x4 w0, w1; w0.x = cvtpk(ov[0], ov[1]); w0.y = cvtpk(ov[2], ov[3]); w0.z = cvtpk(ov[4], ov[5]); w0.w = cvtpk(ov[6], ov[7]);
    w1.x = cvtpk(ov[8], ov[9]); w1.y = cvtpk(ov[10], ov[11]); w1.z = cvtpk(ov[12], ov[13]); w1.w = cvtpk(ov[14], ov[15]);
    if (!dry || w0.x == 0x12345u) { rp[0] = w0; rp[1] = w1; }
}

__device__ __forceinline__ void small_gemm(LAS unsigned char* lds, const bf16* A, int lda, const bf16* Bt, int ldb, int K, f32x4 (&acc)[2]) {
    int tid_ = threadIdx.x; asm volatile("" : "+v"(tid_));
    const int tid = tid_, lane = tid & 63, w = __builtin_amdgcn_readfirstlane(tid >> 6), fr = lane & 15, fq = lane >> 4, wr = w & 3, wc = w >> 2;
    const int r = tid >> 3, seg = tid & 7, ns = K >> 7;
    const bf16* ap = A + (size_t)r * lda + 8 * seg; const bf16* bp = Bt + (size_t)r * ldb + 8 * seg;
    u32x4 pa[3][2], pb[3][2];
#pragma unroll
    for (int u = 0; u < 3; ++u) if (u < ns) {
#pragma unroll
        for (int hh = 0; hh < 2; ++hh) { pa[u][hh] = *(const u32x4*)(ap + u * 128 + 64 * hh); pb[u][hh] = *(const u32x4*)(bp + u * 128 + 64 * hh); } }
    for (int s0 = 0; s0 < ns; s0 += 3) {
#pragma unroll
        for (int u = 0; u < 3; ++u) { const int st = s0 + u; if (st < ns) {
            LAS bf16* As = (LAS bf16*)(lds + u * 34816); LAS bf16* Bs = (LAS bf16*)(lds + u * 34816 + 17408);
#pragma unroll
            for (int hh = 0; hh < 2; ++hh) { *(LAS u32x4*)(As + r * 136 + 64 * hh + 8 * seg) = pa[u][hh]; *(LAS u32x4*)(Bs + r * 136 + 64 * hh + 8 * seg) = pb[u][hh]; }
            LDS_BARRIER();
            if (st + 3 < ns) {
#pragma unroll
                for (int hh = 0; hh < 2; ++hh) { pa[u][hh] = *(const u32x4*)(ap + (st + 3) * 128 + 64 * hh); pb[u][hh] = *(const u32x4*)(bp + (st + 3) * 128 + 64 * hh); } }
            bf16x8 af[4], bf_[2][4];
#pragma unroll
            for (int kk = 0; kk < 4; ++kk) { af[kk] = *(const LAS bf16x8*)(As + (16 * wr + fr) * 136 + 32 * kk + 8 * fq);
#pragma unroll
                for (int n = 0; n < 2; ++n) bf_[n][kk] = *(const LAS bf16x8*)(Bs + (32 * wc + 16 * n + fr) * 136 + 32 * kk + 8 * fq); }
            __builtin_amdgcn_sched_barrier(0);
#pragma unroll
            for (int kk = 0; kk < 4; ++kk)
#pragma unroll
                for (int n = 0; n < 2; ++n) acc[n] = MFMA16(af[kk], bf_[n][kk], acc[n]);
        } }
    }
    LDS_BARRIER();
}

#define XB_TMO      128
#define XB_XCNT(j)  (256  + 64 * (j))
#define XB_XSUB(j)  (1280 + 64 * (j))
#define XB_XGEN(j)  (2304 + 64 * (j))
#define XB_TOP      3328
#define XB_TOPGEN   3392
#define XCD_BAR_WORDS 3456
#define XB_SPIN_CAP (1u << 18)

__device__ __forceinline__ unsigned xb_ld(unsigned* p)              { return __hip_atomic_load(p, __ATOMIC_RELAXED, __HIP_MEMORY_SCOPE_AGENT); }
__device__ __forceinline__ unsigned xb_add(unsigned* p, unsigned v) { return __hip_atomic_fetch_add(p, v, __ATOMIC_RELAXED, __HIP_MEMORY_SCOPE_AGENT); }
__device__ __forceinline__ unsigned xb_xcc_id() { return (unsigned)__builtin_amdgcn_s_getreg((3 << 11) | 20) & 0xFu; }
#define XB_SPIN(cond, bar) do { unsigned _sp = 0; while (cond) { __builtin_amdgcn_s_sleep(1); \
    if ((++_sp & 255u) == 0u) { if (xb_ld(&(bar)[XB_TMO])) break; if (_sp > XB_SPIN_CAP) { atomicAdd(&(bar)[XB_TMO], 1u); break; } } } } while (0)

struct XcdBarrier {
    unsigned* bar; unsigned x;
    volatile LAS unsigned* st;
};

__device__ __forceinline__ XcdBarrier xcd_barrier_post(unsigned* bar, volatile LAS unsigned* st) {
    XcdBarrier b; b.bar = bar; b.x = xb_xcc_id(); b.st = st;
    if (threadIdx.x == 0) (void)xb_add(&bar[XB_XCNT(b.x)], 1u);
    return b;
}
__device__ __forceinline__ void xcd_barrier_complete(unsigned* bar, unsigned x, unsigned& nloc, unsigned& nx) {
    const unsigned G = gridDim.x * gridDim.y * gridDim.z;
    unsigned sum, cnt, mine, sp = 0u;
    for (;;) {
        sum = 0u; cnt = 0u; mine = 0u;
#pragma unroll
        for (unsigned j = 0; j < 16; ++j) { const unsigned c = xb_ld(&bar[XB_XCNT(j)]); sum += c; cnt += (c > 0u) ? 1u : 0u; mine = (j == x) ? c : mine; }
        if (sum == G) break;
        __builtin_amdgcn_s_sleep(1);
        if ((++sp & 255u) == 0u) { if (xb_ld(&bar[XB_TMO])) break; if (sp > XB_SPIN_CAP) { atomicAdd(&bar[XB_TMO], 1u); break; } }
    }
    nloc = mine > 0u ? mine : 1u; nx = cnt > 0u ? cnt : 1u;
}

__device__ __forceinline__ void xcd_barrier(const XcdBarrier& b) {
    asm volatile("s_waitcnt vmcnt(0)" ::: "memory");
    __syncthreads();
    if (threadIdx.x == 0) {
        unsigned* bar = b.bar;
        __builtin_amdgcn_s_waitcnt(0);
        unsigned nloc = b.st[0], nx = b.st[1];
        if (nloc == 0u) { xcd_barrier_complete(bar, b.x, nloc, nx); b.st[0] = nloc; b.st[1] = nx; }
        const unsigned old = xb_add(&bar[XB_XSUB(b.x)], 1u);
        const unsigned gen = old / nloc;
        if (old + 1u == (gen + 1u) * nloc) {
            __builtin_amdgcn_fence(__ATOMIC_RELEASE, "agent");
            asm volatile("s_waitcnt vmcnt(0)" ::: "memory");
            const unsigned og = xb_add(&bar[XB_TOP], 1u);
            const unsigned tg = og / nx;
            if (og + 1u == (tg + 1u) * nx) xb_add(&bar[XB_TOPGEN], 1u);
            else XB_SPIN(xb_ld(&bar[XB_TOPGEN]) == tg, bar);
            __builtin_amdgcn_fence(__ATOMIC_ACQUIRE, "agent");
            xb_add(&bar[XB_XGEN(b.x)], 1u);
            asm volatile("s_waitcnt vmcnt(0)" ::: "memory");
        } else {
            XB_SPIN(xb_ld(&bar[XB_XGEN(b.x)]) == gen, bar);
            __builtin_amdgcn_fence(__ATOMIC_ACQUIRE, "agent");
            asm volatile("s_waitcnt vmcnt(0)" ::: "memory");
        }
    }
    __syncthreads();
}

constexpr int N_PHASES = 23;
__global__ void __launch_bounds__(NTHR, 2) fwd(Args args) {
    extern __shared__ __attribute__((aligned(16))) unsigned char lds_raw[];
    LAS unsigned char* lds = (LAS unsigned char*)lds_raw;
    cg::grid_group grid = cg::this_grid();
    { volatile LAS unsigned* st0 = (volatile LAS unsigned*)(lds + 131072 + 64); if (threadIdx.x < 2) st0[threadIdx.x] = 0u; __syncthreads(); }
    const XcdBarrier xbar = xcd_barrier_post((unsigned*)(args.ws + WS_BAR), (volatile LAS unsigned*)(lds + 131072 + 64));
    const int G = gridDim.x, bx = blockIdx.x;
#define PHASE_LOCALS int t_ = threadIdx.x; asm volatile("" : "+v"(t_)); const int tid = t_, lane = tid & 63, wave = __builtin_amdgcn_readfirstlane(tid >> 6), gw = bx * NWAVES + wave, NGW = G * NWAVES; (void)tid; (void)lane; (void)gw; (void)NGW;
#define ws WSP
#define X (OUTP + O_Y)
#define HN ((bf16*)(WSP + WS_HN))
#define U ((bf16*)(WSP + WS_U))
#define FF ((bf16*)(WSP + WS_U))
#define PB ((float*)(WSP + WS_P))
#define MOD ((float*)(WSP + WS_MOD))
#define CS ((bf16*)(WSP + WS_CS))
    const int lo = args.ph_lo, hi = args.ph_hi;
#ifndef PROBE_P0
#define PROBE_P0 0
#endif
#ifndef PROBE_SYNC
#define PROBE_SYNC 0
#endif
#ifndef PROBE_RES
#define PROBE_RES 0
#endif
#ifndef PROBE_PREP
#define PROBE_PREP 0
#endif
#ifndef PROBE_REC
#define PROBE_REC 0
#endif
#ifndef PROBE_FIN
#define PROBE_FIN 0
#endif
#ifndef REP
#define REP 1
#endif
#ifndef SCM
#define SCM 15
#endif
#ifndef DBG_MASK
#define DBG_MASK 0x7ffff
#endif
#define PHON(k) ((DBG_MASK >> ((k) < 10 ? (k) : (k) - 8)) & 1)
#define IN(k) (lo <= (k) && (k) < hi)
#define SEAM(k) do { if (lo <= (k) && (k) + 1 < hi) { if (lo == 0x7fffffff) grid.sync(); else xcd_barrier(xbar); } } while (0)

    for (int rp0_ = 0; rp0_ < 1 + (PROBE_P0 ? (hi > 22) : 0); ++rp0_) if (IN(0)) {
        PHASE_LOCALS
        LAS float* scr = (LAS float*)(lds + wave * 16384);
        constexpr int I_ADA = 16 * 192;
        for (int it = gw; it < 2 * I_ADA; it += NGW) { const int l = it / I_ADA, r = it % I_ADA;
            transpose_item(inp(9) + (size_t)l * D * NMOD, D, NMOD, (bf16*)(ws + WS_ADA + l * SZ_ADA), D, 0, 192, 0, scr, r, lane); }
        bf16* WG = (bf16*)(ws + WS_WG);
        for (int idx = bx * NTHR + tid; idx < 2 * 10 * 256 * 128; idx += G * NTHR) {
            const int l = idx / 327680, r = idx % 327680, n = r >> 15, vv = (r >> 7) & 255, wi = r & 127;
            const float* src = (vv < 128 ? inp(14) : inp(16)) + ((size_t)(l * 10 + n) * 128 + wi) * 128 + (vv & 127);
            WG[idx] = f2bf1(*src);
        }
        for (int idx = bx * NTHR + tid; idx < 256 * D; idx += G * NTHR) {
            const int row = idx >> 10, col = idx & 1023; float v = 0.f;
            if (row < 8) v = inp(2)[row * D + col]; else if (row < NB) v = inp(3)[(row - 8) * D + col];
            CS[idx] = f2bf1(v * fsigmoid(v));
        }
    }
    SEAM(0);
    for (int rp1_ = 0; rp1_ < 1 + (PROBE_P0 ? (hi > 22) : 0); ++rp1_) if (IN(1)) {
        if (bx < 48) { const int l = bx / 24;
            pg8::Gemm g{CS, (const bf16*)(ws + WS_ADA + l * SZ_ADA), 256, NMOD, D, D, D}; pg8::StaticOrder S; S.init(256, NMOD, G, bx % 24);
            pg8::EpiMod E{MOD + (size_t)l * NB * NMOD, inp(10) + (size_t)l * NMOD};
            pg8::gemm_phase<pg8::EpiMod, pg8::StaticOrder, true, true>(lds, g, S, E);
        } else {
            PHASE_LOCALS
            LAS float* scr = (LAS float*)(lds + wave * 16384);
            const int gw2 = (bx - 48) * NWAVES + wave, NGW2 = (G - 48) * NWAVES;
            constexpr int I_WIN = 16 * 248, I_PA = 20 * 32, I_PB = 16 * 32, I_WO = 16 * 32, I_W1 = 16 * 176, I_W2 = 44 * 32;
            constexpr int I_L = I_WIN + I_PA + I_PB + I_WO + I_W1 + I_W2;
            for (int it = gw2; it < 2 * I_L; it += NGW2) {
                const int l = it / I_L; int r = it % I_L;
                if (r < I_WIN) { transpose_item(inp(11) + (size_t)l * D * 7696, D, 7696, (bf16*)(ws + WS_WIN + l * SZ_WIN), D, 0, 248, 1, scr, r, lane); continue; } r -= I_WIN;
                if (r < I_PA) { transpose_item(inp(22) + (size_t)l * DR * D, DR, D, (bf16*)(ws + WS_WPJ + l * SZ_WPJ), DR + DVT, 0, 32, 0, scr, r, lane); continue; } r -= I_PA;
                if (r < I_PB) { transpose_item(inp(23) + (size_t)l * DVT * D, DVT, D, (bf16*)(ws + WS_WPJ + l * SZ_WPJ), DR + DVT, DR, 32, 0, scr, r, lane); continue; } r -= I_PB;
                if (r < I_WO) { transpose_item(inp(24) + (size_t)l * D * D, D, D, (bf16*)(ws + WS_WOUT + l * SZ_WOUT), D, 0, 32, 0, scr, r, lane); continue; } r -= I_WO;
                if (r < I_W1) { transpose_item(inp(25) + (size_t)l * D * 2 * DFF, D, 2 * DFF, (bf16*)(ws + WS_W1 + l * SZ_W1), D, 0, 176, 2, scr, r, lane); continue; } r -= I_W1;
                transpose_item(inp(26) + (size_t)l * DFF * D, DFF, D, (bf16*)(ws + WS_W2 + l * SZ_W2), DFF, 0, 32, 0, scr, r, lane);
            }
        }
    }
    SEAM(1);
    for (int l = 0; l < 2; ++l) {
        const int pb = 2 + 10 * l;
#define modl (MOD + (size_t)l * NB * NMOD)
        if (IN(pb)) {
            PHASE_LOCALS
            for (int row = gw; row < M; row += NGW) {
                const float* xr = l == 0 ? (row < MP ? inp(0) + (size_t)row * D : inp(1) + (size_t)(row - MP) * D) : X + (size_t)row * D;
                const float* mb = modl + (size_t)row_batch(row) * NMOD;
                norm_row(xr, inp(7) + l * D, mb + 1024, mb, HN + (size_t)row * D, nullptr, lane);
            }
        }
        SEAM(pb);
        if (IN(pb + 1)) {
            pg8::Gemm g{HN, (const bf16*)(ws + WS_WIN + l * SZ_WIN), M, NINP, D, D, D}; pg8::StaticOrder S; S.init(M, NINP, G, bx);
            pg8::EpiWin E{U};
            pg8::gemm_phase<pg8::EpiWin, pg8::StaticOrder, true, true>(lds, g, S, E);
        }
        SEAM(pb + 1);
        if (IN(pb + 2)) {
            const int nrep = 1 + (PROBE_PREP ? (hi > 22) : 0);
            for (int rp_ = 0; rp_ < nrep; ++rp_) { const int dry = rp_ < nrep - 1;
            for (int item = bx; item < 1536; item += G) gla_prep(lds, l, item, dry); }
        }
        SEAM(pb + 2);
        if (IN(pb + 3)) {
            ScanP P; P.l = l;
            float* const o_gla_p = OUTP + O_GLAP + (size_t)l * 8 * 4 * 32768; float* const o_gla_s = OUTP + O_GLAS + (size_t)l * 128 * 4 * 32768;
            if (bx < 64) { const int nrep = 1 + (PROBE_REC == 2 ? (hi > 22) : 0); for (int rp_ = 0; rp_ < nrep; ++rp_) { const int b = bx >> 3, h = (bx >> 1) & 3, vh = bx & 1; gla_rec(lds, l, h, vh, b * SEQ, SEQ / 64, 64, b * 32, nullptr, o_gla_p + (size_t)(b * 4 + h) * 32768 + vh * 128, rp_ < nrep - 1); } }
            else if (bx < 224) { lru_half_item(lds, l, bx - 64); }
            { unsigned* qc = (unsigned*)(WSP + WS_BAR) + 8192 + 64 * l; volatile LAS unsigned* qs = (volatile LAS unsigned*)(lds + 131072 + 128);
              for (;;) {
                __syncthreads();
                if (threadIdx.x == 0) *qs = atomicAdd(qc, 1u);
                __syncthreads();
                const int j = (int)*qs;
                if (j >= 1104) break;
                if (j < 80) lru_item<true>(lds, P, j);
                else { const int jj = j - 80, b = jj >> 3, h = (jj >> 1) & 3, vh = jj & 1;
                    gla_rec(lds, l, h, vh, MP + b * 4, 1, 4, 256 + b, inp(6) + (size_t)l * 128 * 4 * 32768 + (size_t)(b * 4 + h) * 32768 + vh * 128, o_gla_s + (size_t)(b * 4 + h) * 32768 + vh * 128); }
              } }
        }
        SEAM(pb + 3);
        if (IN(pb + 4)) {
            PHASE_LOCALS
            const int nrep = 1 + (PROBE_FIN ? (hi > 22) : 0);
            for (int rp_ = 0; rp_ < nrep; ++rp_) { const int dry = rp_ < nrep - 1;
            for (int row = gw; row < M; row += NGW) gla_fin_row(U, inp(21) + (size_t)l * DVT, row, lane, dry); }
        }
        SEAM(pb + 4);
        if (IN(pb + 5)) {
            const bf16* wpj = (const bf16*)(ws + WS_WPJ + l * SZ_WPJ);
            { pg8::Gemm g{U + G0, wpj, MP, D, DR, NINP, DR + DVT}; pg8::StaticOrder S; S.init(MP, D, G, bx); pg8::EpiProj E{U, PB, HN, 0};
              pg8::gemm_phase<pg8::EpiProj, pg8::StaticOrder, true, true>(lds, g, S, E); }
            { pg8::Gemm g{U + R0, wpj + DR, MP, D, DVT, NINP, DR + DVT}; pg8::StaticOrder S; S.init(MP, D, G, bx); pg8::EpiProj E{U, PB, HN, 1};
              pg8::gemm_phase<pg8::EpiProj, pg8::StaticOrder, true, true>(lds, g, S, E); }
            if (bx >= G - 128) {
                const int j = G - 1 - bx, rt = j >> 4, ct = j & 15; const int rowt = MP + 64 * rt, colt = 64 * ct;
                f32x4 aa[2] = {{0.f, 0.f, 0.f, 0.f}, {0.f, 0.f, 0.f, 0.f}}, ab[2] = {{0.f, 0.f, 0.f, 0.f}, {0.f, 0.f, 0.f, 0.f}};
                small_gemm(lds, U + (size_t)rowt * NINP + G0, NINP, wpj + (size_t)colt * (DR + DVT), DR + DVT, DR, aa);
                small_gemm(lds, U + (size_t)rowt * NINP + R0, NINP, wpj + (size_t)colt * (DR + DVT) + DR, DR + DVT, DVT, ab);
                int t_ = threadIdx.x; asm volatile("" : "+v"(t_)); const int lane = t_ & 63, w = t_ >> 6, fr = lane & 15, fq = lane >> 4;
#pragma unroll
                for (int n = 0; n < 2; ++n)
#pragma unroll
                    for (int e = 0; e < 4; ++e) { const int row = rowt + 16 * (w & 3) + 4 * fq + e, col = colt + 32 * (w >> 2) + 16 * n + fr; const bf16* up = U + (size_t)row * NINP + col;
                        HN[(size_t)row * D + col] = f2bf1(bf2f(up[GA0]) * aa[n][e] + bf2f(up[GB0]) * ab[n][e]); }
            }
        }
        SEAM(pb + 5);
        if (IN(pb + 6)) {
            pg8::Gemm g{HN, (const bf16*)(ws + WS_WOUT + l * SZ_WOUT), MP, D, D, D, D}; pg8::StaticOrder S; S.init(MP, D, G, bx);
            const int nrep = 1 + (PROBE_RES ? (hi > 22) : 0);
            for (int rp_ = 0; rp_ < nrep; ++rp_) {
            pg8::EpiRes E{l == 0 ? inp(0) : X, l == 0 ? inp(1) : X + (size_t)MP * D, X, modl + 2048, rp_ < nrep - 1};
            pg8::gemm_phase<pg8::EpiRes, pg8::StaticOrder, true, true>(lds, g, S, E); }
            if (bx >= G - 128) { const int j = G - 1 - bx, rt = j >> 4, ct = j & 15; const int rowt = MP + 64 * rt, colt = 64 * ct;
                f32x4 aa[2] = {{0.f, 0.f, 0.f, 0.f}, {0.f, 0.f, 0.f, 0.f}};
                small_gemm(lds, HN + (size_t)rowt * D, D, (const bf16*)(ws + WS_WOUT + l * SZ_WOUT) + (size_t)colt * D, D, D, aa);
                int t_ = threadIdx.x; asm volatile("" : "+v"(t_)); const int lane = t_ & 63, w = t_ >> 6, fr = lane & 15, fq = lane >> 4;
                const float* bs = l == 0 ? inp(1) : X + (size_t)MP * D;
#pragma unroll
                for (int n = 0; n < 2; ++n)
#pragma unroll
                    for (int e = 0; e < 4; ++e) { const int row = rowt + 16 * (w & 3) + 4 * fq + e, col = colt + 32 * (w >> 2) + 16 * n + fr;
                        X[(size_t)row * D + col] = bs[(size_t)(row - MP) * D + col] + (modl + 2048)[(size_t)row_batch(row) * NMOD + col] * aa[n][e]; }
            }
        }
        SEAM(pb + 6);
        if (IN(pb + 7)) {
            PHASE_LOCALS
            for (int row = gw; row < M; row += NGW) {
                const float* mb = modl + (size_t)row_batch(row) * NMOD;
                norm_row(X + (size_t)row * D, inp(8) + l * D, mb + 4096, mb + 3072, HN + (size_t)row * D, nullptr, lane);
            }
        }
        SEAM(pb + 7);
        if (IN(pb + 8)) {
            pg8::Gemm g{HN, (const bf16*)(ws + WS_W1 + l * SZ_W1), M, 2 * DFF, D, D, D}; pg8::StaticOrder S; S.init(M, 2 * DFF, G, bx);
            pg8::EpiSwiglu E{FF};
            pg8::gemm_phase<pg8::EpiSwiglu, pg8::StaticOrder, true, true>(lds, g, S, E);
        }
        SEAM(pb + 8);
        if (IN(pb + 9)) {
            pg8::Gemm g{FF, (const bf16*)(ws + WS_W2 + l * SZ_W2), MP, D, DFF, DFF, DFF}; pg8::StaticOrder S; S.init(MP, D, G, bx);
            const int nrep = 1 + (PROBE_RES ? (hi > 22) : 0);
            for (int rp_ = 0; rp_ < nrep; ++rp_) {
            pg8::EpiRes E{X, X + (size_t)MP * D, X, modl + 5120, rp_ < nrep - 1};
            pg8::gemm_phase<pg8::EpiRes, pg8::StaticOrder, true, true>(lds, g, S, E); }
            if (bx >= G - 128) { const int j = G - 1 - bx, rt = j >> 4, ct = j & 15; const int rowt = MP + 64 * rt, colt = 64 * ct;
                f32x4 aa[2] = {{0.f, 0.f, 0.f, 0.f}, {0.f, 0.f, 0.f, 0.f}};
                small_gemm(lds, FF + (size_t)rowt * DFF, DFF, (const bf16*)(ws + WS_W2 + l * SZ_W2) + (size_t)colt * DFF, DFF, DFF, aa);
                int t_ = threadIdx.x; asm volatile("" : "+v"(t_)); const int lane = t_ & 63, w = t_ >> 6, fr = lane & 15, fq = lane >> 4;
#pragma unroll
                for (int n = 0; n < 2; ++n)
#pragma unroll
                    for (int e = 0; e < 4; ++e) { const int row = rowt + 16 * (w & 3) + 4 * fq + e, col = colt + 32 * (w >> 2) + 16 * n + fr;
                        float* xp_ = X + (size_t)row * D + col; *xp_ = *xp_ + (modl + 5120)[(size_t)row_batch(row) * NMOD + col] * aa[n][e]; }
            }
        }
        SEAM(pb + 9);
    }
    if (IN(22)) {
        PHASE_LOCALS
        for (int row = gw; row < M; row += NGW) norm_row(X + (size_t)row * D, inp(27), nullptr, nullptr, nullptr, X + (size_t)row * D, lane);
    }
#undef IN
#undef SEAM
#undef ws
#undef X
#undef HN
#undef U
#undef FF
#undef PB
#undef MOD
#undef CS
#undef modl
}

#ifndef MK_SPLIT
#define MK_SPLIT 0
#endif
extern "C" void kernel_launch(void* const* d_in, const int* in_sizes, int n_in, void* d_out, int out_size, void* d_ws, size_t ws_size, hipStream_t stream) {
    static int grid = 0;
    if (grid == 0) {
        if (n_in != 28 || (size_t)out_size != O_END || ws_size < WS_END) { fprintf(stderr, "kernel_launch: unexpected shapes (n_in %d, out %d, ws %zu, need %zu); nothing launched\n", n_in, out_size, ws_size, (size_t)WS_END); grid = -1; return; }
        int dev = 0, cus = 0, per_cu = 0;
        (void)hipGetDevice(&dev); (void)hipDeviceGetAttribute(&cus, hipDeviceAttributeMultiprocessorCount, dev);
        if (hipFuncSetAttribute((const void*)fwd, hipFuncAttributeMaxDynamicSharedMemorySize, LDS_BYTES) != hipSuccess) { fprintf(stderr, "kernel_launch: hipFuncSetAttribute failed\n"); grid = -1; return; }
        if (hipOccupancyMaxActiveBlocksPerMultiprocessor(&per_cu, (const void*)fwd, NTHR, LDS_BYTES) != hipSuccess || per_cu < 1) { fprintf(stderr, "kernel_launch: occupancy query says %d\n", per_cu); per_cu = 1; }
        (void)hipGetLastError();
        grid = 256;
        if (cus * per_cu < 256) { fprintf(stderr, "kernel_launch: device holds only %d x %d workgroups; this kernel needs 256 co-resident\n", cus, per_cu); grid = -1; return; }
    }
    if (grid < 0) return;
    if (hipMemsetAsync((char*)d_ws + WS_BAR, 0, 65536, stream) != hipSuccess) { fprintf(stderr, "kernel_launch: memset of barrier words failed\n"); return; }
    Args a{};
    for (int i = 0; i < 28; ++i) a.in[i] = (const float*)d_in[i];
    a.out = (float*)d_out; a.ws = (unsigned char*)d_ws;
#if MK_SPLIT
    for (int p = 0; p < N_PHASES; ++p) { a.ph_lo = p; a.ph_hi = p + 1; void* kargs[] = {&a};
        hipError_t e = hipLaunchCooperativeKernel((const void*)fwd, dim3(grid), dim3(NTHR), kargs, LDS_BYTES, stream);
        if (e != hipSuccess) { fprintf(stderr, "kernel_launch: launch failed: %s\n", hipGetErrorString(e)); break; } }
#else
    a.ph_lo = 0; a.ph_hi = N_PHASES; void* kargs[] = {&a};
    hipError_t e = hipLaunchCooperativeKernel((const void*)fwd, dim3(grid), dim3(NTHR), kargs, LDS_BYTES, stream);
    if (e != hipSuccess) fprintf(stderr, "kernel_launch: cooperative launch failed: %s (grid %d)\n", hipGetErrorString(e), grid);
#endif
}
```
